# Optimizing an MI355X kernel written in HIP

```python
import math
import jax, jax.numpy as jnp
from jax import lax
import numpy as np

D_MODEL = 2048
BATCH = 1
SEQ = 8192
DEPTH = 1

ATTN_WIDTH = D_MODEL // 2
CONV_WIDTH = D_MODEL - ATTN_WIDTH
D_MIX = ATTN_WIDTH + CONV_WIDTH
DIFF_HEAD_DIM = 64
N_DIFF_HEADS = ATTN_WIDTH // (2 * DIFF_HEAD_DIM)
CONV_KERNEL = 31
Q_BLOCK = 128
PEER_HEADS = 8
PEER_KEYS = 128
N_EXPERTS = PEER_KEYS * PEER_KEYS
PEER_TOPK = 16
PEER_KEY_DIM = 256
PEER_TOK_BLOCK = 64
EPS = 1e-6
IN_COLS = 3 * ATTN_WIDTH + 2 * CONV_WIDTH

kernel_name = "hybrid_diffattn_conformer_peer_block"


def rms_norm(x, g):
    xf = x.astype(jnp.float32)
    y = xf * lax.rsqrt(jnp.mean(xf * xf, axis=-1, keepdims=True) + EPS)
    return (y * g.astype(jnp.float32)).astype(x.dtype)


def layer_norm(x, g, b):
    xf = x.astype(jnp.float32)
    mu = jnp.mean(xf, axis=-1, keepdims=True)
    var = jnp.mean(jnp.square(xf - mu), axis=-1, keepdims=True)
    y = (xf - mu) * lax.rsqrt(var + EPS)
    return (y * g.astype(jnp.float32) + b.astype(jnp.float32)).astype(x.dtype)


def lambda_init_fn(layer_idx):
    return 0.8 - 0.6 * math.exp(-0.3 * layer_idx)


def alibi_slopes(n_heads):
    return 2.0 ** (-8.0 * (np.arange(n_heads, dtype=np.float32) + 1.0) / n_heads)


def diff_attention(qkv, lq1, lk1, lq2, lk2, g_subln, lambda_init):
    B, S, _ = qkv.shape
    H, Dh = N_DIFF_HEADS, DIFF_HEAD_DIM
    q, k, v = jnp.split(qkv, 3, axis=-1)
    q = q.reshape(B, S, H, 2, Dh).transpose(0, 2, 3, 1, 4)
    k = k.reshape(B, S, H, 2, Dh).transpose(0, 2, 3, 1, 4)
    v = v.reshape(B, S, H, 2 * Dh).transpose(0, 2, 1, 3)
    lam = (jnp.exp(jnp.sum(lq1.astype(jnp.float32) * lk1.astype(jnp.float32)))
           - jnp.exp(jnp.sum(lq2.astype(jnp.float32) * lk2.astype(jnp.float32)))
           + lambda_init)
    slopes = jnp.asarray(alibi_slopes(H))
    scale = 1.0 / math.sqrt(Dh)
    n_blocks = S // Q_BLOCK
    q_blocks = jnp.moveaxis(q.reshape(B, H, 2, n_blocks, Q_BLOCK, Dh), 3, 0)
    starts = jnp.arange(n_blocks, dtype=jnp.int32) * Q_BLOCK
    k_pos = jnp.arange(S, dtype=jnp.int32)

    def block_fn(args):
        qb, start = args
        q_pos = start + jnp.arange(Q_BLOCK, dtype=jnp.int32)
        s = jnp.einsum('bhmqd,bhmkd->bhmqk', qb, k).astype(jnp.float32) * scale
        dist = (q_pos[:, None] - k_pos[None, :])
        bias = -slopes[:, None, None, None] * dist.astype(jnp.float32)
        s = jnp.where(dist >= 0, s + bias, -jnp.inf)
        p = jax.nn.softmax(s, axis=-1)
        a = p[:, :, 0] - lam * p[:, :, 1]
        return jnp.einsum('bhqk,bhkd->bhqd', a.astype(v.dtype), v)

    o = lax.map(block_fn, (q_blocks, starts))
    o = o.transpose(1, 0, 3, 2, 4).reshape(B, S, H, 2 * Dh)
    o = rms_norm(o, g_subln) * (1.0 - lambda_init)
    return o.reshape(B, S, ATTN_WIDTH)


def conformer_conv(glu_in, conv_w, conv_b, ln_g, ln_b):
    a, gate = jnp.split(glu_in, 2, axis=-1)
    u = a * jax.nn.sigmoid(gate)
    y = lax.conv_general_dilated(
        u, conv_w[:, None, :].astype(u.dtype), window_strides=(1,),
        padding=[(CONV_KERNEL - 1, 0)],
        dimension_numbers=('NWC', 'WIO', 'NWC'),
        feature_group_count=CONV_WIDTH)
    y = y + conv_b
    y = layer_norm(y, ln_g, ln_b)
    return jax.nn.silu(y)


def peer_ffn(h, w_q, k1, k2, u_tab, v_tab):
    B, S, D = h.shape
    T = B * S
    half = PEER_KEY_DIM // 2
    q = (h @ w_q).reshape(T, PEER_HEADS, PEER_KEY_DIM)
    hf = h.reshape(T, D)
    nb = T // PEER_TOK_BLOCK
    q_b = q.reshape(nb, PEER_TOK_BLOCK, PEER_HEADS, PEER_KEY_DIM)
    h_b = hf.reshape(nb, PEER_TOK_BLOCK, D)

    def block_fn(args):
        hb, qb = args
        s1 = jnp.einsum('thd,kd->thk', qb[..., :half], k1)
        s2 = jnp.einsum('thd,kd->thk', qb[..., half:], k2)
        v1, i1 = lax.top_k(s1, PEER_TOPK)
        v2, i2 = lax.top_k(s2, PEER_TOPK)
        cand = (v1[..., :, None] + v2[..., None, :]).reshape(
            PEER_TOK_BLOCK, PEER_HEADS, PEER_TOPK * PEER_TOPK)
        cand_idx = (i1[..., :, None] * PEER_KEYS + i2[..., None, :]).reshape(
            PEER_TOK_BLOCK, PEER_HEADS, PEER_TOPK * PEER_TOPK)
        top, pos = lax.top_k(cand, PEER_TOPK)
        idx = jnp.take_along_axis(cand_idx, pos, axis=-1)
        g = jax.nn.softmax(top.astype(jnp.float32), axis=-1)
        u = u_tab[idx]
        vv = v_tab[idx]
        act = jax.nn.gelu(jnp.einsum('thkd,td->thk', u, hb).astype(jnp.float32),
                          approximate=False) * g
        return jnp.einsum('thk,thkd->td', act.astype(vv.dtype), vv)

    out = lax.map(block_fn, (h_b, q_b))
    return out.reshape(B, S, D)


def setup_inputs(seed: int = 0) -> dict:
    key = jax.random.key(seed)
    ks = jax.random.split(key, 24)
    D = D_MODEL
    f32 = jnp.float32
    nrm = lambda k, shape, s: jax.random.normal(k, shape, f32) * s
    gain = lambda k, shape: 1.0 + nrm(k, shape, 0.05)
    return {
        "x": nrm(ks[0], (BATCH, SEQ, D), 1.0),
        "c": nrm(ks[1], (BATCH, D), 1.0),
        "w_ada": nrm(ks[2], (DEPTH, D, 6 * D), 0.2 * D ** -0.5),
        "b_ada": nrm(ks[3], (DEPTH, 6 * D), 0.01),
        "g_pre_mix": gain(ks[4], (DEPTH, D)),
        "g_post_mix": gain(ks[5], (DEPTH, D)),
        "g_pre_ffn": gain(ks[6], (DEPTH, D)),
        "g_post_ffn": gain(ks[7], (DEPTH, D)),
        "w_in": nrm(ks[8], (DEPTH, D, IN_COLS), D ** -0.5),
        "lambda_q1": nrm(ks[9], (DEPTH, DIFF_HEAD_DIM), 0.1),
        "lambda_k1": nrm(ks[10], (DEPTH, DIFF_HEAD_DIM), 0.1),
        "lambda_q2": nrm(ks[11], (DEPTH, DIFF_HEAD_DIM), 0.1),
        "lambda_k2": nrm(ks[12], (DEPTH, DIFF_HEAD_DIM), 0.1),
        "g_subln": gain(ks[13], (DEPTH, 2 * DIFF_HEAD_DIM)),
        "conv_w": nrm(ks[14], (DEPTH, CONV_KERNEL, CONV_WIDTH), CONV_KERNEL ** -0.5),
        "conv_b": nrm(ks[15], (DEPTH, CONV_WIDTH), 0.01),
        "conv_ln_g": gain(ks[16], (DEPTH, CONV_WIDTH)),
        "conv_ln_b": nrm(ks[17], (DEPTH, CONV_WIDTH), 0.01),
        "w_out": nrm(ks[18], (DEPTH, D_MIX, D), D_MIX ** -0.5),
        "peer_wq": nrm(ks[19], (DEPTH, D, PEER_HEADS * PEER_KEY_DIM), D ** -0.5),
        "peer_k1": nrm(ks[20], (DEPTH, PEER_KEYS, PEER_KEY_DIM // 2), (PEER_KEY_DIM // 2) ** -0.5),
        "peer_k2": nrm(ks[21], (DEPTH, PEER_KEYS, PEER_KEY_DIM // 2), (PEER_KEY_DIM // 2) ** -0.5),
        "peer_u": nrm(ks[22], (DEPTH, N_EXPERTS, D), D ** -0.5),
        "peer_v": nrm(ks[23], (DEPTH, N_EXPERTS, D), (PEER_HEADS * PEER_TOPK) ** -0.5),
    }


def reference(x, c, w_ada, b_ada, g_pre_mix, g_post_mix, g_pre_ffn, g_post_ffn,
              w_in, lambda_q1, lambda_k1, lambda_q2, lambda_k2, g_subln,
              conv_w, conv_b, conv_ln_g, conv_ln_b, w_out,
              peer_wq, peer_k1, peer_k2, peer_u, peer_v):
    for l in range(DEPTH):
        lambda_init = lambda_init_fn(l)
        mod = jax.nn.silu(c) @ w_ada[l] + b_ada[l]
        sh_m, sc_m, gt_m, sh_f, sc_f, gt_f = [m[:, None, :] for m in jnp.split(mod, 6, axis=-1)]

        h = rms_norm(x, g_pre_mix[l]) * (1.0 + sc_m) + sh_m
        proj = h @ w_in[l]
        qkv = proj[..., :3 * ATTN_WIDTH]
        glu_in = proj[..., 3 * ATTN_WIDTH:]
        y_attn = diff_attention(qkv, lambda_q1[l], lambda_k1[l], lambda_q2[l], lambda_k2[l],
                                g_subln[l], lambda_init)
        y_conv = conformer_conv(glu_in, conv_w[l], conv_b[l], conv_ln_g[l], conv_ln_b[l])
        mix = jnp.concatenate([y_attn, y_conv], axis=-1) @ w_out[l]
        x = x + gt_m * rms_norm(mix, g_post_mix[l])

        h = rms_norm(x, g_pre_ffn[l]) * (1.0 + sc_f) + sh_f
        ff = peer_ffn(h, peer_wq[l], peer_k1[l], peer_k2[l], peer_u[l], peer_v[l])
        x = x + gt_f * rms_norm(ff, g_post_ffn[l])
    return x
```

```cpp
#include <hip/hip_runtime.h>
#include <cstdio>
#include <cstdint>
#include <cmath>

constexpr int D = 2048, S = 8192, AW = 1024, CW = 1024, INC = 5120, NH = 8, DH = 64, CK = 31;
constexpr int PH = 8, PK = 128, PTOP = 16, PKD = 256;
constexpr float EPS = 1e-6f;
constexpr float LAMBDA_INIT = 0.2f;

constexpr size_t MiB = 1u << 20;
constexpr size_t WS_MOD = 1 * MiB, WS_IDX = 2 * MiB, WS_G = 6 * MiB, WS_H = 16 * MiB, WS_PROJ = 80 * MiB, WS_Y = 240 * MiB, WS_MIX = 304 * MiB, WS_X1 = 368 * MiB;

__device__ __forceinline__ float wave_sum(float v) {
#pragma unroll
    for (int o = 1; o < 64; o <<= 1) v += __shfl_xor(v, o);
    return v;
}
__device__ __forceinline__ float wave_max(float v) {
#pragma unroll
    for (int o = 1; o < 64; o <<= 1) v = fmaxf(v, __shfl_xor(v, o));
    return v;
}
__device__ __forceinline__ float block_sum256(float v, float* red) {
    v = wave_sum(v);
    __syncthreads();
    if ((threadIdx.x & 63) == 0) red[threadIdx.x >> 6] = v;
    __syncthreads();
    return red[0] + red[1] + red[2] + red[3];
}

__global__ void k_mod(const float* c, const float* w_ada, const float* b_ada, float* mod) {
    int j = blockIdx.x * blockDim.x + threadIdx.x;
    if (j >= 6 * D) return;
    float acc = 0.f;
    for (int k = 0; k < D; ++k) {
        float cv = c[k];
        float s = cv / (1.f + expf(-cv));
        acc += s * w_ada[(size_t)k * 6 * D + j];
    }
    mod[j] = acc + b_ada[j];
}

__global__ void k_norm_mod(const float* x, const float* g, const float* sc, const float* sh, float* h) {
    __shared__ float red[4];
    int row = blockIdx.x;
    const float* xr = x + (size_t)row * D;
    float v[8]; float ss = 0.f;
#pragma unroll
    for (int i = 0; i < 8; ++i) { v[i] = xr[threadIdx.x + 256 * i]; ss += v[i] * v[i]; }
    float tot = block_sum256(ss, red);
    float r = rsqrtf(tot / D + EPS);
#pragma unroll
    for (int i = 0; i < 8; ++i) { int cidx = threadIdx.x + 256 * i; h[(size_t)row * D + cidx] = v[i] * r * g[cidx] * (1.f + sc[cidx]) + sh[cidx]; }
}

__global__ void k_gemm(const float* A, const float* B, float* C, int M, int N, int K) {
    __shared__ float As[16][64 + 1];
    __shared__ float Bs[16][64 + 1];
    int tx = threadIdx.x & 15, ty = threadIdx.x >> 4;
    int m0 = blockIdx.y * 64, n0 = blockIdx.x * 64;
    float acc[4][4] = {};
    for (int k0 = 0; k0 < K; k0 += 16) {
#pragma unroll
        for (int i = 0; i < 4; ++i) { int e = threadIdx.x + 256 * i; int r = e >> 4, kk = e & 15; As[kk][r] = A[(size_t)(m0 + r) * K + k0 + kk]; }
#pragma unroll
        for (int i = 0; i < 4; ++i) { int e = threadIdx.x + 256 * i; int kk = e >> 6, cc = e & 63; Bs[kk][cc] = B[(size_t)(k0 + kk) * N + n0 + cc]; }
        __syncthreads();
#pragma unroll
        for (int kk = 0; kk < 16; ++kk) {
            float a[4], b[4];
#pragma unroll
            for (int i = 0; i < 4; ++i) { a[i] = As[kk][ty * 4 + i]; b[i] = Bs[kk][tx * 4 + i]; }
#pragma unroll
            for (int i = 0; i < 4; ++i)
#pragma unroll
                for (int j = 0; j < 4; ++j) acc[i][j] += a[i] * b[j];
        }
        __syncthreads();
    }
#pragma unroll
    for (int i = 0; i < 4; ++i)
#pragma unroll
        for (int j = 0; j < 4; ++j) C[(size_t)(m0 + ty * 4 + i) * N + n0 + tx * 4 + j] = acc[i][j];
}

__global__ void k_attn(const float* proj, const float* lq1, const float* lk1, const float* lq2, const float* lk2, const float* g_subln, float* y) {
    __shared__ float qs[4][128];
    int wave = threadIdx.x >> 6, lane = threadIdx.x & 63;
    int gid = blockIdx.x * 4 + wave;
    int h = gid / S, qpos = gid % S;
    float d1 = wave_sum(lq1[lane] * lk1[lane]);
    float d2 = wave_sum(lq2[lane] * lk2[lane]);
    float lam = expf(d1) - expf(d2) + LAMBDA_INIT;
    float slope = exp2f(-(float)(h + 1));
    const float* qrow = proj + (size_t)qpos * INC + h * 128;
    qs[wave][lane] = qrow[lane]; qs[wave][64 + lane] = qrow[64 + lane];
    __syncthreads();
    float res0 = 0.f, res1 = 0.f;
    for (int m = 0; m < 2; ++m) {
        float mx = -INFINITY, l = 0.f, o0 = 0.f, o1 = 0.f;
        for (int kb = 0; kb <= qpos; kb += 64) {
            int kpos = kb + lane;
            float sdot = -INFINITY;
            if (kpos <= qpos) {
                const float4* kr = (const float4*)(proj + (size_t)kpos * INC + AW + h * 128 + m * 64);
                float a = 0.f;
#pragma unroll
                for (int i = 0; i < 16; ++i) { float4 kv = kr[i]; a += kv.x * qs[wave][m * 64 + 4 * i] + kv.y * qs[wave][m * 64 + 4 * i + 1] + kv.z * qs[wave][m * 64 + 4 * i + 2] + kv.w * qs[wave][m * 64 + 4 * i + 3]; }
                sdot = a * 0.125f - slope * (float)(qpos - kpos);
            }
            float cm = wave_max(sdot);
            float mn = fmaxf(mx, cm);
            float alpha = expf(mx - mn);
            float p = (kpos <= qpos) ? expf(sdot - mn) : 0.f;
            l = l * alpha + wave_sum(p);
            o0 *= alpha; o1 *= alpha;
            int nk = min(64, qpos - kb + 1);
            for (int j = 0; j < nk; ++j) {
                float pj = __shfl(p, j);
                const float2* vr = (const float2*)(proj + (size_t)(kb + j) * INC + 2 * AW + h * 128);
                float2 vv = vr[lane];
                o0 += pj * vv.x; o1 += pj * vv.y;
            }
            mx = mn;
        }
        float inv = 1.f / l;
        if (m == 0) { res0 = o0 * inv; res1 = o1 * inv; }
        else { res0 -= lam * o0 * inv; res1 -= lam * o1 * inv; }
    }
    float ss = wave_sum(res0 * res0 + res1 * res1);
    float r = rsqrtf(ss / 128.f + EPS) * (1.f - LAMBDA_INIT);
    float* yr = y + (size_t)qpos * D + h * 128;
    yr[2 * lane] = res0 * r * g_subln[2 * lane];
    yr[2 * lane + 1] = res1 * r * g_subln[2 * lane + 1];
}

__global__ void k_conv(const float* proj, const float* conv_w, const float* conv_b, const float* ln_g, const float* ln_b, float* y) {
    __shared__ float red[4];
    int t = blockIdx.x;
    float acc[4];
#pragma unroll
    for (int i = 0; i < 4; ++i) acc[i] = 0.f;
    for (int j = 0; j < CK; ++j) {
        int tt = t - (CK - 1) + j;
        if (tt < 0) continue;
        const float* pr = proj + (size_t)tt * INC + 3 * AW;
#pragma unroll
        for (int i = 0; i < 4; ++i) {
            int c = threadIdx.x + 256 * i;
            float a = pr[c], gt = pr[CW + c];
            float u = a / (1.f + expf(-gt));
            acc[i] += conv_w[j * CW + c] * u;
        }
    }
    float s = 0.f;
#pragma unroll
    for (int i = 0; i < 4; ++i) { acc[i] += conv_b[threadIdx.x + 256 * i]; s += acc[i]; }
    float mu = block_sum256(s, red) / CW;
    float q = 0.f;
#pragma unroll
    for (int i = 0; i < 4; ++i) { float d = acc[i] - mu; q += d * d; }
    float var = block_sum256(q, red) / CW;
    float r = rsqrtf(var + EPS);
#pragma unroll
    for (int i = 0; i < 4; ++i) {
        int c = threadIdx.x + 256 * i;
        float v = (acc[i] - mu) * r * ln_g[c] + ln_b[c];
        y[(size_t)t * D + AW + c] = v / (1.f + expf(-v));
    }
}

__global__ void k_res_norm(const float* x, const float* mix, const float* g_post, const float* gt, const float* g_pre, const float* sc, const float* sh, float* x1, float* h2) {
    __shared__ float red[4];
    int row = blockIdx.x;
    float v[8], xv[8]; float ss = 0.f;
#pragma unroll
    for (int i = 0; i < 8; ++i) { v[i] = mix[(size_t)row * D + threadIdx.x + 256 * i]; ss += v[i] * v[i]; }
    float r = rsqrtf(block_sum256(ss, red) / D + EPS);
    float s2 = 0.f;
#pragma unroll
    for (int i = 0; i < 8; ++i) { int c = threadIdx.x + 256 * i; xv[i] = x[(size_t)row * D + c] + gt[c] * (v[i] * r * g_post[c]); s2 += xv[i] * xv[i]; x1[(size_t)row * D + c] = xv[i]; }
    float r2 = rsqrtf(block_sum256(s2, red) / D + EPS);
#pragma unroll
    for (int i = 0; i < 8; ++i) { int c = threadIdx.x + 256 * i; h2[(size_t)row * D + c] = xv[i] * r2 * g_pre[c] * (1.f + sc[c]) + sh[c]; }
}

__device__ __forceinline__ void wave_argmax(float v, int i, float& bv, int& bi) {
#pragma unroll
    for (int o = 1; o < 64; o <<= 1) {
        float ov = __shfl_xor(v, o); int oi = __shfl_xor(i, o);
        if (ov > v || (ov == v && oi < i)) { v = ov; i = oi; }
    }
    bv = v; bi = i;
}

__global__ void k_peer_topk(const float* q, const float* k1, const float* k2, int* idx_out, float* g_out) {
    __shared__ float qs[4][256];
    __shared__ float tv[4][2][16];
    __shared__ int ti[4][2][16];
    int wave = threadIdx.x >> 6, lane = threadIdx.x & 63;
    int gid = blockIdx.x * 4 + wave;
    const float* qr = q + (size_t)gid * PKD;
#pragma unroll
    for (int i = 0; i < 4; ++i) qs[wave][lane + 64 * i] = qr[lane + 64 * i];
    __syncthreads();
    for (int half = 0; half < 2; ++half) {
        const float* kk = half ? k2 : k1;
        float s0 = 0.f, s1 = 0.f;
        for (int d = 0; d < 128; ++d) { float qv = qs[wave][half * 128 + d]; s0 += qv * kk[lane * 128 + d]; s1 += qv * kk[(lane + 64) * 128 + d]; }
        for (int r = 0; r < PTOP; ++r) {
            float lv; int li;
            if (s0 >= s1) { lv = s0; li = lane; } else { lv = s1; li = lane + 64; }
            float bv; int bi; wave_argmax(lv, li, bv, bi);
            if (lane == 0) { tv[wave][half][r] = bv; ti[wave][half][r] = bi; }
            if (bi == lane) s0 = -INFINITY;
            if (bi == lane + 64) s1 = -INFINITY;
        }
    }
    __syncthreads();
    float cv[4];
#pragma unroll
    for (int e = 0; e < 4; ++e) { int f = lane * 4 + e; cv[e] = tv[wave][0][f >> 4] + tv[wave][1][f & 15]; }
    float myv = 0.f; int myi = 0; float mx = 0.f, den = 0.f;
    for (int r = 0; r < PTOP; ++r) {
        float lv = cv[0]; int li = lane * 4;
#pragma unroll
        for (int e = 1; e < 4; ++e) if (cv[e] > lv) { lv = cv[e]; li = lane * 4 + e; }
        float bv; int bi; wave_argmax(lv, li, bv, bi);
        if (r == 0) mx = bv;
        den += expf(bv - mx);
        if (r == lane) { myv = bv; myi = bi; }
#pragma unroll
        for (int e = 0; e < 4; ++e) if (bi == lane * 4 + e) cv[e] = -INFINITY;
    }
    if (lane < PTOP) {
        int e = ti[wave][0][myi >> 4] * PK + ti[wave][1][myi & 15];
        idx_out[(size_t)gid * PTOP + lane] = e;
        g_out[(size_t)gid * PTOP + lane] = expf(myv - mx) / den;
    }
}

__global__ void k_peer_ffn(const float* h2, const int* idx, const float* g, const float* u_tab, const float* v_tab, const float* x1, const float* gt, const float* g_post, float* out) {
    __shared__ float hs[D];
    __shared__ float act[128];
    __shared__ int eidx[128];
    __shared__ float red[4];
    int t = blockIdx.x, wave = threadIdx.x >> 6, lane = threadIdx.x & 63;
#pragma unroll
    for (int i = 0; i < 8; ++i) hs[threadIdx.x + 256 * i] = h2[(size_t)t * D + threadIdx.x + 256 * i];
    if (threadIdx.x < 128) eidx[threadIdx.x] = idx[(size_t)t * 128 + threadIdx.x];
    __syncthreads();
    for (int e = wave; e < 128; e += 4) {
        const float* ur = u_tab + (size_t)eidx[e] * D;
        float a = 0.f;
#pragma unroll 8
        for (int i = 0; i < 32; ++i) a += ur[lane + 64 * i] * hs[lane + 64 * i];
        a = wave_sum(a);
        if (lane == 0) { float ge = 0.5f * a * (1.f + erff(a * 0.70710678118654752f)); act[e] = ge * g[(size_t)t * 128 + e]; }
    }
    __syncthreads();
    float o[8];
#pragma unroll
    for (int i = 0; i < 8; ++i) o[i] = 0.f;
    for (int e = 0; e < 128; ++e) {
        const float* vr = v_tab + (size_t)eidx[e] * D;
        float a = act[e];
#pragma unroll
        for (int i = 0; i < 8; ++i) o[i] += a * vr[threadIdx.x + 256 * i];
    }
    float ss = 0.f;
#pragma unroll
    for (int i = 0; i < 8; ++i) ss += o[i] * o[i];
    float r = rsqrtf(block_sum256(ss, red) / D + EPS);
#pragma unroll
    for (int i = 0; i < 8; ++i) { int c = threadIdx.x + 256 * i; out[(size_t)t * D + c] = x1[(size_t)t * D + c] + gt[c] * (o[i] * r * g_post[c]); }
}

extern "C" void kernel_launch(void* const* d_in, const int* in_sizes, int n_in, void* d_out, int out_size, void* d_ws, size_t ws_size, hipStream_t stream) {
    const float* x = (const float*)d_in[0]; const float* c = (const float*)d_in[1]; const float* w_ada = (const float*)d_in[2]; const float* b_ada = (const float*)d_in[3];
    const float* g_pre_mix = (const float*)d_in[4]; const float* g_post_mix = (const float*)d_in[5]; const float* g_pre_ffn = (const float*)d_in[6]; const float* g_post_ffn = (const float*)d_in[7];
    const float* w_in = (const float*)d_in[8]; const float* lq1 = (const float*)d_in[9]; const float* lk1 = (const float*)d_in[10]; const float* lq2 = (const float*)d_in[11]; const float* lk2 = (const float*)d_in[12];
    const float* g_subln = (const float*)d_in[13]; const float* conv_w = (const float*)d_in[14]; const float* conv_b = (const float*)d_in[15]; const float* conv_ln_g = (const float*)d_in[16]; const float* conv_ln_b = (const float*)d_in[17];
    const float* w_out = (const float*)d_in[18]; const float* peer_wq = (const float*)d_in[19]; const float* peer_k1 = (const float*)d_in[20]; const float* peer_k2 = (const float*)d_in[21];
    const float* peer_u = (const float*)d_in[22]; const float* peer_v = (const float*)d_in[23];
    char* ws = (char*)d_ws;
    float* mod = (float*)(ws + WS_MOD); int* idx = (int*)(ws + WS_IDX); float* gg = (float*)(ws + WS_G);
    float* h = (float*)(ws + WS_H); float* proj = (float*)(ws + WS_PROJ); float* y = (float*)(ws + WS_Y); float* mix = (float*)(ws + WS_MIX); float* x1 = (float*)(ws + WS_X1);
    float* h2 = h; float* q = y;
    const float *sh_m = mod, *sc_m = mod + D, *gt_m = mod + 2 * D, *sh_f = mod + 3 * D, *sc_f = mod + 4 * D, *gt_f = mod + 5 * D;
    k_mod<<<6 * D / 256, 256, 0, stream>>>(c, w_ada, b_ada, mod);
    k_norm_mod<<<S, 256, 0, stream>>>(x, g_pre_mix, sc_m, sh_m, h);
    k_gemm<<<dim3(INC / 64, S / 64), 256, 0, stream>>>(h, w_in, proj, S, INC, D);
    k_attn<<<NH * S / 4, 256, 0, stream>>>(proj, lq1, lk1, lq2, lk2, g_subln, y);
    k_conv<<<S, 256, 0, stream>>>(proj, conv_w, conv_b, conv_ln_g, conv_ln_b, y);
    k_gemm<<<dim3(D / 64, S / 64), 256, 0, stream>>>(y, w_out, mix, S, D, D);
    k_res_norm<<<S, 256, 0, stream>>>(x, mix, g_post_mix, gt_m, g_pre_ffn, sc_f, sh_f, x1, h2);
    k_gemm<<<dim3(D / 64, S / 64), 256, 0, stream>>>(h2, peer_wq, q, S, D, D);
    k_peer_topk<<<S * PH / 4, 256, 0, stream>>>(q, peer_k1, peer_k2, idx, gg);
    k_peer_ffn<<<S, 256, 0, stream>>>(h2, idx, gg, peer_u, peer_v, x1, gt_f, g_post_ffn, (float*)d_out);
}
```

```cpp
#include <hip/hip_runtime.h>
#include <cstdio>
#include <cstdint>
#include <cmath>
namespace pg8 {
#define PG8_LAS __attribute__((address_space(3)))
typedef unsigned short bf16_t;
typedef short bf16x8 __attribute__((ext_vector_type(8)));
typedef float f32x4 __attribute__((ext_vector_type(4)));
typedef unsigned u32x4 __attribute__((ext_vector_type(4)));
constexpr int BM = 256, BK = 64, HALF = 128, HTB = HALF * BK * 2  , STAGE_BYTES = 8 * HTB, NXCD = 8, WGM = 8;

__host__ __device__ __forceinline__ int lds_byte(int r, int c) { const int st = (r >> 4) * 2 + (c >> 5), rr = r & 15, cc = c & 31, ob = rr * 64 + cc * 2; return st * 1024 + (ob ^ (((ob >> 9) & 1) << 5)); }
__host__ __device__ __forceinline__ void stage_rc(int b, int& R, int& C) { const int st = b / 1024, sb = b % 1024, swz = sb ^ (((sb >> 9) & 1) << 5); R = (st >> 1) * 16 + swz / 64; C = (st & 1) * 32 + (swz % 64) / 2; }
__host__ __device__ __forceinline__ int perm32(int rho) { const int n = rho >> 4, i = rho & 15; return 8 * (i >> 2) + 4 * n + (i & 3); }

struct Unit { int pm, pn; };
struct Gemm { const bf16_t* A; const bf16_t* Bt; int M, N, K; };

struct StaticOrder {
    int nM, nN, nwg, G, c;
    __host__ __device__ void init(int M, int N, int G_, int c_) { nM = M / BM; nN = N / BM; nwg = nM * nN; G = G_; c = c_; }
    __host__ __device__ bool next(int i, Unit& u) const {
        const long L = (long)i * G + c; if (L >= nwg) return false;
        int wgid = (int)L; { const int q = nwg / NXCD, r = nwg % NXCD, xcd = wgid % NXCD, off = wgid / NXCD; wgid = (xcd < r ? xcd * (q + 1) : r * (q + 1) + (xcd - r) * q) + off; }
        const int nig = WGM * nN, gid = wgid / nig, fm = gid * WGM, gsz = (nM - fm) < WGM ? (nM - fm) : WGM;
        u.pm = fm + ((wgid % nig) % gsz); u.pn = (wgid % nig) / gsz; return true;
    }
    __device__ __forceinline__ void a_ready(const Unit&) const {}
    __device__ __forceinline__ void done(const Unit&) const {}
};

__device__ __forceinline__ unsigned cvt_pk_bf16(float lo, float hi) { unsigned r; asm volatile("v_cvt_pk_bf16_f32 %0, %1, %2" : "=v"(r) : "v"(lo), "v"(hi)); return r; }
typedef float f32x2 __attribute__((ext_vector_type(2)));
__device__ __forceinline__ f32x2 gelu_pk(f32x2 v) {
    const f32x2 av = __builtin_elementwise_abs(v), d = av * 0.2316418882f + 1.0f;
    f32x2 t; t.x = __builtin_amdgcn_rcpf(d.x); t.y = __builtin_amdgcn_rcpf(d.y);
    f32x2 q = t * 0.5307027145f + (-0.7265760135f); q = q * t + 0.7107068705f; q = q * t + (-0.142248368f); q = q * t + 0.127414796f; q = q * t;
    const f32x2 s = (v * v) * (-0.72134752044f);
    f32x2 e; e.x = __builtin_amdgcn_exp2f(s.x); e.y = __builtin_amdgcn_exp2f(s.y);
    const f32x2 m = v * (q * e), r = v - m;
    f32x2 o; o.x = v.x < 0.f ? m.x : r.x; o.y = v.y < 0.f ? m.y : r.y; return o;
}

template <int ACT  > struct EpiBf16 {
    static constexpr bool PERM = true, AFTER_DRAIN = false; static_assert(ACT == 0 || ACT == 1, "EpiBf16: ACT is 0 (none) or 1 (gelu_pk)");
    bf16_t* O; int ldc; const float* bias; int split_cols; size_t split_stride; float scale0;
    __device__ __forceinline__ void operator()(const f32x4 (&acc)[2][2][4][2], const Unit& u, int wr, int wc, int fr, int fq) const {
        const int row0 = u.pm * BM + wr * 64 + fr; int colt = u.pn * BM; bf16_t* base = O;
        float sc = 1.f; if (split_cols) { const int t = colt / split_cols; base += (size_t)t * split_stride; colt -= t * split_cols; if (t == 0) sc = scale0; }
        const int col0 = colt + wc * 32 + 8 * fq, bcol0 = u.pn * BM + wc * 32 + 8 * fq;
        f32x4 bv[2][2];
#pragma unroll
        for (int bj = 0; bj < 2; ++bj)
#pragma unroll
            for (int n = 0; n < 2; ++n) bv[bj][n] = bias ? *(const f32x4*)(bias + bcol0 + bj * HALF + 4 * n) : (f32x4){0.f, 0.f, 0.f, 0.f};
#pragma unroll
        for (int ai = 0; ai < 2; ++ai)
#pragma unroll
            for (int m = 0; m < 4; ++m) { bf16_t* rowp = base + (size_t)(row0 + ai * HALF + m * 16) * ldc + col0;
#pragma unroll
                for (int bj = 0; bj < 2; ++bj) { f32x4 v0 = acc[ai][bj][m][0] + bv[bj][0], v1 = acc[ai][bj][m][1] + bv[bj][1];
                    if (ACT == 1) { f32x2 a = gelu_pk((f32x2){v0[0], v0[1]}), b = gelu_pk((f32x2){v0[2], v0[3]}), c = gelu_pk((f32x2){v1[0], v1[1]}), d = gelu_pk((f32x2){v1[2], v1[3]});
                        v0 = (f32x4){a.x, a.y, b.x, b.y}; v1 = (f32x4){c.x, c.y, d.x, d.y}; }
                    v0 = v0 * sc; v1 = v1 * sc; u32x4 w; w.x = cvt_pk_bf16(v0[0], v0[1]); w.y = cvt_pk_bf16(v0[2], v0[3]); w.z = cvt_pk_bf16(v1[0], v1[1]); w.w = cvt_pk_bf16(v1[2], v1[3]);
                    *(u32x4*)(rowp + bj * HALF) = w; } }
    }
};
template <class Epi, class Sched, bool ALIGN_EPI = false, bool SP2 = false>
__device__ __forceinline__ void gemm_phase(PG8_LAS unsigned char* lds, const Gemm g, const Sched& S, const Epi& E) {
    int tid_ = threadIdx.x; asm volatile("" : "+v"(tid_)); const int tid = tid_, wid = __builtin_amdgcn_readfirstlane(tid >> 6), lane = tid & 63, wr = wid >> 2, wc = wid & 3, fr = lane & 15, fq = lane >> 4;
    const int K = g.K, nt = K / BK;
    unsigned voffA[2], voffB[2];
#pragma unroll
    for (int i = 0; i < 2; ++i) { int R, C; stage_rc(tid * 16 + i * 8192, R, C); const int Rb = Epi::PERM ? ((R & ~31) + perm32(R & 31)) : R;
        voffA[i] = (unsigned)(R * K + C) * 2u; voffB[i] = (unsigned)(Rb * K + C) * 2u; }
    const size_t kstep = (size_t)(BK * 2);
    const size_t hstep = (size_t)HALF * K * 2;
    const size_t tstep = 2 * hstep;
    const unsigned ldsw = (unsigned)wid * 1024u;
    const int aoff = lds_byte(wr * 64 + fr, fq * 8), boff = lds_byte(wc * 32 + fr, fq * 8);
#define PG8_SA(b, h) (((b) * 2 + (h)) * HTB)
#define PG8_SB(b, h) ((4 + (b) * 2 + (h)) * HTB)
#define PG8_STAGE(bufoff, gbase, voff) do { _Pragma("unroll") for (int _i = 0; _i < 2; ++_i) \
        __builtin_amdgcn_global_load_lds((const unsigned*)((const char*)(gbase) + (voff)[_i]), (PG8_LAS unsigned*)(lds + (bufoff) + ldsw + _i * 8192), 16, 0, 0); } while (0)
#define PG8_LDA(dst, b, h) do { _Pragma("unroll") for (int m = 0; m < 4; ++m) _Pragma("unroll") for (int k = 0; k < 2; ++k) dst[m][k] = *(const PG8_LAS bf16x8*)(lds + PG8_SA(b, h) + aoff + m * 2048 + k * 1024); } while (0)
#define PG8_LDB(dst, b, h) do { _Pragma("unroll") for (int n = 0; n < 2; ++n) _Pragma("unroll") for (int k = 0; k < 2; ++k) dst[n][k] = *(const PG8_LAS bf16x8*)(lds + PG8_SB(b, h) + boff + n * 2048 + k * 1024); } while (0)
#define PG8_MMA(ai, bj, At, Bt) do { __builtin_amdgcn_s_setprio(1); _Pragma("unroll") for (int m = 0; m < 4; ++m) _Pragma("unroll") for (int n = 0; n < 2; ++n) _Pragma("unroll") for (int k = 0; k < 2; ++k) \
        acc[ai][bj][m][n] = __builtin_amdgcn_mfma_f32_16x16x32_bf16(Bt[n][k], At[m][k], acc[ai][bj][m][n], 0, 0, 0); __builtin_amdgcn_s_setprio(0); } while (0)
#define PG8_WAIT_V(n) asm volatile("s_waitcnt vmcnt(" #n ")" ::: "memory")
#define PG8_WAIT_L(n) asm volatile("s_waitcnt lgkmcnt(" #n ")" ::: "memory")
#define PG8_BAR __builtin_amdgcn_s_barrier()
#define PG8_SCHED __builtin_amdgcn_sched_barrier(0)
    Unit cur, nxt; int ui = 0;
    if (!S.next(0, cur)) return;
    f32x4 acc[2][2][4][2];
#pragma unroll
    for (int a = 0; a < 2; ++a)
#pragma unroll
        for (int b = 0; b < 2; ++b)
#pragma unroll
            for (int m = 0; m < 4; ++m)
#pragma unroll
                for (int n = 0; n < 2; ++n) acc[a][b][m][n] = (f32x4){0.f, 0.f, 0.f, 0.f};
    bf16x8 At[4][2], B0[2][2], B1[2][2];
    const char* cA = (const char*)g.A + (size_t)cur.pm * tstep; const char* cB = (const char*)g.Bt + (size_t)cur.pn * tstep;
    S.a_ready(cur);
    if constexpr (SP2) {
        PG8_STAGE(PG8_SB(0, 0), cB, voffB); PG8_STAGE(PG8_SB(0, 1), cB + hstep, voffB); PG8_STAGE(PG8_SA(0, 0), cA, voffA); PG8_STAGE(PG8_SA(0, 1), cA + hstep, voffA);
        if (wr == 1) PG8_BAR;
        PG8_WAIT_V(2); PG8_BAR;
        PG8_STAGE(PG8_SB(1, 0), cB + kstep, voffB); PG8_STAGE(PG8_SA(1, 0), cA + kstep, voffA); PG8_STAGE(PG8_SB(1, 1), cB + hstep + kstep, voffB);
        PG8_WAIT_V(6); PG8_BAR;
    } else {
        PG8_STAGE(PG8_SB(0, 0), cB, voffB); PG8_STAGE(PG8_SA(0, 0), cA, voffA); PG8_STAGE(PG8_SB(0, 1), cB + hstep, voffB); PG8_STAGE(PG8_SA(0, 1), cA + hstep, voffA);
        if (wr == 1) PG8_BAR;
        PG8_WAIT_V(4); PG8_BAR;
        PG8_STAGE(PG8_SB(1, 0), cB + kstep, voffB); PG8_STAGE(PG8_SA(1, 0), cA + kstep, voffA); PG8_STAGE(PG8_SB(1, 1), cB + hstep + kstep, voffB);
        PG8_WAIT_V(6); PG8_BAR;
    }
    for (;;) {
        const bool has_next = S.next(ui + 1, nxt);
        const char* nA = has_next ? (const char*)g.A + (size_t)nxt.pm * tstep : cA; const char* nB = has_next ? (const char*)g.Bt + (size_t)nxt.pn * tstep : cB;
        for (int t = 0; t < nt; t += 2) {
            const bool last = (t == nt - 2);
            const char* a1 = cA + (size_t)(t + 1) * kstep;
            const char* a2 = last ? nA : cA + (size_t)(t + 2) * kstep; const char* b2 = last ? nB : cB + (size_t)(t + 2) * kstep;
            const char* a3 = a2 + kstep; const char* b3 = b2 + kstep;
            if (last && has_next) S.a_ready(nxt);
            if constexpr (SP2) {
            PG8_LDB(B0, 0, 0); PG8_LDB(B1, 0, 1); PG8_SCHED; PG8_LDA(At, 0, 0); PG8_STAGE(PG8_SA(1, 1), a1 + hstep, voffA);
            PG8_WAIT_V(8); PG8_WAIT_L(0); PG8_BAR; PG8_MMA(0, 0, At, B0); PG8_MMA(0, 1, At, B1); PG8_BAR; PG8_SCHED;
            PG8_LDA(At, 0, 1); PG8_STAGE(PG8_SB(0, 0), b2, voffB); PG8_STAGE(PG8_SB(0, 1), b2 + hstep, voffB); PG8_STAGE(PG8_SA(0, 0), a2, voffA);
            PG8_WAIT_V(8); PG8_WAIT_L(0); PG8_BAR; PG8_MMA(1, 0, At, B0); PG8_MMA(1, 1, At, B1); PG8_BAR; PG8_SCHED;
            PG8_LDB(B0, 1, 0); PG8_LDB(B1, 1, 1); PG8_SCHED; PG8_LDA(At, 1, 0); PG8_STAGE(PG8_SA(0, 1), a2 + hstep, voffA);
            PG8_WAIT_V(8); PG8_WAIT_L(0); PG8_BAR; PG8_MMA(0, 0, At, B0); PG8_MMA(0, 1, At, B1); PG8_BAR; PG8_SCHED;
            PG8_LDA(At, 1, 1); PG8_STAGE(PG8_SB(1, 0), b3, voffB); PG8_STAGE(PG8_SB(1, 1), b3 + hstep, voffB); PG8_STAGE(PG8_SA(1, 0), a3, voffA);
            PG8_WAIT_V(8); PG8_WAIT_L(0); PG8_BAR; PG8_MMA(1, 0, At, B0); PG8_MMA(1, 1, At, B1); PG8_BAR; PG8_SCHED;
            } else {
            PG8_LDB(B0, 0, 0); PG8_SCHED; PG8_LDA(At, 0, 0); PG8_STAGE(PG8_SA(1, 1), a1 + hstep, voffA);
            PG8_WAIT_L(8); PG8_BAR; PG8_WAIT_L(0); PG8_MMA(0, 0, At, B0); PG8_BAR; PG8_SCHED;
            PG8_LDB(B1, 0, 1); PG8_STAGE(PG8_SB(0, 0), b2, voffB);
            PG8_BAR; PG8_WAIT_L(0); PG8_MMA(0, 1, At, B1); PG8_BAR;
            PG8_LDA(At, 0, 1); PG8_STAGE(PG8_SA(0, 0), a2, voffA);
            PG8_BAR; PG8_WAIT_L(0); PG8_MMA(1, 0, At, B0); PG8_BAR; PG8_SCHED;
            PG8_STAGE(PG8_SB(0, 1), b2 + hstep, voffB);
            PG8_WAIT_V(6); PG8_BAR; PG8_MMA(1, 1, At, B1); PG8_BAR;
            PG8_LDB(B0, 1, 0); PG8_SCHED; PG8_LDA(At, 1, 0); PG8_STAGE(PG8_SA(0, 1), a2 + hstep, voffA);
            PG8_WAIT_L(8); PG8_BAR; PG8_WAIT_L(0); PG8_MMA(0, 0, At, B0); PG8_BAR; PG8_SCHED;
            PG8_LDB(B1, 1, 1); PG8_STAGE(PG8_SB(1, 0), b3, voffB);
            PG8_BAR; PG8_WAIT_L(0); PG8_MMA(0, 1, At, B1); PG8_BAR;
            PG8_LDA(At, 1, 1); PG8_STAGE(PG8_SA(1, 0), a3, voffA);
            PG8_BAR; PG8_WAIT_L(0); PG8_MMA(1, 0, At, B0); PG8_BAR; PG8_SCHED;
            PG8_STAGE(PG8_SB(1, 1), b3 + hstep, voffB);
            PG8_WAIT_V(6); PG8_BAR; PG8_MMA(1, 1, At, B1); PG8_BAR;
            }
        }
        if constexpr (ALIGN_EPI) { if (wr == 0) PG8_BAR; }
        if constexpr (!Epi::AFTER_DRAIN) { E(acc, cur, wr, wc, fr, fq); S.done(cur); }
        if (!has_next) break;
#pragma unroll
        for (int a = 0; a < 2; ++a)
#pragma unroll
            for (int b = 0; b < 2; ++b)
#pragma unroll
                for (int m = 0; m < 4; ++m)
#pragma unroll
                    for (int n = 0; n < 2; ++n) acc[a][b][m][n] = (f32x4){0.f, 0.f, 0.f, 0.f};
        cur = nxt; cA = nA; cB = nB; ++ui;
        if constexpr (ALIGN_EPI) { if (wr == 1) PG8_BAR; }
    }
    PG8_WAIT_V(0);
    if constexpr (!ALIGN_EPI) { if (wr == 0) PG8_BAR; }
    PG8_BAR;
    if constexpr (Epi::AFTER_DRAIN) { E.fused(acc, cur, wr, wc, fr, fq, lds, wid, lane); S.done(cur); }
#undef PG8_SA
#undef PG8_SB
#undef PG8_STAGE
#undef PG8_LDA
#undef PG8_LDB
#undef PG8_MMA
#undef PG8_WAIT_V
#undef PG8_WAIT_L
#undef PG8_BAR
#undef PG8_SCHED
}
}
#define GAS __attribute__((address_space(1)))
#define LAS __attribute__((address_space(3)))
typedef unsigned short bf16;
typedef unsigned v4u __attribute__((ext_vector_type(4)));
typedef float f32x4 __attribute__((ext_vector_type(4)));
typedef short bf16x8 __attribute__((ext_vector_type(8)));
typedef GAS unsigned gu32;
typedef GAS unsigned long long gu64;
#define RLX_AGENT __ATOMIC_RELAXED, __HIP_MEMORY_SCOPE_AGENT
#define LDS_WAIT() asm volatile("s_waitcnt lgkmcnt(0)" ::: "memory")
#define VM_WAIT() asm volatile("s_waitcnt vmcnt(0)" ::: "memory")
__device__ __forceinline__ unsigned long long rt() { return __builtin_amdgcn_s_memrealtime(); }
__device__ __forceinline__ unsigned f2bf(float f) { unsigned u = __builtin_bit_cast(unsigned, f); return (u + 0x7fffu + ((u >> 16) & 1u)) >> 16; }
__device__ __forceinline__ unsigned pk2(float lo, float hi) { return f2bf(lo) | (f2bf(hi) << 16); }

#define XB_TMO      128
#define XB_XCNT(j)  (256  + 64 * (j))
#define XB_XSUB(j)  (1280 + 64 * (j))
#define XB_XGEN(j)  (2304 + 64 * (j))
#define XB_TOP      3328
#define XB_TOPGEN   3392
#define XCD_BAR_WORDS 3456
#define XB_SPIN_CAP (1u << 18)

__device__ __forceinline__ unsigned xb_ld(unsigned* p)              { return __hip_atomic_load(p, __ATOMIC_RELAXED, __HIP_MEMORY_SCOPE_AGENT); }
__device__ __forceinline__ unsigned xb_add(unsigned* p, unsigned v) { return __hip_atomic_fetch_add(p, v, __ATOMIC_RELAXED, __HIP_MEMORY_SCOPE_AGENT); }
__device__ __forceinline__ unsigned xb_xcc_id() { return (unsigned)__builtin_amdgcn_s_getreg((3 << 11) | 20) & 0xFu; }
#define XB_SPIN(cond, bar) do { unsigned _sp = 0; while (cond) { __builtin_amdgcn_s_sleep(1); \
    if ((++_sp & 255u) == 0u) { if (xb_ld(&(bar)[XB_TMO])) break; if (_sp > XB_SPIN_CAP) { atomicAdd(&(bar)[XB_TMO], 1u); break; } } } } while (0)

struct XcdBarrier {
    unsigned* bar; unsigned x;
    volatile LAS unsigned* st;
};

__device__ __forceinline__ XcdBarrier xcd_barrier_post(unsigned* bar, volatile LAS unsigned* st) {
    XcdBarrier b; b.bar = bar; b.x = xb_xcc_id(); b.st = st;
    if (threadIdx.x == 0) (void)xb_add(&bar[XB_XCNT(b.x)], 1u);
    return b;
}
__device__ __forceinline__ void xcd_barrier_complete(unsigned* bar, unsigned x, unsigned& nloc, unsigned& nx) {
    const unsigned G = gridDim.x * gridDim.y * gridDim.z;
    unsigned sum, cnt, mine, sp = 0u;
    for (;;) {
        sum = 0u; cnt = 0u; mine = 0u;
#pragma unroll
        for (unsigned j = 0; j < 16; ++j) { const unsigned c = xb_ld(&bar[XB_XCNT(j)]); sum += c; cnt += (c > 0u) ? 1u : 0u; mine = (j == x) ? c : mine; }
        if (sum == G) break;
        __builtin_amdgcn_s_sleep(1);
        if ((++sp & 255u) == 0u) { if (xb_ld(&bar[XB_TMO])) break; if (sp > XB_SPIN_CAP) { atomicAdd(&bar[XB_TMO], 1u); break; } }
    }
    nloc = mine > 0u ? mine : 1u; nx = cnt > 0u ? cnt : 1u;
}

__device__ __forceinline__ void xcd_barrier(const XcdBarrier& b) {
    asm volatile("s_waitcnt vmcnt(0)" ::: "memory");
    __syncthreads();
    if (threadIdx.x == 0) {
        unsigned* bar = b.bar;
        __builtin_amdgcn_s_waitcnt(0);
        unsigned nloc = b.st[0], nx = b.st[1];
        if (nloc == 0u) { xcd_barrier_complete(bar, b.x, nloc, nx); b.st[0] = nloc; b.st[1] = nx; }
        const unsigned old = xb_add(&bar[XB_XSUB(b.x)], 1u);
        const unsigned gen = old / nloc;
        if (old + 1u == (gen + 1u) * nloc) {
            __builtin_amdgcn_fence(__ATOMIC_RELEASE, "agent");
            asm volatile("s_waitcnt vmcnt(0)" ::: "memory");
            const unsigned og = xb_add(&bar[XB_TOP], 1u);
            const unsigned tg = og / nx;
            if (og + 1u == (tg + 1u) * nx) xb_add(&bar[XB_TOPGEN], 1u);
            else XB_SPIN(xb_ld(&bar[XB_TOPGEN]) == tg, bar);
            __builtin_amdgcn_fence(__ATOMIC_ACQUIRE, "agent");
            xb_add(&bar[XB_XGEN(b.x)], 1u);
            asm volatile("s_waitcnt vmcnt(0)" ::: "memory");
        } else {
            XB_SPIN(xb_ld(&bar[XB_XGEN(b.x)]) == gen, bar);
            __builtin_amdgcn_fence(__ATOMIC_ACQUIRE, "agent");
            asm volatile("s_waitcnt vmcnt(0)" ::: "memory");
        }
    }
    __syncthreads();
}

constexpr int NWAVES = 8, NTHR = 512;
constexpr int D = 2048, S = 8192, AW = 1024, CW = 1024, INC = 5120, NH = 8, DH = 64, CK = 31;
constexpr int PH = 8, PKEYS = 128, PTOP = 16, PKD = 256, NEXP = 16384;
constexpr float EPS = 1e-6f, LAMBDA_INIT = 0.2f;
constexpr float LOG2E = 1.4426950408889634f;
constexpr float C2 = 0.125f * LOG2E;

constexpr size_t MiB = 1u << 20;
constexpr size_t WS_CTL = 0, CTL_ZERO_BYTES = 1 * MiB;
constexpr size_t WS_MOD = 1 * MiB;
constexpr size_t WS_MODP = 2 * MiB;
constexpr size_t WS_IDX = 5 * MiB, WS_GATE = 9 * MiB;
constexpr size_t WS_WIN = 16 * MiB, WS_WOUT = 36 * MiB, WS_WQ = 44 * MiB;
constexpr size_t WS_UB = 52 * MiB, WS_VB = 116 * MiB;
constexpr size_t WS_XN = 180 * MiB;
constexpr size_t WS_PROJ = 212 * MiB;
constexpr size_t WS_MIX = 212 * MiB;
constexpr size_t WS_Y = 292 * MiB;
constexpr size_t WS_QP = 292 * MiB;
constexpr size_t WS_X1 = 324 * MiB;
constexpr size_t WS_END = 388 * MiB;
constexpr int CW_BAR = 4096, CW_PEERQ = 8192;

constexpr int RING_OFF = 0, RING_BYTES = 131072;
constexpr int LDSCTL_OFF = RING_BYTES, MISC_OFF = LDSCTL_OFF + 320, XTRA_OFF = LDSCTL_OFF + 512;
constexpr int LDS_BYTES = 147456;

__device__ __forceinline__ float bf2f(unsigned short b) { return __uint_as_float((unsigned)b << 16); }
__device__ __forceinline__ float bflo(unsigned u) { return __uint_as_float(u << 16); }
__device__ __forceinline__ float bfhi(unsigned u) { return __uint_as_float(u & 0xffff0000u); }
template <int X> __device__ __forceinline__ float swz_xor(float v) { return __int_as_float(__builtin_amdgcn_ds_swizzle(__float_as_int(v), (X << 10) | 0x1f)); }
template <int X> __device__ __forceinline__ int swz_xor_i(int v) { return __builtin_amdgcn_ds_swizzle(v, (X << 10) | 0x1f); }
__device__ __forceinline__ float xor32_f(float v) { auto rr = __builtin_amdgcn_permlane32_swap(__float_as_uint(v), __float_as_uint(v), false, false); return __uint_as_float((threadIdx.x & 32) ? rr[0] : rr[1]); }
__device__ __forceinline__ int xor32_i(int v) { auto rr = __builtin_amdgcn_permlane32_swap((unsigned)v, (unsigned)v, false, false); return (int)((threadIdx.x & 32) ? rr[0] : rr[1]); }
__device__ __forceinline__ float wave_sum(float v) {
    v += swz_xor<1>(v); v += swz_xor<2>(v); v += swz_xor<4>(v); v += swz_xor<8>(v); v += swz_xor<16>(v);
    auto rr = __builtin_amdgcn_permlane32_swap(__float_as_uint(v), __float_as_uint(v), false, false); return __uint_as_float(rr[0]) + __uint_as_float(rr[1]);
}
__device__ __forceinline__ float wave_max(float v) {
    v = fmaxf(v, swz_xor<1>(v)); v = fmaxf(v, swz_xor<2>(v)); v = fmaxf(v, swz_xor<4>(v)); v = fmaxf(v, swz_xor<8>(v)); v = fmaxf(v, swz_xor<16>(v));
    auto rr = __builtin_amdgcn_permlane32_swap(__float_as_uint(v), __float_as_uint(v), false, false); return fmaxf(__uint_as_float(rr[0]), __uint_as_float(rr[1]));
}
__device__ __forceinline__ float silu_f(float v) { return v / (1.f + __expf(-v)); }

struct Args { const float* in[24]; float* out; unsigned char* ws; };

__device__ __forceinline__ void p0_transpose_item(const float* W, int K, int N, bf16* WT, int row_off, LAS float* scr, int item, int lane) {
    const int nblk = N / 32, kb = item / nblk, nb = item % nblk, k0 = 64 * kb, n0 = 32 * nb;
#pragma unroll 8
    for (int i = 0; i < 32; ++i) { const int kk = 2 * i + (lane >> 5); scr[kk * 33 + (lane & 31)] = W[(size_t)(k0 + kk) * N + n0 + (lane & 31)]; }
    LDS_WAIT(); asm volatile("" ::: "memory");
    const int c = lane & 7;
#pragma unroll
    for (int j = 0; j < 4; ++j) { const int n = (lane >> 3) + 8 * j; const LAS float* s = scr + (8 * c) * 33 + n;
        v4u o; o.x = pk2(s[0 * 33], s[1 * 33]); o.y = pk2(s[2 * 33], s[3 * 33]); o.z = pk2(s[4 * 33], s[5 * 33]); o.w = pk2(s[6 * 33], s[7 * 33]);
        *(GAS v4u*)(WT + (size_t)(row_off + n0 + n) * K + k0 + 8 * c) = o; }
    LDS_WAIT(); asm volatile("" ::: "memory");
}
__device__ __forceinline__ void p0_mod_block(const float* c, const float* w_ada, const float* b_ada, float* mod, LAS float* red, int cb, int tid, int wave, int lane) {
    const int slot = lane / 12, q = lane % 12;
    f32x4 acc = (f32x4){0.f, 0.f, 0.f, 0.f};
    if (slot < 5) {
        const float* wp = w_ada + (size_t)(wave * 256) * (6 * D) + cb * 48 + q * 4;
#pragma unroll 4
        for (int i = 0; i < 52; ++i) { const int r = i * 5 + slot;
            if (r < 256) { const float s = silu_f(c[wave * 256 + r]); const f32x4 w = *(const f32x4*)(wp + (size_t)r * (6 * D)); acc += w * s; } }
        *(LAS f32x4*)(red + (wave * 5 + slot) * 48 + q * 4) = acc;
    }
    __syncthreads();
    if (tid < 48) { float s = b_ada[cb * 48 + tid];
#pragma unroll 8
        for (int p = 0; p < 40; ++p) s += red[p * 48 + tid];
        mod[cb * 48 + tid] = s; }
    __syncthreads();
}
__device__ __forceinline__ void p0_cvt_row_fp6(const float* src, unsigned char* dst, float scale, int lane) {
    typedef float f32x16v __attribute__((ext_vector_type(16))); typedef unsigned u32x6 __attribute__((ext_vector_type(6))); typedef unsigned u32x2 __attribute__((ext_vector_type(2)));
    f32x4 v[8];
#pragma unroll
    for (int j = 0; j < 4; ++j) { v[j] = *(const f32x4*)(src + lane * 16 + 4 * j); v[4 + j] = *(const f32x4*)(src + 1024 + lane * 16 + 4 * j); }
    f32x16v a, b;
#pragma unroll
    for (int j = 0; j < 4; ++j) { a[4 * j] = v[j].x * scale; a[4 * j + 1] = v[j].y * scale; a[4 * j + 2] = v[j].z * scale; a[4 * j + 3] = v[j].w * scale;
                                  b[4 * j] = v[4 + j].x * scale; b[4 * j + 1] = v[4 + j].y * scale; b[4 * j + 2] = v[4 + j].z * scale; b[4 * j + 3] = v[4 + j].w * scale; }
    const u32x6 w = __builtin_amdgcn_cvt_scalef32_2xpk16_fp6_f32(a, b, 1.0f);
    asm volatile("" :: "v"(a), "v"(b));
    u32x2* o = (u32x2*)(dst + lane * 24);
    o[0] = (u32x2){w[0], w[1]}; o[1] = (u32x2){w[2], w[3]}; o[2] = (u32x2){w[4], w[5]};
}

__device__ __forceinline__ void convert_tables(const Args& a, int r0, int r1, int cw, int ncw, int lane) {
    for (int r = r0 + cw; r < r1; r += ncw) {
        if (r < NEXP) p0_cvt_row_fp6(a.in[22] + (size_t)r * D, (unsigned char*)(a.ws + WS_UB) + (size_t)r * 1536, 64.f, lane);
        else p0_cvt_row_fp6(a.in[23] + (size_t)(r - NEXP) * D, (unsigned char*)(a.ws + WS_VB) + (size_t)(r - NEXP) * 1536, 16.f, lane);
    }
}
constexpr int CVT_EARLY_ROWS = 0;

__device__ __forceinline__ void phase_p0a(const Args& a, LAS unsigned char* lds, int vcu, int G, int tid, int wave, int lane) {
    const float* c = a.in[1]; const float* w_ada = a.in[2];
    for (int cb = vcu; cb < 6 * D / 48; cb += G) p0_mod_block(c, w_ada, a.in[3], (float*)(a.ws + WS_MOD), (LAS float*)(lds + XTRA_OFF + 64), cb, tid, wave, lane);
    LAS float* scr = (LAS float*)(lds + RING_OFF + wave * 16384);
    const int gw = vcu * NWAVES + wave, NGW = G * NWAVES;
    constexpr int I_WIN = (D / 64) * (INC / 32), I_WOUT = (D / 64) * (D / 32), I_WQ = I_WOUT, I_TAB = NEXP;
    constexpr int NITEMS = I_WIN + I_WOUT + I_WQ;
    for (int it = gw; it < NITEMS; it += NGW) {
        int r = it;
        if (r < I_WIN) { p0_transpose_item(a.in[8], D, INC, (bf16*)(a.ws + WS_WIN), 0, scr, r, lane); continue; } r -= I_WIN;
        if (r < I_WOUT) { p0_transpose_item(a.in[18], D, D, (bf16*)(a.ws + WS_WOUT), 0, scr, r, lane); continue; } r -= I_WOUT;
        p0_transpose_item(a.in[19], D, D, (bf16*)(a.ws + WS_WQ), 0, scr, r, lane);
    }
}

__device__ __forceinline__ void phase_p0b(const Args& a, LAS unsigned char* lds, int vcu, int G, int tid, int wave, int lane) {
    const float* mod = (const float*)(a.ws + WS_MOD); const float* g_pre = a.in[4];
    LAS float* gm = (LAS float*)(lds + RING_OFF); LAS float* sh = gm + D;
#pragma unroll
    for (int i = 0; i < 4; ++i) { const int k = tid + NTHR * i; sh[k] = mod[k]; gm[k] = g_pre[k] * (1.f + mod[D + k]); }
    __syncthreads();
    const float* x = a.in[0]; bf16* XN = (bf16*)(a.ws + WS_XN);
    const int gw = vcu * NWAVES + wave, NGW = G * NWAVES;
    for (int row = gw; row < S; row += NGW) {
        const float* xr = x + (size_t)row * D + lane * 4;
        f32x4 v[8]; float ss = 0.f;
#pragma unroll
        for (int j = 0; j < 8; ++j) { v[j] = *(const f32x4*)(xr + 256 * j); ss += (v[j].x * v[j].x + v[j].y * v[j].y) + (v[j].z * v[j].z + v[j].w * v[j].w); }
        const float r = rsqrtf(wave_sum(ss) * (1.f / D) + EPS);
#pragma unroll
        for (int j = 0; j < 8; ++j) { const f32x4 g4 = *(const LAS f32x4*)(gm + lane * 4 + 256 * j), s4 = *(const LAS f32x4*)(sh + lane * 4 + 256 * j);
            const f32x4 o = v[j] * r * g4 + s4;
            *(unsigned long long*)(XN + (size_t)row * D + lane * 4 + 256 * j) = (unsigned long long)pk2(o.x, o.y) | ((unsigned long long)pk2(o.z, o.w) << 32); }
    }
}

struct EpiF32 {
    static constexpr bool PERM = false, AFTER_DRAIN = false;
    float* O; int ldc;
    __device__ __forceinline__ void operator()(const pg8::f32x4 (&acc)[2][2][4][2], const pg8::Unit& u, int wr, int wc, int fr, int fq) const {
        const int row0 = u.pm * pg8::BM + wr * 64 + fr, col0 = u.pn * pg8::BM + wc * 32 + 4 * fq;
#pragma unroll
        for (int ai = 0; ai < 2; ++ai)
#pragma unroll
            for (int m = 0; m < 4; ++m) { float* rowp = O + (size_t)(row0 + ai * pg8::HALF + m * 16) * ldc + col0;
#pragma unroll
                for (int bj = 0; bj < 2; ++bj)
#pragma unroll
                    for (int n = 0; n < 2; ++n) *(pg8::f32x4*)(rowp + bj * pg8::HALF + n * 16) = acc[ai][bj][m][n]; }
    }
};

__device__ __forceinline__ void phase_attn_simple(const Args& a, LAS unsigned char* lds, int vcu, int G, int wave, int lane) {
    const bf16* proj = (const bf16*)(a.ws + WS_PROJ); bf16* Y = (bf16*)(a.ws + WS_Y);
    const float* g_subln = a.in[13];
    LAS float* qs = (LAS float*)(lds + RING_OFF) + wave * 128;
    const float lam = __expf(wave_sum(a.in[9][lane] * a.in[10][lane])) - __expf(wave_sum(a.in[11][lane] * a.in[12][lane])) + LAMBDA_INIT;
    const int gw = vcu * NWAVES + wave, NGW = G * NWAVES;
    for (int gid = gw; gid < NH * S; gid += NGW) {
        const int h = gid & 7, qpos = gid >> 3;
        const float slope = exp2f(-(float)(h + 1)) * LOG2E;
        const bf16* qrow = proj + (size_t)qpos * INC + h * 128;
        LDS_WAIT(); asm volatile("" ::: "memory");
        qs[lane] = bf2f(qrow[lane]); qs[64 + lane] = bf2f(qrow[64 + lane]);
        LDS_WAIT(); asm volatile("" ::: "memory");
        float res0 = 0.f, res1 = 0.f;
        for (int m = 0; m < 2; ++m) {
            float mx = -INFINITY, l = 0.f, o0 = 0.f, o1 = 0.f;
            for (int kb = 0; kb <= qpos; kb += 64) {
                const int kpos = kb + lane;
                float sdot = -INFINITY;
                if (kpos <= qpos) {
                    const v4u* kr = (const v4u*)(proj + (size_t)kpos * INC + AW + h * 128 + m * 64);
                    float acc = 0.f;
#pragma unroll
                    for (int i = 0; i < 8; ++i) { const v4u kv = kr[i]; const LAS float* qq = qs + m * 64 + 8 * i;
                        acc += bflo(kv.x) * qq[0] + bfhi(kv.x) * qq[1] + bflo(kv.y) * qq[2] + bfhi(kv.y) * qq[3] + bflo(kv.z) * qq[4] + bfhi(kv.z) * qq[5] + bflo(kv.w) * qq[6] + bfhi(kv.w) * qq[7]; }
                    sdot = acc - slope * (float)(qpos - kpos);
                }
                const float mn = fmaxf(mx, wave_max(sdot));
                const float alpha = exp2f(mx - mn);
                const float p = (kpos <= qpos) ? exp2f(sdot - mn) : 0.f;
                l = l * alpha + wave_sum(p);
                o0 *= alpha; o1 *= alpha;
                const int nk = min(64, qpos - kb + 1);
                for (int j = 0; j < nk; ++j) {
                    const float pj = __shfl(p, j);
                    const unsigned vv = *((const unsigned*)(proj + (size_t)(kb + j) * INC + 2 * AW + h * 128) + lane);
                    o0 += pj * bflo(vv); o1 += pj * bfhi(vv);
                }
                mx = mn;
            }
            const float inv = 1.f / l;
            if (m == 0) { res0 = o0 * inv; res1 = o1 * inv; } else { res0 -= lam * o0 * inv; res1 -= lam * o1 * inv; }
        }
        const float ss = wave_sum(res0 * res0 + res1 * res1);
        const float r = rsqrtf(ss * (1.f / 128.f) + EPS) * (1.f - LAMBDA_INIT);
        *((unsigned*)(Y + (size_t)qpos * D + h * 128) + lane) = pk2(res0 * r * g_subln[2 * lane], res1 * r * g_subln[2 * lane + 1]);
    }
}

__device__ __forceinline__ void block_sum2(float& a, float& b, LAS float* red, int wave, int lane) {
    a = wave_sum(a); b = wave_sum(b);
    __syncthreads();
    if (lane == 0) { red[wave] = a; red[8 + wave] = b; }
    __syncthreads();
    float sa = 0.f, sb = 0.f;
#pragma unroll
    for (int i = 0; i < 8; ++i) { sa += red[i]; sb += red[8 + i]; }
    a = sa; b = sb;
}

__device__ __forceinline__ void phase_conv_simple(const Args& a, LAS unsigned char* lds, int vcu, int G, int tid, int wave, int lane) {
    const bf16* proj = (const bf16*)(a.ws + WS_PROJ); bf16* Y = (bf16*)(a.ws + WS_Y);
    const float* conv_w = a.in[14]; const float* conv_b = a.in[15]; const float* ln_g = a.in[16]; const float* ln_b = a.in[17];
    LAS float* red = (LAS float*)(lds + XTRA_OFF);
    const int per = S / G;
    for (int t = vcu * per; t < (vcu + 1) * per; ++t) {
        float acc0 = 0.f, acc1 = 0.f;
        for (int j = 0; j < CK; ++j) {
            const int tt = t - (CK - 1) + j;
            if (tt < 0) continue;
            const unsigned av = *((const unsigned*)(proj + (size_t)tt * INC + 3 * AW) + tid);
            const unsigned gv = *((const unsigned*)(proj + (size_t)tt * INC + 3 * AW + CW) + tid);
            const float u0 = bflo(av) / (1.f + __expf(-bflo(gv))), u1 = bfhi(av) / (1.f + __expf(-bfhi(gv)));
            acc0 += conv_w[j * CW + 2 * tid] * u0; acc1 += conv_w[j * CW + 2 * tid + 1] * u1;
        }
        acc0 += conv_b[2 * tid]; acc1 += conv_b[2 * tid + 1];
        float s1 = acc0 + acc1, s2 = acc0 * acc0 + acc1 * acc1;
        block_sum2(s1, s2, red, wave, lane);
        const float mu = s1 * (1.f / CW), var = fmaxf(s2 * (1.f / CW) - mu * mu, 0.f), r = rsqrtf(var + EPS);
        const float v0 = (acc0 - mu) * r * ln_g[2 * tid] + ln_b[2 * tid], v1 = (acc1 - mu) * r * ln_g[2 * tid + 1] + ln_b[2 * tid + 1];
        *((unsigned*)(Y + (size_t)t * D + AW) + tid) = pk2(silu_f(v0), silu_f(v1));
    }
}

__device__ __forceinline__ void phase_p3b(const Args& a, LAS unsigned char* lds, int vcu, int G, int tid, int wave, int lane) {
    const float* mod = (const float*)(a.ws + WS_MOD);
    LAS float* gA = (LAS float*)(lds + RING_OFF); LAS float* gB = gA + D; LAS float* sB = gB + D;
#pragma unroll
    for (int i = 0; i < 4; ++i) { const int k = tid + NTHR * i; gA[k] = mod[2 * D + k] * a.in[5][k]; gB[k] = a.in[6][k] * (1.f + mod[4 * D + k]); sB[k] = mod[3 * D + k]; }
    __syncthreads();
    const float* x = a.in[0]; const bf16* mix = (const bf16*)(a.ws + WS_MIX); bf16* XN = (bf16*)(a.ws + WS_XN); float* x1o = (float*)(a.ws + WS_X1);
    const int gw = vcu * NWAVES + wave, NGW = G * NWAVES;
    for (int row = gw; row < S; row += NGW) {
        const size_t ro = (size_t)row * D + lane * 4;
        unsigned long long mv[8]; f32x4 xv[8];
#pragma unroll
        for (int j = 0; j < 8; ++j) { mv[j] = *(const unsigned long long*)(mix + ro + 256 * j); xv[j] = *(const f32x4*)(x + ro + 256 * j); }
        f32x4 v[8]; float ss = 0.f;
#pragma unroll
        for (int j = 0; j < 8; ++j) { const unsigned lo = (unsigned)mv[j], hi = (unsigned)(mv[j] >> 32); v[j] = (f32x4){bflo(lo), bfhi(lo), bflo(hi), bfhi(hi)};
            ss += (v[j].x * v[j].x + v[j].y * v[j].y) + (v[j].z * v[j].z + v[j].w * v[j].w); }
        const float r = rsqrtf(wave_sum(ss) * (1.f / D) + EPS);
        float s2 = 0.f;
#pragma unroll
        for (int j = 0; j < 8; ++j) { const f32x4 g4 = *(const LAS f32x4*)(gA + lane * 4 + 256 * j);
            v[j] = xv[j] + v[j] * r * g4; *(f32x4*)(x1o + ro + 256 * j) = v[j]; s2 += (v[j].x * v[j].x + v[j].y * v[j].y) + (v[j].z * v[j].z + v[j].w * v[j].w); }
        const float r2 = rsqrtf(wave_sum(s2) * (1.f / D) + EPS);
#pragma unroll
        for (int j = 0; j < 8; ++j) { const f32x4 g4 = *(const LAS f32x4*)(gB + lane * 4 + 256 * j), s4 = *(const LAS f32x4*)(sB + lane * 4 + 256 * j);
            const f32x4 o = v[j] * r2 * g4 + s4;
            *(unsigned long long*)(XN + ro + 256 * j) = (unsigned long long)pk2(o.x, o.y) | ((unsigned long long)pk2(o.z, o.w) << 32); }
    }
}

#define ARGMAX_STEP(OV, OI) do { const float ov_ = (OV); const int oi_ = (OI); if (ov_ > v || (ov_ == v && oi_ < i)) { v = ov_; i = oi_; } } while (0)
__device__ __forceinline__ void wave_argmax(float v, int i, float& bv, int& bi) {
    ARGMAX_STEP(swz_xor<1>(v), swz_xor_i<1>(i)); ARGMAX_STEP(swz_xor<2>(v), swz_xor_i<2>(i)); ARGMAX_STEP(swz_xor<4>(v), swz_xor_i<4>(i));
    ARGMAX_STEP(swz_xor<8>(v), swz_xor_i<8>(i)); ARGMAX_STEP(swz_xor<16>(v), swz_xor_i<16>(i)); ARGMAX_STEP(xor32_f(v), xor32_i(i));
    bv = v; bi = i;
}
__device__ __forceinline__ void phase_topk_simple(const Args& a, LAS unsigned char* lds, int vcu, int G, int tid, int wave, int lane) {
    LAS float* kt = (LAS float*)(lds + RING_OFF);
    for (int e = tid; e < 2 * PKEYS * 128; e += NTHR) { const int half = e >> 14, key = (e >> 7) & 127, d = e & 127; kt[half * 16384 + d * 128 + key] = a.in[20 + half][key * 128 + d]; }
    LAS float* qs = (LAS float*)(lds + XTRA_OFF + 64) + wave * 256;
    LAS float* tv = (LAS float*)(lds + XTRA_OFF + 64 + 8192) + wave * 32;
    LAS int* ti = (LAS int*)(lds + XTRA_OFF + 64 + 8192 + 1024) + wave * 32;
    __syncthreads();
    const bf16* QP = (const bf16*)(a.ws + WS_QP); int* idx_out = (int*)(a.ws + WS_IDX); float* g_out = (float*)(a.ws + WS_GATE);
    const int gw = vcu * NWAVES + wave, NGW = G * NWAVES;
    for (int gid = gw; gid < S * PH; gid += NGW) {
        const bf16* qr = QP + (size_t)gid * PKD;
        LDS_WAIT(); asm volatile("" ::: "memory");
#pragma unroll
        for (int i = 0; i < 4; ++i) qs[lane + 64 * i] = bf2f(qr[lane + 64 * i]);
        LDS_WAIT(); asm volatile("" ::: "memory");
        for (int half = 0; half < 2; ++half) {
            const LAS float* kk = kt + half * 16384;
            float s0 = 0.f, s1 = 0.f;
#pragma unroll 8
            for (int d = 0; d < 128; ++d) { const float qv = qs[half * 128 + d]; s0 += qv * kk[d * 128 + lane]; s1 += qv * kk[d * 128 + 64 + lane]; }
            for (int r = 0; r < PTOP; ++r) {
                float lv; int li;
                if (s0 >= s1) { lv = s0; li = lane; } else { lv = s1; li = lane + 64; }
                float bv; int bi; wave_argmax(lv, li, bv, bi);
                if (lane == 0) { tv[half * 16 + r] = bv; ti[half * 16 + r] = bi; }
                if (bi == lane) s0 = -INFINITY;
                if (bi == lane + 64) s1 = -INFINITY;
            }
        }
        LDS_WAIT(); asm volatile("" ::: "memory");
        float cv[4];
#pragma unroll
        for (int e = 0; e < 4; ++e) { const int f = lane * 4 + e; cv[e] = tv[f >> 4] + tv[16 + (f & 15)]; }
        float myv = 0.f; int myi = 0; float mx = 0.f, den = 0.f;
        for (int r = 0; r < PTOP; ++r) {
            float lv = cv[0]; int li = lane * 4;
#pragma unroll
            for (int e = 1; e < 4; ++e) if (cv[e] > lv) { lv = cv[e]; li = lane * 4 + e; }
            float bv; int bi; wave_argmax(lv, li, bv, bi);
            if (r == 0) mx = bv;
            den += __expf(bv - mx);
            if (r == lane) { myv = bv; myi = bi; }
#pragma unroll
            for (int e = 0; e < 4; ++e) if (bi == lane * 4 + e) cv[e] = -INFINITY;
        }
        if (lane < PTOP) {
            const int e = ti[myi >> 4] * PKEYS + ti[16 + (myi & 15)];
            idx_out[(size_t)gid * PTOP + lane] = e;
            g_out[(size_t)gid * PTOP + lane] = __expf(myv - mx) / den;
        }
    }
}

__device__ __forceinline__ void phase_peer_simple(const Args& a, LAS unsigned char* lds, int vcu, int G, int tid, int wave, int lane) {
    const float* mod = (const float*)(a.ws + WS_MOD);
    const bf16* XN = (const bf16*)(a.ws + WS_XN); const bf16* Ub = (const bf16*)(a.ws + WS_UB); const bf16* Vb = (const bf16*)(a.ws + WS_VB);
    const int* IDX = (const int*)(a.ws + WS_IDX); const float* GATE = (const float*)(a.ws + WS_GATE);
    LAS float* act = (LAS float*)(lds + RING_OFF); LAS int* eidx = (LAS int*)(lds + RING_OFF + 512); LAS float* red = (LAS float*)(lds + XTRA_OFF);
    const f32x4 gfin = (f32x4){mod[5 * D + 4 * tid] * a.in[7][4 * tid], mod[5 * D + 4 * tid + 1] * a.in[7][4 * tid + 1], mod[5 * D + 4 * tid + 2] * a.in[7][4 * tid + 2], mod[5 * D + 4 * tid + 3] * a.in[7][4 * tid + 3]};
    const int per = S / G;
    for (int t = vcu * per; t < (vcu + 1) * per; ++t) {
        __syncthreads();
        if (tid < 128) eidx[tid] = IDX[(size_t)t * 128 + tid];
        v4u hv[4];
#pragma unroll
        for (int j = 0; j < 4; ++j) hv[j] = *(const v4u*)(XN + (size_t)t * D + lane * 8 + 512 * j);
        __syncthreads();
#pragma unroll 2
        for (int ee = 0; ee < 16; ++ee) {
            const int e = wave * 16 + ee;
            const bf16* ur = Ub + (size_t)eidx[e] * D + lane * 8;
            float acc = 0.f;
#pragma unroll
            for (int j = 0; j < 4; ++j) { const v4u uv = *(const v4u*)(ur + 512 * j);
                acc += bflo(uv.x) * bflo(hv[j].x) + bfhi(uv.x) * bfhi(hv[j].x) + bflo(uv.y) * bflo(hv[j].y) + bfhi(uv.y) * bfhi(hv[j].y)
                     + bflo(uv.z) * bflo(hv[j].z) + bfhi(uv.z) * bfhi(hv[j].z) + bflo(uv.w) * bflo(hv[j].w) + bfhi(uv.w) * bfhi(hv[j].w); }
            acc = wave_sum(acc);
            if (lane == 0) act[e] = 0.5f * acc * (1.f + erff(acc * 0.70710678118654752f)) * GATE[(size_t)t * 128 + e];
        }
        __syncthreads();
        f32x4 o = (f32x4){0.f, 0.f, 0.f, 0.f};
#pragma unroll 8
        for (int e = 0; e < 128; ++e) {
            const unsigned long long vv = *(const unsigned long long*)(Vb + (size_t)eidx[e] * D + 4 * tid);
            const float av = act[e]; const unsigned lo = (unsigned)vv, hi = (unsigned)(vv >> 32);
            o.x += av * bflo(lo); o.y += av * bfhi(lo); o.z += av * bflo(hi); o.w += av * bfhi(hi);
        }
        float ss = (o.x * o.x + o.y * o.y) + (o.z * o.z + o.w * o.w), dummy = 0.f;
        block_sum2(ss, dummy, red, wave, lane);
        const float r = rsqrtf(ss * (1.f / D) + EPS);
        float* op = a.out + (size_t)t * D + 4 * tid;
        const f32x4 x1 = *(const f32x4*)op;
        *(f32x4*)op = x1 + o * r * gfin;
    }
}


namespace att {
using f32x16 = __attribute__((ext_vector_type(16))) float;
using s16x4 = __attribute__((ext_vector_type(4))) short;
typedef __attribute__((address_space(3))) const char* lds_cptr;
constexpr int KSLOT = 16384, NKS = 3, VSLOT = 16384, NVS = 4, KVB = 64, QBR = 128;
constexpr int LDS_KR = 0, LDS_VR = NKS * KSLOT, LDS_O2 = 0, LDS_OST = 65536, LDS_WS = LDS_VR + NVS * VSLOT, LDS_FLAG = LDS_WS + 2048, ATT_LDS_BYTES = LDS_FLAG + 64;
__device__ __forceinline__ int crow(int r, int hi) { return (r & 3) + 8 * (r >> 2) + 4 * hi; }
__device__ __forceinline__ void glds16(const void* gsrc, unsigned lds_dst) { unsigned keep;
    asm volatile("s_mov_b32 %0, m0\n\ts_mov_b32 m0, %2\n\ts_nop 0\n\tglobal_load_lds_dwordx4 %1, off\n\ts_mov_b32 m0, %0" : "=&s"(keep) : "v"(gsrc), "s"(lds_dst) : "memory"); }
#define ATT_WAIT_BAR(N) asm volatile("s_waitcnt vmcnt(" #N ") lgkmcnt(0)\n\ts_barrier" ::: "memory")
typedef float f32x2_t __attribute__((ext_vector_type(2))); typedef __bf16 bf16x2_t __attribute__((ext_vector_type(2)));
__device__ __forceinline__ unsigned cvtpk(float lo, float hi) { f32x2_t v = {lo, hi}; bf16x2_t b = __builtin_convertvector(v, bf16x2_t); return __builtin_bit_cast(unsigned, b); }
__device__ __forceinline__ float swap_max(float m) { auto rr = __builtin_amdgcn_permlane32_swap(__float_as_uint(m), __float_as_uint(m), false, false); return fmaxf(__uint_as_float(rr[0]), __uint_as_float(rr[1])); }
__device__ __forceinline__ float swap_sum(float m) { auto rr = __builtin_amdgcn_permlane32_swap(__float_as_uint(m), __float_as_uint(m), false, false); return __uint_as_float(rr[0]) + __uint_as_float(rr[1]); }
__device__ __forceinline__ float max3a(float a, float b, float c) { float r; asm("v_max3_f32 %0, %1, %2, %3" : "=v"(r) : "v"(a), "v"(b), "v"(c)); return r; }
#define ATT_VRD(dst, off) asm volatile("ds_read_b64_tr_b16 %0, %1 offset:%c2" : "=v"(dst) : "v"(vaddr), "i"(off) : "memory")
#define ATT_VF(i) (bf16x8){vlo[i][0], vlo[i][1], vlo[i][2], vlo[i][3], vhi[i][0], vhi[i][1], vhi[i][2], vhi[i][3]}

struct UnitCtx {
    const bf16* ksrc; const bf16* vsrc; unsigned kdst, vdst; unsigned lds0; lds_cptr shm3;
    int NT, q0, wq, m, r32, hi, lane, qrow; float ch;
};
#define ATT_DMA(t, ko_, vo_) do { const size_t ro_ = (size_t)(t) * KVB * INC; \
        glds16(c.ksrc + ro_, (unsigned)__builtin_amdgcn_readfirstlane(c.kdst + (ko_))); glds16(c.ksrc + ro_ + (size_t)32 * INC, (unsigned)__builtin_amdgcn_readfirstlane(c.kdst + (ko_) + 8192)); \
        glds16(c.vsrc + ro_, (unsigned)__builtin_amdgcn_readfirstlane(c.vdst + (vo_))); glds16(c.vsrc + ro_ + 64, (unsigned)__builtin_amdgcn_readfirstlane(c.vdst + (vo_) + 8192)); } while (0)

__device__ __forceinline__ void qk_tile(const UnitCtx& c, const bf16x8 (&qr)[4], float m0, int t, int ko, f32x16& p0, f32x16& p1) {
    const int hi = c.hi;
    const float tm = c.ch * (float)(t * KVB + 4 * hi - c.qrow) - m0, c32 = c.ch * 32.f;
#pragma unroll
    for (int r = 0; r < 16; ++r) { p0[r] = c.ch * (float)((r & 3) + 8 * (r >> 2)) + tm; p1[r] = p0[r] + c32; }
    const lds_cptr kp = c.shm3 + LDS_KR + ko + c.r32 * 256;
    bf16x8 ka[4], kb[4];
#pragma unroll
    for (int d0 = 0; d0 < 4; ++d0) { const int off = (((8 * c.m + hi + 2 * d0) ^ (c.r32 & 15)) * 16);
        ka[d0] = *(const __attribute__((address_space(3))) bf16x8*)(kp + off); kb[d0] = *(const __attribute__((address_space(3))) bf16x8*)(kp + off + 8192); }
    asm volatile("" : "+v"(ka[0]), "+v"(ka[1]), "+v"(ka[2]), "+v"(ka[3]), "+v"(kb[0]), "+v"(kb[1]), "+v"(kb[2]), "+v"(kb[3]));
#pragma unroll
    for (int d0 = 0; d0 < 4; ++d0) p0 = __builtin_amdgcn_mfma_f32_32x32x16_bf16(ka[d0], qr[d0], p0, 0, 0, 0);
#pragma unroll
    for (int d0 = 0; d0 < 4; ++d0) p1 = __builtin_amdgcn_mfma_f32_32x32x16_bf16(kb[d0], qr[d0], p1, 0, 0, 0);
    if (t * KVB + KVB - 1 > c.q0 + 32 * c.wq) {
        const int kb_ = t * KVB + 4 * hi;
#pragma unroll
        for (int r = 0; r < 16; ++r) { const int kv = kb_ + (r & 3) + 8 * (r >> 2); if (kv > c.qrow) p0[r] = -INFINITY; if (kv + 32 > c.qrow) p1[r] = -INFINITY; }
    }
}
__device__ __forceinline__ void exp_half(f32x16& p, float& sa, float& sb, v4u& wA, v4u& wB) {
#pragma unroll
    for (int r = 0; r < 16; r += 2) { p[r] = __builtin_amdgcn_exp2f(p[r]); p[r + 1] = __builtin_amdgcn_exp2f(p[r + 1]); sa += p[r]; sb += p[r + 1]; }
    wA = (v4u){cvtpk(p[0], p[1]), cvtpk(p[2], p[3]), cvtpk(p[4], p[5]), cvtpk(p[6], p[7])};
    wB = (v4u){cvtpk(p[8], p[9]), cvtpk(p[10], p[11]), cvtpk(p[12], p[13]), cvtpk(p[14], p[15])};
}
template <int H> __device__ __forceinline__ void pv_half(unsigned vaddr, const v4u& wA, const v4u& wB, f32x16 (&o)[4]) {
    s16x4 vlo[8], vhi[8];
#pragma unroll
    for (int d0 = 0; d0 < 4; ++d0) { ATT_VRD(vlo[d0], d0 * 4096 + H * 2048); ATT_VRD(vhi[d0], d0 * 4096 + H * 2048 + 512); }
#pragma unroll
    for (int d0 = 0; d0 < 4; ++d0) { ATT_VRD(vlo[4 + d0], d0 * 4096 + H * 2048 + 1024); ATT_VRD(vhi[4 + d0], d0 * 4096 + H * 2048 + 1024 + 512); }
    asm volatile("s_waitcnt lgkmcnt(8)" ::: "memory"); __builtin_amdgcn_sched_barrier(0);
#pragma unroll
    for (int d0 = 0; d0 < 4; ++d0) o[d0] = __builtin_amdgcn_mfma_f32_32x32x16_bf16(__builtin_bit_cast(bf16x8, wA), ATT_VF(d0), o[d0], 0, 0, 0);
    asm volatile("s_waitcnt lgkmcnt(0)" ::: "memory"); __builtin_amdgcn_sched_barrier(0);
#pragma unroll
    for (int d0 = 0; d0 < 4; ++d0) o[d0] = __builtin_amdgcn_mfma_f32_32x32x16_bf16(__builtin_bit_cast(bf16x8, wB), ATT_VF(4 + d0), o[d0], 0, 0, 0);
    __builtin_amdgcn_sched_barrier(0);
}

template <int MODE, bool STAG>
__device__ __forceinline__ void sweep(const UnitCtx& c, const bf16x8 (&qr)[4], float m0, f32x16 (&o)[4], float& lsum, float& rmax) {
    const int NT = c.NT;
    ATT_DMA(0, 0, 0); ATT_DMA(1, KSLOT, VSLOT);
    const unsigned vbase = c.lds0 + LDS_VR + ((c.lane >> 4) & 1) * 32 + (c.lane & 3) * 8 + (4 * c.hi + ((c.lane & 15) >> 2)) * 64;
    int ko = 0, vo = 0;
    v4u pw0 = (v4u){0u, 0u, 0u, 0u}, pw1 = pw0, pw2 = pw0, pw3 = pw0;
    unsigned vprev = vbase;
    for (int t = 0; t < NT; ++t) {
        if (t + 1 < NT) ATT_WAIT_BAR(4); else ATT_WAIT_BAR(0);
        { const int t2 = t + 2; if (t2 < NT) { int k2 = ko + 2 * KSLOT; if (k2 >= NKS * KSLOT) k2 -= NKS * KSLOT; int v2 = vo + 2 * VSLOT; if (v2 >= NVS * VSLOT) v2 -= NVS * VSLOT; ATT_DMA(t2, k2, v2); } }
        f32x16 p0, p1;
        if constexpr (MODE == 1) {
            qk_tile(c, qr, m0, t, ko, p0, p1);
            float a = max3a(p0[0], p0[1], p1[0]), b = max3a(p0[2], p0[3], p1[1]); a = max3a(a, p1[2], p1[3]);
#pragma unroll
            for (int r = 4; r < 16; r += 4) { a = max3a(a, p0[r], p0[r + 1]); b = max3a(b, p0[r + 2], p0[r + 3]); a = max3a(a, p1[r], p1[r + 1]); b = max3a(b, p1[r + 2], p1[r + 3]); }
            rmax = max3a(rmax, a, b);
        } else if constexpr (!STAG) {
            qk_tile(c, qr, m0, t, ko, p0, p1);
            const unsigned vaddr = vbase + (unsigned)vo;
            float sa = 0.f, sb = 0.f;
            exp_half(p0, sa, sb, pw0, pw1);
            {
                s16x4 vlo[8], vhi[8];
#pragma unroll
                for (int d0 = 0; d0 < 4; ++d0) { ATT_VRD(vlo[d0], d0 * 4096); ATT_VRD(vhi[d0], d0 * 4096 + 512); }
#pragma unroll
                for (int d0 = 0; d0 < 4; ++d0) { ATT_VRD(vlo[4 + d0], d0 * 4096 + 1024); ATT_VRD(vhi[4 + d0], d0 * 4096 + 1024 + 512); }
                asm volatile("s_waitcnt lgkmcnt(8)" ::: "memory"); __builtin_amdgcn_sched_barrier(0);
#pragma unroll
                for (int d0 = 0; d0 < 4; ++d0) o[d0] = __builtin_amdgcn_mfma_f32_32x32x16_bf16(__builtin_bit_cast(bf16x8, pw0), ATT_VF(d0), o[d0], 0, 0, 0);
                exp_half(p1, sa, sb, pw2, pw3);
                asm volatile("s_waitcnt lgkmcnt(0)" ::: "memory"); __builtin_amdgcn_sched_barrier(0);
#pragma unroll
                for (int d0 = 0; d0 < 4; ++d0) o[d0] = __builtin_amdgcn_mfma_f32_32x32x16_bf16(__builtin_bit_cast(bf16x8, pw1), ATT_VF(4 + d0), o[d0], 0, 0, 0);
                __builtin_amdgcn_sched_barrier(0);
            }
            lsum += sa + sb;
            pv_half<1>(vaddr, pw2, pw3, o);
        } else {
            if (t > 0) { pv_half<0>(vprev, pw0, pw1, o); pv_half<1>(vprev, pw2, pw3, o); }
            qk_tile(c, qr, m0, t, ko, p0, p1);
            float sa = 0.f, sb = 0.f;
            exp_half(p0, sa, sb, pw0, pw1);
            exp_half(p1, sa, sb, pw2, pw3);
            lsum += sa + sb;
            vprev = vbase + (unsigned)vo;
        }
        ko += KSLOT; if (ko >= NKS * KSLOT) ko = 0;
        vo += VSLOT; if (vo >= NVS * VSLOT) vo = 0;
    }
    if constexpr (MODE == 0 && STAG) { pv_half<0>(vprev, pw0, pw1, o); pv_half<1>(vprev, pw2, pw3, o); }
}

__device__ __forceinline__ void attn_unit(int h, int qb, const bf16* PROJ, bf16* Y, const float* g_subln, float lam, LAS unsigned char* shm) {
    int tid_ = threadIdx.x; asm volatile("" : "+v"(tid_)); const int tid = tid_, lane = tid & 63, r32 = lane & 31, hi = lane >> 5; const int w = __builtin_amdgcn_readfirstlane(tid >> 6);
    UnitCtx c;
    c.m = w >> 2; c.wq = w & 3; c.q0 = qb * QBR; c.r32 = r32; c.hi = hi; c.lane = lane;
    c.lds0 = (unsigned)(uintptr_t)shm; c.shm3 = (lds_cptr)shm;
    LAS float* wsf = (LAS float*)(shm + LDS_WS) + w * 64;
    LAS int* flags = (LAS int*)(shm + LDS_FLAG);
    c.ksrc = PROJ + AW + h * 128 + (size_t)(4 * w + (lane >> 4)) * INC + (((lane & 15) ^ ((4 * w + (lane >> 4)) & 15)) * 8);
    c.vsrc = PROJ + 2 * AW + h * 128 + (size_t)(16 * (w & 3) + (lane >> 2)) * INC + (w >> 2) * 32 + (lane & 3) * 8;
    c.kdst = c.lds0 + LDS_KR + w * 1024; c.vdst = c.lds0 + LDS_VR + w * 1024;
    c.NT = c.q0 / KVB + 2;
    c.qrow = c.q0 + 32 * c.wq + r32;
    c.ch = exp2f(-(float)(h + 1)) * LOG2E;
    bf16x8 qr[4];
    { const bf16* Qw = PROJ + (size_t)c.qrow * INC + h * 128 + c.m * 64 + hi * 8;
#pragma unroll
      for (int d0 = 0; d0 < 4; ++d0) qr[d0] = *(const bf16x8*)(Qw + d0 * 16); }
    asm volatile("" : "+v"(qr[0]), "+v"(qr[1]), "+v"(qr[2]), "+v"(qr[3]));
    f32x16 o[4]; float lsum, m0 = 0.f;
#pragma unroll 1
    for (int pass = 0; ; ++pass) {
#pragma unroll
        for (int d = 0; d < 4; ++d) o[d] = f32x16{};
        lsum = 0.f; float dummy = 0.f;
        if (c.m == 0) sweep<0, false>(c, qr, m0, o, lsum, dummy); else sweep<0, true>(c, qr, m0, o, lsum, dummy);
        lsum = swap_sum(lsum);
        const bool bad = !(lsum > 0.f) || !(lsum < 3.0e38f);
        if (lane == 0) flags[w] = 0;
        if (bad) flags[w] = 1;
        ATT_WAIT_BAR(0);
        int anybad = 0;
#pragma unroll
        for (int i = 0; i < 8; ++i) anybad |= flags[i];
        if (anybad == 0 || pass >= 1) break;
        float rmax = -INFINITY;
        ATT_WAIT_BAR(0);
        sweep<1, false>(c, qr, 0.f, o, lsum, rmax);
        m0 = swap_max(rmax);
        ATT_WAIT_BAR(0);
    }
    if (hi == 0) wsf[32 + r32] = 1.f / lsum;
    asm volatile("s_waitcnt lgkmcnt(0)" ::: "memory");
    { const f32x4 fa = *(const LAS f32x4*)(wsf + 32 + 4 * hi), fb = *(const LAS f32x4*)(wsf + 40 + 4 * hi), fc = *(const LAS f32x4*)(wsf + 48 + 4 * hi), fd = *(const LAS f32x4*)(wsf + 56 + 4 * hi);
      const f32x16 fv = (f32x16){fa.x, fa.y, fa.z, fa.w, fb.x, fb.y, fb.z, fb.w, fc.x, fc.y, fc.z, fc.w, fd.x, fd.y, fd.z, fd.w};
#pragma unroll
      for (int d = 0; d < 4; ++d) o[d] = o[d] * fv; }
    LAS float* o2 = (LAS float*)(shm + LDS_O2) + c.wq * 4096 + lane;
    if (c.m == 1) {
#pragma unroll
        for (int d = 0; d < 4; ++d)
#pragma unroll
            for (int r = 0; r < 16; ++r) o2[(d * 16 + r) * 64] = o[d][r];
    }
    ATT_WAIT_BAR(0);
    if (c.m == 0) {
        float ssq[16];
#pragma unroll
        for (int r = 0; r < 16; ++r) ssq[r] = 0.f;
#pragma unroll
        for (int d = 0; d < 4; ++d)
#pragma unroll
            for (int r = 0; r < 16; ++r) { const float v = o[d][r] - lam * o2[(d * 16 + r) * 64]; o[d][r] = v; ssq[r] += v * v; }
#pragma unroll
        for (int r = 0; r < 16; ++r) {
            float s = ssq[r];
            s += swz_xor<1>(s); s += swz_xor<2>(s); s += swz_xor<4>(s); s += swz_xor<8>(s); s += swz_xor<16>(s);
            ssq[r] = rsqrtf(s * (1.f / 128.f) + EPS) * (1.f - LAMBDA_INIT);
        }
        LAS bf16* stg = (LAS bf16*)(shm + LDS_OST) + c.wq * 4096;
#pragma unroll
        for (int d = 0; d < 4; ++d) { const float gd = g_subln[d * 32 + r32];
#pragma unroll
            for (int r = 0; r < 16; ++r) stg[crow(r, hi) * 128 + d * 32 + r32] = (bf16)f2bf(o[d][r] * ssq[r] * gd); }
        asm volatile("s_waitcnt lgkmcnt(0)" ::: "memory");
        bf16* Yw = Y + (size_t)(c.q0 + 32 * c.wq) * D + h * 128;
#pragma unroll
        for (int i = 0; i < 8; ++i) { const int row = i * 4 + (lane >> 4), chn = lane & 15; const v4u v = *(const LAS v4u*)(stg + row * 128 + chn * 8); *(v4u*)(Yw + (size_t)row * D + chn * 8) = v; }
    }
    ATT_WAIT_BAR(0);
}

__device__ __forceinline__ void attn_phase(const Args& a, LAS unsigned char* lds, int vcu, int G, int lane) {
    const bf16* PROJ = (const bf16*)(a.ws + WS_PROJ); bf16* Y = (bf16*)(a.ws + WS_Y);
    const float lam = __expf(wave_sum(a.in[9][lane] * a.in[10][lane])) - __expf(wave_sum(a.in[11][lane] * a.in[12][lane])) + LAMBDA_INIT;
    for (int u = vcu; u < NH * 32; u += G) {
        const int h = u >> 5, s = u & 31;
#pragma unroll 1
        for (int k = 0; k < 2; ++k) attn_unit(h, k == 0 ? 63 - s : s, PROJ, Y, a.in[13], lam, lds);
    }
}
#undef ATT_VRD
#undef ATT_VF
#undef ATT_DMA
}

namespace peer {
typedef int i32x16 __attribute__((ext_vector_type(16)));
typedef float f32x16s __attribute__((ext_vector_type(16)));
typedef float f32x2 __attribute__((ext_vector_type(2)));
typedef unsigned u32x6 __attribute__((ext_vector_type(6)));
typedef float f32x32 __attribute__((ext_vector_type(32)));
typedef float f32x16v __attribute__((ext_vector_type(16)));
constexpr int ROWB = 1536;
constexpr float U_SCALE = 64.f, V_SCALE = 16.f;
template <int N> __device__ __forceinline__ float dpp_ror(float v) { return __int_as_float(__builtin_amdgcn_update_dpp(0, __float_as_int(v), 0x120 + N, 0xf, 0xf, false)); }
__device__ __forceinline__ void dma_row(const char* rowbase, unsigned lds_dst, unsigned voff) {
    unsigned keep; unsigned long long ex; const unsigned v1 = voff + 1024u;
    asm volatile("s_nop 4\n\ts_mov_b32 %0, m0\n\ts_mov_b32 m0, %3\n\ts_nop 0\n\tglobal_load_lds_dwordx4 %4, %2\n\t"
                 "s_add_u32 m0, m0, 0x400\n\ts_mov_b64 %1, exec\n\ts_mov_b64 exec, 0xffffffff\n\tglobal_load_lds_dwordx4 %5, %2\n\t"
                 "s_mov_b64 exec, %1\n\ts_mov_b32 m0, %0" : "=&s"(keep), "=&s"(ex) : "s"(rowbase), "s"(lds_dst), "v"(voff), "v"(v1) : "memory", "scc");
}
__device__ __forceinline__ void sload16(i32x16& d, const void* p) { asm volatile("s_load_dwordx16 %0, %1, 0x0\n\ts_waitcnt lgkmcnt(0)" : "=&s"(d) : "s"(p) : "memory"); }
__device__ __forceinline__ void sload16x2(i32x16& d0, const void* p0, i32x16& d1, const void* p1) {
    asm volatile("s_load_dwordx16 %0, %2, 0x0\n\ts_load_dwordx16 %1, %3, 0x0\n\ts_waitcnt lgkmcnt(0)" : "=&s"(d0), "=&s"(d1) : "s"(p0), "s"(p1) : "memory"); }
#define PIN16(x, o) asm volatile("" : "+v"(x[o]), "+v"(x[o+1]), "+v"(x[o+2]), "+v"(x[o+3]), "+v"(x[o+4]), "+v"(x[o+5]), "+v"(x[o+6]), "+v"(x[o+7]), "+v"(x[o+8]), "+v"(x[o+9]), "+v"(x[o+10]), "+v"(x[o+11]), "+v"(x[o+12]), "+v"(x[o+13]), "+v"(x[o+14]), "+v"(x[o+15]))
#define PEER_SWAIT() asm volatile("s_waitcnt lgkmcnt(0)" ::: "memory")
#define PEER_VWAIT(N) asm volatile("s_waitcnt vmcnt(" #N ")" ::: "memory")
#define PEER_VWAIT_PF() do { if (PEER_PF == 8) PEER_VWAIT(12); else if (PEER_PF == 6) PEER_VWAIT(8); else if (PEER_PF == 4) PEER_VWAIT(4); else PEER_VWAIT(0); } while (0)
__device__ __forceinline__ f32x32 row32(const LAS unsigned char* slot, int lane) {
    typedef unsigned u32x2 __attribute__((ext_vector_type(2)));
    const LAS u32x2* p = (const LAS u32x2*)(slot + lane * 24);
    const u32x2 d0 = p[0], d1 = p[1], d2 = p[2];
    const u32x6 src = (u32x6){d0.x, d0.y, d1.x, d1.y, d2.x, d2.y};
    const f32x32 f = __builtin_amdgcn_cvt_scalef32_pk32_f32_fp6(src, 1.0f);
    asm volatile("" :: "v"(src));
    return f;
}

__device__ __forceinline__ void phase_peer(const Args& a, LAS unsigned char* lds, int vcu, int G, int tid, int wave, int lane, float* dst) {
    const float* mod = (const float*)(a.ws + WS_MOD);
    const bf16* XN = (const bf16*)(a.ws + WS_XN); const char* Ub = (const char*)(a.ws + WS_UB); const char* Vb = (const char*)(a.ws + WS_VB);
    const int* IDX = (const int*)(a.ws + WS_IDX); const float* GATE = (const float*)(a.ws + WS_GATE);
    LAS float* gfin = (LAS float*)(lds + XTRA_OFF + 64);
#pragma unroll
    for (int i = 0; i < 4; ++i) { const int k = tid + NTHR * i; gfin[k] = mod[5 * D + k] * a.in[7][k]; }
    __syncthreads();
    const int gw = vcu * NWAVES + wave, NGW = G * NWAVES;
    const int ntok = (S - gw + NGW - 1) / NGW;
    if (ntok <= 0) return;
    const int nbb = ntok * 8;
    const unsigned ring = (unsigned)(uintptr_t)(lds + RING_OFF) + (unsigned)wave * 16384u;
    const LAS unsigned char* ringp = lds + RING_OFF + wave * 16384;
    const unsigned voff = (unsigned)lane * 16u;
    i32x16 ic, in_; f32x16s gc;
    sload16(ic, IDX + (size_t)gw * 128);
    in_ = ic;
#define ROWU(v, e) (Ub + (size_t)(unsigned)(v)[e] * ROWB)
#define ROWV(v, e) (Vb + (size_t)(unsigned)(v)[e] * ROWB)
#ifndef PEER_PF
#define PEER_PF 8
#endif
#define SLOT(n) (((n) % PEER_PF) * 2048)
#pragma unroll
    for (int e = 0; e < PEER_PF; ++e) dma_row(ROWU(ic, e), ring + SLOT(e), voff);
    int eo[32];
    {
        f32x16v ta, tb;
#pragma unroll
        for (int i = 0; i < 16; ++i) { ta[i] = 0.125f * (float)i; tb[i] = (i < 8) ? 2.f + 0.25f * (float)i : 4.f + 0.5f * (float)(i - 8); }
        const u32x6 tp = __builtin_amdgcn_cvt_scalef32_2xpk16_fp6_f32(ta, tb, 1.0f);
        asm volatile("" :: "v"(ta), "v"(tb));
        const f32x32 tf = __builtin_amdgcn_cvt_scalef32_pk32_f32_fp6(tp, 1.0f);
        asm volatile("" :: "v"(tp));
#pragma unroll
        for (int p = 0; p < 32; ++p) { const float v = tf[p]; const int i = (v < 2.f) ? (int)(v * 8.f) : (v < 4.f) ? 16 + (int)((v - 2.f) * 4.f) : 24 + (int)((v - 4.f) * 2.f);
            eo[p] = ((i & 16) ? 1024 : 0) + lane * 16 + (i & 15); }
    }
    float hp[32];
    float op[32];
    int tok = gw;
    for (int bb = 0; bb < nbb; ++bb) {
        const int b = bb & 7;
        if (b == 0) {
            tok = gw + (bb >> 3) * NGW;
#pragma unroll
            for (int p = 0; p < 32; ++p) hp[p] = bf2f(XN[(size_t)tok * D + eo[p]]);
            PIN16(hp, 0); PIN16(hp, 16);
#pragma unroll
            for (int p = 0; p < 32; ++p) op[p] = 0.f;
        }
        {
            const int nb = (bb + 1 < nbb) ? bb + 1 : bb;
            const size_t nofs = (size_t)(gw + (nb >> 3) * NGW) * 128 + (nb & 7) * 16;
            i32x16 gtmp;
            sload16x2(gtmp, GATE + (size_t)tok * 128 + b * 16, in_, IDX + nofs);
            gc = __builtin_bit_cast(f32x16s, gtmp);
        }
        float s[16];
#pragma unroll
        for (int st = 0; st < 8; ++st) {
            PEER_VWAIT_PF();
            const f32x32 f0 = row32(ringp + SLOT(2 * st), lane), f1 = row32(ringp + SLOT(2 * st + 1), lane);
            PEER_SWAIT();
            {
                const int e8 = 2 * st + PEER_PF;
                if (e8 < 16) { dma_row(ROWU(ic, e8), ring + SLOT(2 * st), voff); dma_row(ROWU(ic, e8 + 1), ring + SLOT(2 * st + 1), voff); }
                else { dma_row(ROWV(ic, e8 - 16), ring + SLOT(2 * st), voff); dma_row(ROWV(ic, e8 - 15), ring + SLOT(2 * st + 1), voff); }
            }
            float a0 = 0.f, a1 = 0.f, b0 = 0.f, b1 = 0.f;
#pragma unroll
            for (int p = 0; p < 32; p += 2) { a0 += f0[p] * hp[p]; b0 += f0[p + 1] * hp[p + 1]; a1 += f1[p] * hp[p]; b1 += f1[p + 1] * hp[p + 1]; }
            s[2 * st] = a0 + b0; s[2 * st + 1] = a1 + b1;
            asm volatile("" : "+v"(s[2 * st]), "+v"(s[2 * st + 1]));
        }
        float u[4];
        {
            float t8[8];
#pragma unroll
            for (int e = 0; e < 8; ++e) { auto rr = __builtin_amdgcn_permlane32_swap(__float_as_uint(s[e]), __float_as_uint(s[e + 8]), false, false); t8[e] = __uint_as_float(rr[0]) + __uint_as_float(rr[1]); }
#pragma unroll
            for (int e = 0; e < 4; ++e) { auto rr = __builtin_amdgcn_permlane16_swap(__float_as_uint(t8[e]), __float_as_uint(t8[e + 4]), false, false); u[e] = __uint_as_float(rr[0]) + __uint_as_float(rr[1]); }
#pragma unroll
            for (int e = 0; e < 4; ++e) { u[e] += dpp_ror<8>(u[e]); u[e] += dpp_ror<4>(u[e]); u[e] += dpp_ror<2>(u[e]); u[e] += dpp_ror<1>(u[e]); }
        }
        if (b == 7) {
            const float* xp = (const float*)(a.ws + WS_X1) + (size_t)tok * D;
#pragma unroll
            for (int p = 0; p < 32; ++p) hp[p] = xp[eo[p]];
        }
        float actv;
        { const int k = lane & 3; const float d = ((k == 0) ? u[0] : (k == 1) ? u[1] : (k == 2) ? u[2] : u[3]) * (1.f / U_SCALE);
          actv = 0.5f * d * (1.f + erff(d * 0.70710678118654752f)) * (1.f / V_SCALE); }
#pragma unroll
        for (int st = 0; st < 8; ++st) {
            PEER_VWAIT_PF();
            const f32x32 f0 = row32(ringp + SLOT(2 * st), lane), f1 = row32(ringp + SLOT(2 * st + 1), lane);
            PEER_SWAIT();
            {
                const int e8 = 2 * st + PEER_PF;
                if (e8 < 16) { dma_row(ROWV(ic, e8), ring + SLOT(2 * st), voff); dma_row(ROWV(ic, e8 + 1), ring + SLOT(2 * st + 1), voff); }
                else { dma_row(ROWU(in_, e8 - 16), ring + SLOT(2 * st), voff); dma_row(ROWU(in_, e8 - 15), ring + SLOT(2 * st + 1), voff); }
            }
            const int e0 = 2 * st, e1 = 2 * st + 1;
            const float g0 = __int_as_float(__builtin_amdgcn_readlane(__float_as_int(actv), 16 * (e0 >> 2) + (e0 & 3))) * gc[e0], g1 = __int_as_float(__builtin_amdgcn_readlane(__float_as_int(actv), 16 * (e1 >> 2) + (e1 & 3))) * gc[e1];
#pragma unroll
            for (int p = 0; p < 32; ++p) op[p] += g0 * f0[p] + g1 * f1[p];
            PIN16(op, 16);
            PIN16(op, 0);
        }
        ic = in_;
        if (b == 7) {
            float ss = 0.f;
#pragma unroll
            for (int p = 0; p < 32; ++p) ss += op[p] * op[p];
            const float r = rsqrtf(wave_sum(ss) * (1.f / D) + EPS);
            float* dp = dst + (size_t)tok * D;
#pragma unroll
            for (int p = 0; p < 32; ++p) dp[eo[p]] = hp[p] + op[p] * r * gfin[eo[p]];
        }
    }
    PEER_VWAIT(0);
#undef ROWU
#undef ROWV
#undef SLOT
}
#undef PEER_SWAIT
#undef PEER_VWAIT
}

namespace peer2 {
using peer::f32x32; using peer::u32x6; using peer::f32x16v; using peer::ROWB; using peer::U_SCALE; using peer::V_SCALE; using peer::row32; using peer::dpp_ror;
constexpr int NSLOT = 8, DOTS_OFF = NSLOT * ROWB, DUMMY = 512;
#define P2_VWAIT(N) asm volatile("s_waitcnt vmcnt(" #N ")" ::: "memory")
#define P2_SWAIT() asm volatile("s_waitcnt lgkmcnt(0)" ::: "memory")
__device__ __forceinline__ void dma_row(const char* rowbase, unsigned lds_dst, unsigned voff) {
    unsigned keep; unsigned long long ex; const unsigned v1 = voff + 1024u;
    asm volatile("s_nop 4\n\ts_mov_b32 %0, m0\n\ts_mov_b32 m0, %3\n\ts_nop 0\n\tglobal_load_lds_dwordx4 %4, %2\n\t"
                 "s_add_u32 m0, m0, 0x400\n\ts_mov_b64 %1, exec\n\ts_mov_b32 exec_hi, 0\n\tglobal_load_lds_dwordx4 %5, %2\n\t"
                 "s_mov_b64 exec, %1\n\ts_mov_b32 m0, %0" : "=&s"(keep), "=&s"(ex) : "s"(rowbase), "s"(lds_dst), "v"(voff), "v"(v1) : "memory", "scc");
}
__device__ __forceinline__ void wait_rows(int n) {
    if (n >= 7) P2_VWAIT(14); else if (n == 6) P2_VWAIT(12); else if (n == 5) P2_VWAIT(10); else if (n == 4) P2_VWAIT(8);
    else if (n == 3) P2_VWAIT(6); else if (n == 2) P2_VWAIT(4); else if (n == 1) P2_VWAIT(2); else P2_VWAIT(0);
}
__device__ __forceinline__ int pop_slot(unsigned long long& m0, unsigned long long& m1) {
    if (m0) { const int b = __builtin_ctzll(m0); m0 &= m0 - 1; return b; }
    const int b = __builtin_ctzll(m1); m1 &= m1 - 1; return 64 + b;
}
__device__ __forceinline__ int idx_of(int slot, int i0, int i1) { return __builtin_amdgcn_readlane(slot < 64 ? i0 : i1, slot & 63); }

__device__ __forceinline__ void calibrate(int (&eo)[32], int lane, float zero) {
    f32x16v ta, tb;
#pragma unroll
    for (int i = 0; i < 16; ++i) { ta[i] = 0.125f * (float)i + zero; tb[i] = ((i < 8) ? 2.f + 0.25f * (float)i : 4.f + 0.5f * (float)(i - 8)) + zero; }
    const u32x6 tp = __builtin_amdgcn_cvt_scalef32_2xpk16_fp6_f32(ta, tb, 1.0f);
    asm volatile("" :: "v"(ta), "v"(tb));
    const f32x32 tf = __builtin_amdgcn_cvt_scalef32_pk32_f32_fp6(tp, 1.0f);
    asm volatile("" :: "v"(tp));
#pragma unroll
    for (int p = 0; p < 32; ++p) { const float v = tf[p]; const int i = (v < 2.f) ? (int)(v * 8.f) : (v < 4.f) ? 16 + (int)((v - 2.f) * 4.f) : 24 + (int)((v - 4.f) * 2.f);
        eo[p] = ((i & 16) ? 1024 : 0) + lane * 16 + (i & 15); }
}

template <int PASS>
__device__ __forceinline__ void task(const char* tab, int sl, int i0, int i1, float (&x)[32]  , float c0, float c1, LAS float* dotsw, int dbase,
                                     unsigned ring, const LAS unsigned char* ringp, unsigned voff, int lane) {
    unsigned long long m0 = __ballot((i0 >> 11) == sl), m1 = __ballot((i1 >> 11) == sl);
    const int n = __builtin_popcountll(m0) + __builtin_popcountll(m1);
    if (n == 0) return;
    unsigned long long p0 = m0, p1 = m1;
    int issued = 0;
#pragma unroll 1
    for (; issued < NSLOT && issued < n; ++issued) { const int s = pop_slot(p0, p1); dma_row(tab + (size_t)(unsigned)idx_of(s, i0, i1) * ROWB, ring + issued * ROWB, voff); }
#pragma unroll 1
    for (int j = 0; j < n; j += 8) {
        float s8[8];
        int myslot = DUMMY + lane;
#pragma unroll
        for (int e = 0; e < 8; ++e) {
            s8[e] = 0.f;
            if (j + e < n) {
                wait_rows(issued - (j + e) - 1);
                const f32x32 f = row32(ringp + e * ROWB, lane);
                P2_SWAIT();
                if (issued < n) { const int s = pop_slot(p0, p1); dma_row(tab + (size_t)(unsigned)idx_of(s, i0, i1) * ROWB, ring + e * ROWB, voff); ++issued; }
                const int slot = pop_slot(m0, m1);
                if (PASS == 0) {
                    float a = 0.f, b = 0.f;
#pragma unroll
                    for (int p = 0; p < 32; p += 2) { a += f[p] * x[p]; b += f[p + 1] * x[p + 1]; }
                    s8[e] = a + b;
                    asm("v_writelane_b32 %0, %1, %2" : "+v"(myslot) : "s"(dbase + slot), "n"(16 * (e >> 1) + (e & 1)));
                } else {
                    const float g = __int_as_float(__builtin_amdgcn_readlane(__float_as_int(slot < 64 ? c0 : c1), slot & 63));
#pragma unroll
                    for (int p = 0; p < 32; ++p) x[p] += g * f[p];
                }
            }
        }
        if (PASS == 0) {
            float t4[4], u[2];
#pragma unroll
            for (int e = 0; e < 4; ++e) { auto rr = __builtin_amdgcn_permlane32_swap(__float_as_uint(s8[e]), __float_as_uint(s8[e + 4]), false, false); t4[e] = __uint_as_float(rr[0]) + __uint_as_float(rr[1]); }
#pragma unroll
            for (int e = 0; e < 2; ++e) { auto rr = __builtin_amdgcn_permlane16_swap(__float_as_uint(t4[e]), __float_as_uint(t4[e + 2]), false, false); u[e] = __uint_as_float(rr[0]) + __uint_as_float(rr[1]); }
#pragma unroll
            for (int e = 0; e < 2; ++e) { u[e] += dpp_ror<8>(u[e]); u[e] += dpp_ror<4>(u[e]); u[e] += dpp_ror<2>(u[e]); u[e] += dpp_ror<1>(u[e]); }
            dotsw[myslot] = (lane & 1) ? u[1] : u[0];
        }
    }
}

__device__ __forceinline__ void phase_peer2(const Args& a, LAS unsigned char* lds, int vcu, int G, int tid, int wave, int lane, unsigned xcc, float* dst) {
    const float* mod = (const float*)(a.ws + WS_MOD);
    const bf16* XN = (const bf16*)(a.ws + WS_XN); const char* Ub = (const char*)(a.ws + WS_UB); const char* Vb = (const char*)(a.ws + WS_VB);
    const int* IDX = (const int*)(a.ws + WS_IDX); const float* GATE = (const float*)(a.ws + WS_GATE); const float* X1 = (const float*)(a.ws + WS_X1);
    LAS float* gfin = (LAS float*)(lds + XTRA_OFF + 64);
#pragma unroll
    for (int i = 0; i < 4; ++i) { const int k = tid + NTHR * i; gfin[k] = mod[5 * D + k] * a.in[7][k]; }
    __syncthreads();
    const int gw = vcu * NWAVES + wave, NGW = G * NWAVES;
    if (gw + 3 * NGW >= S) return;
    const unsigned ring = (unsigned)(uintptr_t)(lds + RING_OFF) + (unsigned)wave * 16384u;
    const LAS unsigned char* ringp = lds + RING_OFF + wave * 16384;
    LAS float* dotsw = (LAS float*)(lds + RING_OFF + wave * 16384 + DOTS_OFF);
    const unsigned voff = (unsigned)lane * 16u;
    int eo[32];
    calibrate(eo, lane, 0.f);
    int i0[4], i1[4]; float c0[4], c1[4];
    float x0[32], x1[32], x2[32], x3[32];
#pragma unroll
    for (int k = 0; k < 4; ++k) { const size_t t = (size_t)(gw + k * NGW); i0[k] = IDX[t * 128 + lane]; i1[k] = IDX[t * 128 + 64 + lane]; c0[k] = 0.f; c1[k] = 0.f; }
#pragma unroll
    for (int p = 0; p < 32; ++p) { x0[p] = bf2f(XN[(size_t)(gw) * D + eo[p]]); x1[p] = bf2f(XN[(size_t)(gw + NGW) * D + eo[p]]);
                                   x2[p] = bf2f(XN[(size_t)(gw + 2 * NGW) * D + eo[p]]); x3[p] = bf2f(XN[(size_t)(gw + 3 * NGW) * D + eo[p]]); }
    asm volatile("s_waitcnt vmcnt(0)" ::: "memory");
#pragma unroll 1
    for (int s = 0; s < 8; ++s) {
        const int sl = (s + (int)xcc) & 7;
        task<0>(Ub, sl, i0[0], i1[0], x0, 0.f, 0.f, dotsw, 0, ring, ringp, voff, lane);
        task<0>(Ub, sl, i0[1], i1[1], x1, 0.f, 0.f, dotsw, 128, ring, ringp, voff, lane);
        task<0>(Ub, sl, i0[2], i1[2], x2, 0.f, 0.f, dotsw, 256, ring, ringp, voff, lane);
        task<0>(Ub, sl, i0[3], i1[3], x3, 0.f, 0.f, dotsw, 384, ring, ringp, voff, lane);
    }
#pragma unroll
    for (int k = 0; k < 4; ++k) { const size_t t = (size_t)(gw + k * NGW);
        const float d0 = dotsw[k * 128 + lane] * (1.f / U_SCALE), d1 = dotsw[k * 128 + 64 + lane] * (1.f / U_SCALE);
        c0[k] = 0.5f * d0 * (1.f + erff(d0 * 0.70710678118654752f)) * GATE[t * 128 + lane] * (1.f / V_SCALE);
        c1[k] = 0.5f * d1 * (1.f + erff(d1 * 0.70710678118654752f)) * GATE[t * 128 + 64 + lane] * (1.f / V_SCALE); }
#pragma unroll
    for (int p = 0; p < 32; ++p) { x0[p] = 0.f; x1[p] = 0.f; x2[p] = 0.f; x3[p] = 0.f; }
    asm volatile("s_waitcnt vmcnt(0)" ::: "memory");
#pragma unroll 1
    for (int s = 0; s < 8; ++s) {
        const int sl = (s + (int)xcc) & 7;
        task<1>(Vb, sl, i0[0], i1[0], x0, c0[0], c1[0], dotsw, 0, ring, ringp, voff, lane);
        task<1>(Vb, sl, i0[1], i1[1], x1, c0[1], c1[1], dotsw, 0, ring, ringp, voff, lane);
        task<1>(Vb, sl, i0[2], i1[2], x2, c0[2], c1[2], dotsw, 0, ring, ringp, voff, lane);
        task<1>(Vb, sl, i0[3], i1[3], x3, c0[3], c1[3], dotsw, 0, ring, ringp, voff, lane);
    }
    int eo2[32];
    { int lane2 = lane; float z = 0.f; asm volatile("" : "+v"(lane2), "+v"(z)); calibrate(eo2, lane2, z); }
#define P2_FIN(xk, k) do { const size_t t = (size_t)(gw + (k) * NGW); float ss = 0.f; _Pragma("unroll") for (int p = 0; p < 32; ++p) ss += xk[p] * xk[p]; \
        const float r = rsqrtf(wave_sum(ss) * (1.f / D) + EPS); \
        _Pragma("unroll") for (int hf = 0; hf < 2; ++hf) { float xv[16]; _Pragma("unroll") for (int p = 0; p < 16; ++p) xv[p] = X1[t * D + eo2[hf * 16 + p]]; \
            _Pragma("unroll") for (int p = 0; p < 16; ++p) dst[t * D + eo2[hf * 16 + p]] = xv[p] + xk[hf * 16 + p] * r * gfin[eo2[hf * 16 + p]]; } } while (0)
    P2_FIN(x0, 0); P2_FIN(x1, 1); P2_FIN(x2, 2); P2_FIN(x3, 3);
#undef P2_FIN
}
#undef P2_VWAIT
#undef P2_SWAIT
}

namespace topk {
using f32x16 = __attribute__((ext_vector_type(16))) float;
constexpr int LDS_KIMG = 0, LDS_TK = 65536;
__device__ __forceinline__ float swapf(float m) { auto rr = __builtin_amdgcn_permlane32_swap(__float_as_uint(m), __float_as_uint(m), false, false); return (threadIdx.x & 32) ? __uint_as_float(rr[0]) : __uint_as_float(rr[1]); }
__device__ __forceinline__ float max3(float a, float b, float c) { return fmaxf(fmaxf(a, b), c); }

__device__ __forceinline__ void half_topk(const bf16* qrow  , const LAS unsigned char* kimg, int r32, int hi, float (&vals)[16]) {
    bf16x8 qf[8];
#pragma unroll
    for (int ks = 0; ks < 8; ++ks) qf[ks] = *(const bf16x8*)(qrow + ks * 16 + hi * 8);
    float p[64];
#pragma unroll
    for (int blk = 0; blk < 4; ++blk) {
        f32x16 acc = f32x16{};
#pragma unroll
        for (int ks = 0; ks < 8; ++ks) {
            const bf16x8 kf = *(const LAS bf16x8*)(kimg + (ks * 2 + hi) * 2048 + (32 * blk + r32) * 16);
            acc = __builtin_amdgcn_mfma_f32_32x32x16_bf16(kf, qf[ks], acc, 0, 0, 0);
        }
#pragma unroll
        for (int r = 0; r < 16; ++r) { const int key = 32 * blk + (r & 3) + 8 * (r >> 2) + 4 * hi; p[blk * 16 + r] = __uint_as_float((__float_as_uint(acc[r]) & 0xffffff80u) | (unsigned)(127 - key)); }
    }
#pragma unroll
    for (int rd = 0; rd < 16; ++rd) {
        float m = max3(p[0], p[1], p[2]);
#pragma unroll
        for (int i = 3; i < 63; i += 2) m = max3(m, p[i], p[i + 1]);
        m = fmaxf(m, p[63]);
        const float g = fmaxf(m, swapf(m));
        vals[rd] = g;
#pragma unroll
        for (int i = 0; i < 64; ++i) p[i] = (__float_as_uint(p[i]) == __float_as_uint(g)) ? -INFINITY : p[i];
    }
}

__device__ __forceinline__ void phase_topk(const Args& a, LAS unsigned char* lds, int vcu, int G, int tid, int wave, int lane) {
    for (int e = tid; e < 2 * 128 * 16; e += NTHR) {
        const int half = e >> 11, key = (e >> 4) & 127, c = e & 15;
        const float* src = a.in[20 + half] + key * 128 + c * 8;
        const f32x4 x0 = *(const f32x4*)src, x1 = *(const f32x4*)(src + 4);
        v4u o; o.x = pk2(x0.x, x0.y); o.y = pk2(x0.z, x0.w); o.z = pk2(x1.x, x1.y); o.w = pk2(x1.z, x1.w);
        *(LAS v4u*)(lds + LDS_KIMG + half * 32768 + c * 2048 + key * 16) = o;
    }
    __syncthreads();
    const bf16* QP = (const bf16*)(a.ws + WS_QP); int* idx_out = (int*)(a.ws + WS_IDX); float* g_out = (float*)(a.ws + WS_GATE);
    const int r32 = lane & 31, hi = lane >> 5;
    LAS int* tk = (LAS int*)(lds + LDS_TK + wave * 4096) + r32 * 32;
    const int gw = vcu * NWAVES + wave, NGW = G * NWAVES;
    if (wave < 4) convert_tables(a, CVT_EARLY_ROWS, 2 * NEXP, gw, NGW, lane);
    for (int task = gw; task < (S / 32) * PH; task += NGW) {
        const int tb = task >> 3, h = task & 7, token = tb * 32 + r32;
        const bf16* qrow = QP + (size_t)token * D + h * PKD;
        float v1[16], v2[16];
        half_topk(qrow, lds + LDS_KIMG, r32, hi, v1);
        half_topk(qrow + 128, lds + LDS_KIMG + 32768, r32, hi, v2);
        if (hi == 0) {
#pragma unroll
            for (int i = 0; i < 16; ++i) { tk[i] = 127 - (int)(__float_as_uint(v1[i]) & 0x7fu); tk[16 + i] = 127 - (int)(__float_as_uint(v2[i]) & 0x7fu); }
        }
        float c[25];
        {
            int k = 0;
#pragma unroll
            for (int ai = 0; ai < 16; ++ai)
#pragma unroll
                for (int bi = 0; bi < 16; ++bi) if ((ai + 1) * (bi + 1) <= 16) {
                    const float sm = __uint_as_float(__float_as_uint(v1[ai]) & 0xffffff80u) + __uint_as_float(__float_as_uint(v2[bi]) & 0xffffff80u);
                    const float pk = __uint_as_float((__float_as_uint(sm) & 0xffffff00u) | (unsigned)(255 - (ai * 16 + bi)));
                    if ((k & 1) == 0) c[k >> 1] = pk; else c[k >> 1] = hi ? pk : c[k >> 1];
                    ++k;
                }
        }
        float top[16];
#pragma unroll
        for (int rd = 0; rd < 16; ++rd) {
            float m = c[0];
#pragma unroll
            for (int i = 1; i < 25; i += 2) m = max3(m, c[i], c[i + 1]);
            const float g = fmaxf(m, swapf(m));
            top[rd] = g;
#pragma unroll
            for (int i = 0; i < 25; ++i) c[i] = (__float_as_uint(c[i]) == __float_as_uint(g)) ? -INFINITY : c[i];
        }
        asm volatile("s_waitcnt lgkmcnt(0)" ::: "memory");
        const float mx = __uint_as_float(__float_as_uint(top[0]) & 0xffffff00u);
        float ev[16], den = 0.f;
#pragma unroll
        for (int i = 0; i < 16; ++i) { ev[i] = __expf(__uint_as_float(__float_as_uint(top[i]) & 0xffffff00u) - mx); den += ev[i]; }
        const float rden = 1.f / den;
        if (hi == 0) {
            const size_t ob = ((size_t)token * PH + h) * PTOP;
#pragma unroll
            for (int q4 = 0; q4 < 4; ++q4) {
                int oi[4]; float og[4];
#pragma unroll
                for (int i = 0; i < 4; ++i) { const int flat = 255 - (int)(__float_as_uint(top[q4 * 4 + i]) & 0xffu); oi[i] = tk[flat >> 4] * PKEYS + tk[16 + (flat & 15)]; og[i] = ev[q4 * 4 + i] * rden; }
                *(v4u*)(idx_out + ob + q4 * 4) = (v4u){(unsigned)oi[0], (unsigned)oi[1], (unsigned)oi[2], (unsigned)oi[3]};
                *(f32x4*)(g_out + ob + q4 * 4) = (f32x4){og[0], og[1], og[2], og[3]};
            }
        }
        asm volatile("s_waitcnt lgkmcnt(0)" ::: "memory");
    }
    if (wave >= 4) convert_tables(a, CVT_EARLY_ROWS, 2 * NEXP, gw, NGW, lane);
}
}

namespace conv {
constexpr int TCH = 32, ROWS = TCH + CK - 1;
constexpr int LDS_U = 0, LDS_PART = ROWS * CW * 2, LDS_STAT = LDS_PART + 8 * 64 * 4;
template <int N> __device__ __forceinline__ float dpp_ror(float v) { return __int_as_float(__builtin_amdgcn_update_dpp(0, __float_as_int(v), 0x120 + N, 0xf, 0xf, false)); }

__device__ __forceinline__ void phase_conv(const Args& a, LAS unsigned char* lds, int vcu, int G, int tid, int wave, int lane) {
    const bf16* PROJ = (const bf16*)(a.ws + WS_PROJ); bf16* Y = (bf16*)(a.ws + WS_Y);
    const float* conv_w = a.in[14]; const float* conv_b = a.in[15]; const float* ln_g = a.in[16]; const float* ln_b = a.in[17];
    LAS unsigned* ut = (LAS unsigned*)(lds + LDS_U);
    LAS float* part = (LAS float*)(lds + LDS_PART);
    LAS float* stat = (LAS float*)(lds + LDS_STAT);
    float w0[CK], w1[CK];
#pragma unroll
    for (int j = 0; j < CK; ++j) { const float2 wv = *(const float2*)(conv_w + j * CW + 2 * tid); w0[j] = wv.x; w1[j] = wv.y; }
    const float2 cb = *(const float2*)(conv_b + 2 * tid), lg = *(const float2*)(ln_g + 2 * tid), lb = *(const float2*)(ln_b + 2 * tid);
    for (int ch = vcu; ch < S / TCH; ch += G) {
        const int t0 = ch * TCH;
        __syncthreads();
#pragma unroll 8
        for (int r = 0; r < ROWS; ++r) {
            const int tt = t0 - (CK - 1) + r;
            unsigned pk = 0u;
            if (tt >= 0) {
                const unsigned av = *((const unsigned*)(PROJ + (size_t)tt * INC + 3 * AW) + tid);
                const unsigned gv = *((const unsigned*)(PROJ + (size_t)tt * INC + 3 * AW + CW) + tid);
                pk = pk2(bflo(av) * __builtin_amdgcn_rcpf(1.f + __expf(-bflo(gv))), bfhi(av) * __builtin_amdgcn_rcpf(1.f + __expf(-bfhi(gv))));
            }
            ut[r * 512 + tid] = pk;
        }
        __syncthreads();
        float y0[TCH], y1[TCH];
#pragma unroll
        for (int g8 = 0; g8 < 4; ++g8) {
            unsigned uu[38];
#pragma unroll
            for (int r = 0; r < 38; ++r) uu[r] = ut[(g8 * 8 + r) * 512 + tid];
#pragma unroll
            for (int t = 0; t < 8; ++t) {
                float s0 = cb.x, s1 = cb.y;
#pragma unroll
                for (int j = 0; j < CK; ++j) { s0 += w0[j] * bflo(uu[t + j]); s1 += w1[j] * bfhi(uu[t + j]); }
                y0[g8 * 8 + t] = s0; y1[g8 * 8 + t] = s1;
            }
        }
#pragma unroll
        for (int hf = 0; hf < 2; ++hf) {
            float v[32];
#pragma unroll
            for (int t = 0; t < 16; ++t) { const float a0 = y0[hf * 16 + t], a1 = y1[hf * 16 + t]; v[2 * t] = a0 + a1; v[2 * t + 1] = a0 * a0 + a1 * a1; }
            float h16[16];
#pragma unroll
            for (int i = 0; i < 16; ++i) { auto rr = __builtin_amdgcn_permlane32_swap(__float_as_uint(v[i]), __float_as_uint(v[i + 16]), false, false); h16[i] = __uint_as_float(rr[0]) + __uint_as_float(rr[1]); }
            float h8[8];
#pragma unroll
            for (int i = 0; i < 8; ++i) { auto rr = __builtin_amdgcn_permlane16_swap(__float_as_uint(h16[i]), __float_as_uint(h16[i + 8]), false, false); h8[i] = __uint_as_float(rr[0]) + __uint_as_float(rr[1]); }
#pragma unroll
            for (int i = 0; i < 8; ++i) { h8[i] += dpp_ror<8>(h8[i]); h8[i] += dpp_ror<4>(h8[i]); h8[i] += dpp_ror<2>(h8[i]); h8[i] += dpp_ror<1>(h8[i]); }
            if ((lane & 15) == 0) {
                *(LAS f32x4*)(part + wave * 64 + hf * 32 + 8 * (lane >> 4)) = (f32x4){h8[0], h8[1], h8[2], h8[3]};
                *(LAS f32x4*)(part + wave * 64 + hf * 32 + 8 * (lane >> 4) + 4) = (f32x4){h8[4], h8[5], h8[6], h8[7]};
            }
        }
        __syncthreads();
        if (tid < TCH) {
            float s = 0.f, ss = 0.f;
#pragma unroll
            for (int w = 0; w < 8; ++w) { s += part[w * 64 + 2 * tid]; ss += part[w * 64 + 2 * tid + 1]; }
            const float mu = s * (1.f / CW), var = fmaxf(ss * (1.f / CW) - mu * mu, 0.f);
            stat[2 * tid] = mu; stat[2 * tid + 1] = rsqrtf(var + EPS);
        }
        __syncthreads();
#pragma unroll
        for (int t = 0; t < TCH; ++t) {
            const float mu = stat[2 * t], rs = stat[2 * t + 1];
            const float v0 = (y0[t] - mu) * rs * lg.x + lb.x, v1 = (y1[t] - mu) * rs * lg.y + lb.y;
            *((unsigned*)(Y + (size_t)(t0 + t) * D + AW) + tid) = pk2(v0 * __builtin_amdgcn_rcpf(1.f + __expf(-v0)), v1 * __builtin_amdgcn_rcpf(1.f + __expf(-v1)));
        }
    }
}
}
#ifndef PROBE_ID
#define PROBE_ID (-1)
#endif
#ifndef PROBE_K
#define PROBE_K 8
#endif
#define TICK(k) do { if (PROBE_ID >= 0) { const unsigned long long now_ = __builtin_amdgcn_s_memrealtime(); if (PROBE_ID == (k)) tsel_ = now_ - tprev_; tprev_ = now_; } } while (0)
#define TOCK() do { if (PROBE_ID >= 0) tprev_ = __builtin_amdgcn_s_memrealtime(); } while (0)
#ifndef REP_P0A
#define REP_P0A 1
#endif
#ifndef REP_P0B
#define REP_P0B 1
#endif
#ifndef REP_P1
#define REP_P1 1
#endif
#ifndef REP_CONV
#define REP_CONV 1
#endif
#ifndef REP_ATT
#define REP_ATT 1
#endif
#ifndef REP_P3
#define REP_P3 1
#endif
#ifndef REP_P3B
#define REP_P3B 1
#endif
#ifndef REP_P4
#define REP_P4 1
#endif
#ifndef REP_P5
#define REP_P5 1
#endif
#ifndef REP_P6
#define REP_P6 1
#endif
#ifndef REP_BAR
#define REP_BAR 1
#endif
#define REPEAT(n) _Pragma("unroll 1") for (int rep_ = 0; rep_ < (n); ++rep_)
__global__ void __launch_bounds__(NTHR, 2) mega_fwd(Args args) {
    extern __shared__ __attribute__((aligned(16))) unsigned char lds_raw[];
    LAS unsigned char* lds = (LAS unsigned char*)lds_raw;
    int tid = threadIdx.x, lane = tid & 63, wave = __builtin_amdgcn_readfirstlane(tid >> 6);
    const int G = gridDim.x; const int bx = blockIdx.x; const int vcu = (G % 8 == 0) ? (bx % 8) * (G / 8) + bx / 8 : bx;
    for (int u = tid; u < (LDS_BYTES - LDSCTL_OFF) / 4; u += NTHR) ((LAS unsigned*)(lds + LDSCTL_OFF))[u] = 0u;
    __syncthreads();
    gu32* ctl = (gu32*)(args.ws + WS_CTL);
    XcdBarrier bar = xcd_barrier_post((unsigned*)(ctl + CW_BAR), (volatile LAS unsigned*)(lds + MISC_OFF) + 8);

    unsigned long long tprev_ = 0, tsel_ = 0;
#define RETID() do { int t_ = threadIdx.x; asm volatile("" : "+v"(t_)); tid = t_; lane = tid & 63; wave = __builtin_amdgcn_readfirstlane(tid >> 6); } while (0)
    TOCK(); REPEAT(REP_P0A) { RETID(); phase_p0a(args, lds, vcu, G, tid, wave, lane); }
    TICK(0);
    REPEAT(REP_BAR) xcd_barrier(bar);
    TICK(10);
    TOCK(); REPEAT(REP_P0B) { RETID(); phase_p0b(args, lds, vcu, G, tid, wave, lane); }
    TICK(1);
    xcd_barrier(bar);
    TICK(11);
    TOCK(); REPEAT(REP_P1) {
        pg8::Gemm g{(const pg8::bf16_t*)(args.ws + WS_XN), (const pg8::bf16_t*)(args.ws + WS_WIN), S, INC, D};
        pg8::StaticOrder So; So.init(S, INC, G, bx);
        pg8::EpiBf16<0> E{(pg8::bf16_t*)(args.ws + WS_PROJ), INC, nullptr, AW, (size_t)AW, C2};
        pg8::gemm_phase<pg8::EpiBf16<0>, pg8::StaticOrder, true, true>(lds + RING_OFF, g, So, E);
    }
    TICK(2);
    xcd_barrier(bar);
    TICK(12);
    TOCK(); REPEAT(REP_CONV) { RETID(); conv::phase_conv(args, lds, vcu, G, tid, wave, lane); }
    TICK(3);
    TOCK(); REPEAT(REP_ATT) { RETID(); att::attn_phase(args, lds, vcu, G, lane); }
    TICK(4);
    xcd_barrier(bar);
    TICK(13);
    TOCK(); REPEAT(REP_P3) {
        pg8::Gemm g{(const pg8::bf16_t*)(args.ws + WS_Y), (const pg8::bf16_t*)(args.ws + WS_WOUT), S, D, D};
        pg8::StaticOrder So; So.init(S, D, G, bx);
        pg8::EpiBf16<0> E{(pg8::bf16_t*)(args.ws + WS_MIX), D, nullptr, 0, 0, 1.f};
        pg8::gemm_phase<pg8::EpiBf16<0>, pg8::StaticOrder, true, true>(lds + RING_OFF, g, So, E);
    }
    TICK(5);
    xcd_barrier(bar);
    TICK(14);
    TOCK(); REPEAT(REP_P3B) { RETID(); phase_p3b(args, lds, vcu, G, tid, wave, lane); }
    TICK(6);
    xcd_barrier(bar);
    TICK(15);
    TOCK(); REPEAT(REP_P4) {
        pg8::Gemm g{(const pg8::bf16_t*)(args.ws + WS_XN), (const pg8::bf16_t*)(args.ws + WS_WQ), S, D, D};
        pg8::StaticOrder So; So.init(S, D, G, bx);
        pg8::EpiBf16<0> E{(pg8::bf16_t*)(args.ws + WS_QP), D, nullptr, 0, 0, 1.f};
        pg8::gemm_phase<pg8::EpiBf16<0>, pg8::StaticOrder, true, true>(lds + RING_OFF, g, So, E);
    }
    TICK(7);
    xcd_barrier(bar);
    TICK(16);
    TOCK(); REPEAT(REP_P5) { RETID(); topk::phase_topk(args, lds, vcu, G, tid, wave, lane); }
    TICK(8);
    xcd_barrier(bar);
    TICK(17);
    TOCK(); REPEAT(REP_P6) { RETID(); peer2::phase_peer2(args, lds, vcu, G, tid, wave, lane, bar.x, (rep_ + 1 < REP_P6) ? (float*)(args.ws + WS_MIX) : args.out); }
    TICK(9);
    if (PROBE_ID >= 0 && blockIdx.x == 0) { const unsigned long long t0_ = __builtin_amdgcn_s_memrealtime(); while (__builtin_amdgcn_s_memrealtime() - t0_ < tsel_ * PROBE_K) __builtin_amdgcn_s_sleep(8); }
}

extern "C" void kernel_launch(void* const* d_in, const int* in_sizes, int n_in, void* d_out, int out_size, void* d_ws, size_t ws_size, hipStream_t stream) {
    static int grid = 0;
    if (grid == 0) {
        if (n_in != 24 || out_size != S * D || ws_size < WS_END) { fprintf(stderr, "kernel_launch: unexpected problem shape (n_in %d, out %d, ws %zu)\n", n_in, out_size, ws_size); grid = -1; return; }
        int dev = 0, cus = 0;
        if (hipGetDevice(&dev) != hipSuccess || hipDeviceGetAttribute(&cus, hipDeviceAttributeMultiprocessorCount, dev) != hipSuccess) { grid = -1; return; }
        if (hipFuncSetAttribute((const void*)mega_fwd, hipFuncAttributeMaxDynamicSharedMemorySize, LDS_BYTES) != hipSuccess) { fprintf(stderr, "kernel_launch: hipFuncSetAttribute failed\n"); grid = -1; return; }
        int per_cu = 0;
        if (hipOccupancyMaxActiveBlocksPerMultiprocessor(&per_cu, (const void*)mega_fwd, NTHR, LDS_BYTES) != hipSuccess || per_cu < 1) fprintf(stderr, "kernel_launch: occupancy query reports %d\n", per_cu);
        (void)hipGetLastError();
        grid = cus;
    }
    if (grid < 0) return;
    if (hipMemsetAsync((char*)d_ws + WS_CTL, 0, CTL_ZERO_BYTES, stream) != hipSuccess) return;
    Args a{};
    for (int i = 0; i < 24; ++i) a.in[i] = (const float*)d_in[i];
    a.out = (float*)d_out; a.ws = (unsigned char*)d_ws;
    hipLaunchKernelGGL(mega_fwd, dim3(grid), dim3(NTHR), LDS_BYTES, stream, a);
}
```

```cpp
#include <hip/hip_runtime.h>
#include <cstdio>
#include <cstdint>
#include <cmath>
namespace pg8 {
#define PG8_LAS __attribute__((address_space(3)))
typedef unsigned short bf16_t;
typedef short bf16x8 __attribute__((ext_vector_type(8)));
typedef float f32x4 __attribute__((ext_vector_type(4)));
typedef unsigned u32x4 __attribute__((ext_vector_type(4)));
constexpr int BM = 256, BK = 64, HALF = 128, HTB = HALF * BK * 2  , STAGE_BYTES = 8 * HTB, NXCD = 8, WGM = 8;

__host__ __device__ __forceinline__ int lds_byte(int r, int c) { const int st = (r >> 4) * 2 + (c >> 5), rr = r & 15, cc = c & 31, ob = rr * 64 + cc * 2; return st * 1024 + (ob ^ (((ob >> 9) & 1) << 5)); }
__host__ __device__ __forceinline__ void stage_rc(int b, int& R, int& C) { const int st = b / 1024, sb = b % 1024, swz = sb ^ (((sb >> 9) & 1) << 5); R = (st >> 1) * 16 + swz / 64; C = (st & 1) * 32 + (swz % 64) / 2; }
__host__ __device__ __forceinline__ int perm32(int rho) { const int n = rho >> 4, i = rho & 15; return 8 * (i >> 2) + 4 * n + (i & 3); }

struct Unit { int pm, pn; };
struct Gemm { const bf16_t* A; const bf16_t* Bt; int M, N, K; };

struct StaticOrder {
    int nM, nN, nwg, G, c;
    __host__ __device__ void init(int M, int N, int G_, int c_) { nM = M / BM; nN = N / BM; nwg = nM * nN; G = G_; c = c_; }
    __host__ __device__ bool next(int i, Unit& u) const {
        const long L = (long)i * G + c; if (L >= nwg) return false;
        int wgid = (int)L; { const int q = nwg / NXCD, r = nwg % NXCD, xcd = wgid % NXCD, off = wgid / NXCD; wgid = (xcd < r ? xcd * (q + 1) : r * (q + 1) + (xcd - r) * q) + off; }
        const int nig = WGM * nN, gid = wgid / nig, fm = gid * WGM, gsz = (nM - fm) < WGM ? (nM - fm) : WGM;
        u.pm = fm + ((wgid % nig) % gsz); u.pn = (wgid % nig) / gsz; return true;
    }
    __device__ __forceinline__ void a_ready(const Unit&) const {}
    __device__ __forceinline__ void done(const Unit&) const {}
};

__device__ __forceinline__ unsigned cvt_pk_bf16(float lo, float hi) { unsigned r; asm volatile("v_cvt_pk_bf16_f32 %0, %1, %2" : "=v"(r) : "v"(lo), "v"(hi)); return r; }
typedef float f32x2 __attribute__((ext_vector_type(2)));
__device__ __forceinline__ f32x2 gelu_pk(f32x2 v) {
    const f32x2 av = __builtin_elementwise_abs(v), d = av * 0.2316418882f + 1.0f;
    f32x2 t; t.x = __builtin_amdgcn_rcpf(d.x); t.y = __builtin_amdgcn_rcpf(d.y);
    f32x2 q = t * 0.5307027145f + (-0.7265760135f); q = q * t + 0.7107068705f; q = q * t + (-0.142248368f); q = q * t + 0.127414796f; q = q * t;
    const f32x2 s = (v * v) * (-0.72134752044f);
    f32x2 e; e.x = __builtin_amdgcn_exp2f(s.x); e.y = __builtin_amdgcn_exp2f(s.y);
    const f32x2 m = v * (q * e), r = v - m;
    f32x2 o; o.x = v.x < 0.f ? m.x : r.x; o.y = v.y < 0.f ? m.y : r.y; return o;
}

template <int ACT  > struct EpiBf16 {
    static constexpr bool PERM = true, AFTER_DRAIN = false; static_assert(ACT == 0 || ACT == 1, "EpiBf16: ACT is 0 (none) or 1 (gelu_pk)");
    bf16_t* O; int ldc; const float* bias; int split_cols; size_t split_stride; float scale0;
    __device__ __forceinline__ void operator()(const f32x4 (&acc)[2][2][4][2], const Unit& u, int wr, int wc, int fr, int fq) const {
        const int row0 = u.pm * BM + wr * 64 + fr; int colt = u.pn * BM; bf16_t* base = O;
        float sc = 1.f; if (split_cols) { const int t = colt / split_cols; base += (size_t)t * split_stride; colt -= t * split_cols; if (t == 0) sc = scale0; }
        const int col0 = colt + wc * 32 + 8 * fq, bcol0 = u.pn * BM + wc * 32 + 8 * fq;
        f32x4 bv[2][2];
#pragma unroll
        for (int bj = 0; bj < 2; ++bj)
#pragma unroll
            for (int n = 0; n < 2; ++n) bv[bj][n] = bias ? *(const f32x4*)(bias + bcol0 + bj * HALF + 4 * n) : (f32x4){0.f, 0.f, 0.f, 0.f};
#pragma unroll
        for (int ai = 0; ai < 2; ++ai)
#pragma unroll
            for (int m = 0; m < 4; ++m) { bf16_t* rowp = base + (size_t)(row0 + ai * HALF + m * 16) * ldc + col0;
#pragma unroll
                for (int bj = 0; bj < 2; ++bj) { f32x4 v0 = acc[ai][bj][m][0] + bv[bj][0], v1 = acc[ai][bj][m][1] + bv[bj][1];
                    if (ACT == 1) { f32x2 a = gelu_pk((f32x2){v0[0], v0[1]}), b = gelu_pk((f32x2){v0[2], v0[3]}), c = gelu_pk((f32x2){v1[0], v1[1]}), d = gelu_pk((f32x2){v1[2], v1[3]});
                        v0 = (f32x4){a.x, a.y, b.x, b.y}; v1 = (f32x4){c.x, c.y, d.x, d.y}; }
                    v0 = v0 * sc; v1 = v1 * sc; u32x4 w; w.x = cvt_pk_bf16(v0[0], v0[1]); w.y = cvt_pk_bf16(v0[2], v0[3]); w.z = cvt_pk_bf16(v1[0], v1[1]); w.w = cvt_pk_bf16(v1[2], v1[3]);
                    *(u32x4*)(rowp + bj * HALF) = w; } }
    }
};
template <class Epi, class Sched, bool ALIGN_EPI = false, bool SP2 = false>
__device__ __forceinline__ void gemm_phase(PG8_LAS unsigned char* lds, const Gemm g, const Sched& S, const Epi& E) {
    int tid_ = threadIdx.x; asm volatile("" : "+v"(tid_)); const int tid = tid_, wid = __builtin_amdgcn_readfirstlane(tid >> 6), lane = tid & 63, wr = wid >> 2, wc = wid & 3, fr = lane & 15, fq = lane >> 4;
    const int K = g.K, nt = K / BK;
    unsigned voffA[2], voffB[2];
#pragma unroll
    for (int i = 0; i < 2; ++i) { int R, C; stage_rc(tid * 16 + i * 8192, R, C); const int Rb = Epi::PERM ? ((R & ~31) + perm32(R & 31)) : R;
        voffA[i] = (unsigned)(R * K + C) * 2u; voffB[i] = (unsigned)(Rb * K + C) * 2u; }
    const size_t kstep = (size_t)(BK * 2);
    const size_t hstep = (size_t)HALF * K * 2;
    const size_t tstep = 2 * hstep;
    const unsigned ldsw = (unsigned)wid * 1024u;
    const int aoff = lds_byte(wr * 64 + fr, fq * 8), boff = lds_byte(wc * 32 + fr, fq * 8);
#define PG8_SA(b, h) (((b) * 2 + (h)) * HTB)
#define PG8_SB(b, h) ((4 + (b) * 2 + (h)) * HTB)
#define PG8_STAGE(bufoff, gbase, voff) do { _Pragma("unroll") for (int _i = 0; _i < 2; ++_i) \
        __builtin_amdgcn_global_load_lds((const unsigned*)((const char*)(gbase) + (voff)[_i]), (PG8_LAS unsigned*)(lds + (bufoff) + ldsw + _i * 8192), 16, 0, 0); } while (0)
#define PG8_LDA(dst, b, h) do { _Pragma("unroll") for (int m = 0; m < 4; ++m) _Pragma("unroll") for (int k = 0; k < 2; ++k) dst[m][k] = *(const PG8_LAS bf16x8*)(lds + PG8_SA(b, h) + aoff + m * 2048 + k * 1024); } while (0)
#define PG8_LDB(dst, b, h) do { _Pragma("unroll") for (int n = 0; n < 2; ++n) _Pragma("unroll") for (int k = 0; k < 2; ++k) dst[n][k] = *(const PG8_LAS bf16x8*)(lds + PG8_SB(b, h) + boff + n * 2048 + k * 1024); } while (0)
#define PG8_MMA(ai, bj, At, Bt) do { __builtin_amdgcn_s_setprio(1); _Pragma("unroll") for (int m = 0; m < 4; ++m) _Pragma("unroll") for (int n = 0; n < 2; ++n) _Pragma("unroll") for (int k = 0; k < 2; ++k) \
        acc[ai][bj][m][n] = __builtin_amdgcn_mfma_f32_16x16x32_bf16(Bt[n][k], At[m][k], acc[ai][bj][m][n], 0, 0, 0); __builtin_amdgcn_s_setprio(0); } while (0)
#define PG8_WAIT_V(n) asm volatile("s_waitcnt vmcnt(" #n ")" ::: "memory")
#define PG8_WAIT_L(n) asm volatile("s_waitcnt lgkmcnt(" #n ")" ::: "memory")
#define PG8_BAR __builtin_amdgcn_s_barrier()
#define PG8_SCHED __builtin_amdgcn_sched_barrier(0)
    Unit cur, nxt; int ui = 0;
    if (!S.next(0, cur)) return;
    f32x4 acc[2][2][4][2];
#pragma unroll
    for (int a = 0; a < 2; ++a)
#pragma unroll
        for (int b = 0; b < 2; ++b)
#pragma unroll
            for (int m = 0; m < 4; ++m)
#pragma unroll
                for (int n = 0; n < 2; ++n) acc[a][b][m][n] = (f32x4){0.f, 0.f, 0.f, 0.f};
    bf16x8 At[4][2], B0[2][2], B1[2][2];
    const char* cA = (const char*)g.A + (size_t)cur.pm * tstep; const char* cB = (const char*)g.Bt + (size_t)cur.pn * tstep;
    S.a_ready(cur);
    if constexpr (SP2) {
        PG8_STAGE(PG8_SB(0, 0), cB, voffB); PG8_STAGE(PG8_SB(0, 1), cB + hstep, voffB); PG8_STAGE(PG8_SA(0, 0), cA, voffA); PG8_STAGE(PG8_SA(0, 1), cA + hstep, voffA);
        if (wr == 1) PG8_BAR;
        PG8_WAIT_V(2); PG8_BAR;
        PG8_STAGE(PG8_SB(1, 0), cB + kstep, voffB); PG8_STAGE(PG8_SA(1, 0), cA + kstep, voffA); PG8_STAGE(PG8_SB(1, 1), cB + hstep + kstep, voffB);
        PG8_WAIT_V(6); PG8_BAR;
    } else {
        PG8_STAGE(PG8_SB(0, 0), cB, voffB); PG8_STAGE(PG8_SA(0, 0), cA, voffA); PG8_STAGE(PG8_SB(0, 1), cB + hstep, voffB); PG8_STAGE(PG8_SA(0, 1), cA + hstep, voffA);
        if (wr == 1) PG8_BAR;
        PG8_WAIT_V(4); PG8_BAR;
        PG8_STAGE(PG8_SB(1, 0), cB + kstep, voffB); PG8_STAGE(PG8_SA(1, 0), cA + kstep, voffA); PG8_STAGE(PG8_SB(1, 1), cB + hstep + kstep, voffB);
        PG8_WAIT_V(6); PG8_BAR;
    }
    for (;;) {
        const bool has_next = S.next(ui + 1, nxt);
        const char* nA = has_next ? (const char*)g.A + (size_t)nxt.pm * tstep : cA; const char* nB = has_next ? (const char*)g.Bt + (size_t)nxt.pn * tstep : cB;
        for (int t = 0; t < nt; t += 2) {
            const bool last = (t == nt - 2);
            const char* a1 = cA + (size_t)(t + 1) * kstep;
            const char* a2 = last ? nA : cA + (size_t)(t + 2) * kstep; const char* b2 = last ? nB : cB + (size_t)(t + 2) * kstep;
            const char* a3 = a2 + kstep; const char* b3 = b2 + kstep;
            if (last && has_next) S.a_ready(nxt);
            if constexpr (SP2) {
            PG8_LDB(B0, 0, 0); PG8_LDB(B1, 0, 1); PG8_SCHED; PG8_LDA(At, 0, 0); PG8_STAGE(PG8_SA(1, 1), a1 + hstep, voffA);
            PG8_WAIT_V(8); PG8_WAIT_L(0); PG8_BAR; PG8_MMA(0, 0, At, B0); PG8_MMA(0, 1, At, B1); PG8_BAR; PG8_SCHED;
            PG8_LDA(At, 0, 1); PG8_STAGE(PG8_SB(0, 0), b2, voffB); PG8_STAGE(PG8_SB(0, 1), b2 + hstep, voffB); PG8_STAGE(PG8_SA(0, 0), a2, voffA);
            PG8_WAIT_V(8); PG8_WAIT_L(0); PG8_BAR; PG8_MMA(1, 0, At, B0); PG8_MMA(1, 1, At, B1); PG8_BAR; PG8_SCHED;
            PG8_LDB(B0, 1, 0); PG8_LDB(B1, 1, 1); PG8_SCHED; PG8_LDA(At, 1, 0); PG8_STAGE(PG8_SA(0, 1), a2 + hstep, voffA);
            PG8_WAIT_V(8); PG8_WAIT_L(0); PG8_BAR; PG8_MMA(0, 0, At, B0); PG8_MMA(0, 1, At, B1); PG8_BAR; PG8_SCHED;
            PG8_LDA(At, 1, 1); PG8_STAGE(PG8_SB(1, 0), b3, voffB); PG8_STAGE(PG8_SB(1, 1), b3 + hstep, voffB); PG8_STAGE(PG8_SA(1, 0), a3, voffA);
            PG8_WAIT_V(8); PG8_WAIT_L(0); PG8_BAR; PG8_MMA(1, 0, At, B0); PG8_MMA(1, 1, At, B1); PG8_BAR; PG8_SCHED;
            } else {
            PG8_LDB(B0, 0, 0); PG8_SCHED; PG8_LDA(At, 0, 0); PG8_STAGE(PG8_SA(1, 1), a1 + hstep, voffA);
            PG8_WAIT_L(8); PG8_BAR; PG8_WAIT_L(0); PG8_MMA(0, 0, At, B0); PG8_BAR; PG8_SCHED;
            PG8_LDB(B1, 0, 1); PG8_STAGE(PG8_SB(0, 0), b2, voffB);
            PG8_BAR; PG8_WAIT_L(0); PG8_MMA(0, 1, At, B1); PG8_BAR;
            PG8_LDA(At, 0, 1); PG8_STAGE(PG8_SA(0, 0), a2, voffA);
            PG8_BAR; PG8_WAIT_L(0); PG8_MMA(1, 0, At, B0); PG8_BAR; PG8_SCHED;
            PG8_STAGE(PG8_SB(0, 1), b2 + hstep, voffB);
            PG8_WAIT_V(6); PG8_BAR; PG8_MMA(1, 1, At, B1); PG8_BAR;
            PG8_LDB(B0, 1, 0); PG8_SCHED; PG8_LDA(At, 1, 0); PG8_STAGE(PG8_SA(0, 1), a2 + hstep, voffA);
            PG8_WAIT_L(8); PG8_BAR; PG8_WAIT_L(0); PG8_MMA(0, 0, At, B0); PG8_BAR; PG8_SCHED;
            PG8_LDB(B1, 1, 1); PG8_STAGE(PG8_SB(1, 0), b3, voffB);
            PG8_BAR; PG8_WAIT_L(0); PG8_MMA(0, 1, At, B1); PG8_BAR;
            PG8_LDA(At, 1, 1); PG8_STAGE(PG8_SA(1, 0), a3, voffA);
            PG8_BAR; PG8_WAIT_L(0); PG8_MMA(1, 0, At, B0); PG8_BAR; PG8_SCHED;
            PG8_STAGE(PG8_SB(1, 1), b3 + hstep, voffB);
            PG8_WAIT_V(6); PG8_BAR; PG8_MMA(1, 1, At, B1); PG8_BAR;
            }
        }
        if constexpr (ALIGN_EPI) { if (wr == 0) PG8_BAR; }
        if constexpr (!Epi::AFTER_DRAIN) { E(acc, cur, wr, wc, fr, fq); S.done(cur); }
        if (!has_next) break;
#pragma unroll
        for (int a = 0; a < 2; ++a)
#pragma unroll
            for (int b = 0; b < 2; ++b)
#pragma unroll
                for (int m = 0; m < 4; ++m)
#pragma unroll
                    for (int n = 0; n < 2; ++n) acc[a][b][m][n] = (f32x4){0.f, 0.f, 0.f, 0.f};
        cur = nxt; cA = nA; cB = nB; ++ui;
        if constexpr (ALIGN_EPI) { if (wr == 1) PG8_BAR; }
    }
    PG8_WAIT_V(0);
    if constexpr (!ALIGN_EPI) { if (wr == 0) PG8_BAR; }
    PG8_BAR;
    if constexpr (Epi::AFTER_DRAIN) { E.fused(acc, cur, wr, wc, fr, fq, lds, wid, lane); S.done(cur); }
#undef PG8_SA
#undef PG8_SB
#undef PG8_STAGE
#undef PG8_LDA
#undef PG8_LDB
#undef PG8_MMA
#undef PG8_WAIT_V
#undef PG8_WAIT_L
#undef PG8_BAR
#undef PG8_SCHED
}
}
#define GAS __attribute__((address_space(1)))
#define LAS __attribute__((address_space(3)))
typedef unsigned short bf16;
typedef unsigned v4u __attribute__((ext_vector_type(4)));
typedef float f32x4 __attribute__((ext_vector_type(4)));
typedef short bf16x8 __attribute__((ext_vector_type(8)));
typedef GAS unsigned gu32;
typedef GAS unsigned long long gu64;
#define RLX_AGENT __ATOMIC_RELAXED, __HIP_MEMORY_SCOPE_AGENT
#define LDS_WAIT() asm volatile("s_waitcnt lgkmcnt(0)" ::: "memory")
#define VM_WAIT() asm volatile("s_waitcnt vmcnt(0)" ::: "memory")
__device__ __forceinline__ unsigned long long rt() { return __builtin_amdgcn_s_memrealtime(); }
__device__ __forceinline__ unsigned f2bf(float f) { unsigned u = __builtin_bit_cast(unsigned, f); return (u + 0x7fffu + ((u >> 16) & 1u)) >> 16; }
__device__ __forceinline__ unsigned pk2(float lo, float hi) { return f2bf(lo) | (f2bf(hi) << 16); }

#define XB_TMO      128
#define XB_XCNT(j)  (256  + 64 * (j))
#define XB_XSUB(j)  (1280 + 64 * (j))
#define XB_XGEN(j)  (2304 + 64 * (j))
#define XB_TOP      3328
#define XB_TOPGEN   3392
#define XCD_BAR_WORDS 3456
#define XB_SPIN_CAP (1u << 18)

__device__ __forceinline__ unsigned xb_ld(unsigned* p)              { return __hip_atomic_load(p, __ATOMIC_RELAXED, __HIP_MEMORY_SCOPE_AGENT); }
__device__ __forceinline__ unsigned xb_add(unsigned* p, unsigned v) { return __hip_atomic_fetch_add(p, v, __ATOMIC_RELAXED, __HIP_MEMORY_SCOPE_AGENT); }
__device__ __forceinline__ unsigned xb_xcc_id() { return (unsigned)__builtin_amdgcn_s_getreg((3 << 11) | 20) & 0xFu; }
#define XB_SPIN(cond, bar) do { unsigned _sp = 0; while (cond) { __builtin_amdgcn_s_sleep(1); \
    if ((++_sp & 255u) == 0u) { if (xb_ld(&(bar)[XB_TMO])) break; if (_sp > XB_SPIN_CAP) { atomicAdd(&(bar)[XB_TMO], 1u); break; } } } } while (0)

struct XcdBarrier {
    unsigned* bar; unsigned x;
    volatile LAS unsigned* st;
};

__device__ __forceinline__ XcdBarrier xcd_barrier_post(unsigned* bar, volatile LAS unsigned* st) {
    XcdBarrier b; b.bar = bar; b.x = xb_xcc_id(); b.st = st;
    if (threadIdx.x == 0) (void)xb_add(&bar[XB_XCNT(b.x)], 1u);
    return b;
}
__device__ __forceinline__ void xcd_barrier_complete(unsigned* bar, unsigned x, unsigned& nloc, unsigned& nx) {
    const unsigned G = gridDim.x * gridDim.y * gridDim.z;
    unsigned sum, cnt, mine, sp = 0u;
    for (;;) {
        sum = 0u; cnt = 0u; mine = 0u;
#pragma unroll
        for (unsigned j = 0; j < 16; ++j) { const unsigned c = xb_ld(&bar[XB_XCNT(j)]); sum += c; cnt += (c > 0u) ? 1u : 0u; mine = (j == x) ? c : mine; }
        if (sum == G) break;
        __builtin_amdgcn_s_sleep(1);
        if ((++sp & 255u) == 0u) { if (xb_ld(&bar[XB_TMO])) break; if (sp > XB_SPIN_CAP) { atomicAdd(&bar[XB_TMO], 1u); break; } }
    }
    nloc = mine > 0u ? mine : 1u; nx = cnt > 0u ? cnt : 1u;
}

__device__ __forceinline__ void xcd_barrier(const XcdBarrier& b) {
    asm volatile("s_waitcnt vmcnt(0)" ::: "memory");
    __syncthreads();
    if (threadIdx.x == 0) {
        unsigned* bar = b.bar;
        __builtin_amdgcn_s_waitcnt(0);
        unsigned nloc = b.st[0], nx = b.st[1];
        if (nloc == 0u) { xcd_barrier_complete(bar, b.x, nloc, nx); b.st[0] = nloc; b.st[1] = nx; }
        const unsigned old = xb_add(&bar[XB_XSUB(b.x)], 1u);
        const unsigned gen = old / nloc;
        if (old + 1u == (gen + 1u) * nloc) {
            __builtin_amdgcn_fence(__ATOMIC_RELEASE, "agent");
            asm volatile("s_waitcnt vmcnt(0)" ::: "memory");
            const unsigned og = xb_add(&bar[XB_TOP], 1u);
            const unsigned tg = og / nx;
            if (og + 1u == (tg + 1u) * nx) xb_add(&bar[XB_TOPGEN], 1u);
            else XB_SPIN(xb_ld(&bar[XB_TOPGEN]) == tg, bar);
            __builtin_amdgcn_fence(__ATOMIC_ACQUIRE, "agent");
            xb_add(&bar[XB_XGEN(b.x)], 1u);
            asm volatile("s_waitcnt vmcnt(0)" ::: "memory");
        } else {
            XB_SPIN(xb_ld(&bar[XB_XGEN(b.x)]) == gen, bar);
            __builtin_amdgcn_fence(__ATOMIC_ACQUIRE, "agent");
            asm volatile("s_waitcnt vmcnt(0)" ::: "memory");
        }
    }
    __syncthreads();
}

constexpr int NWAVES = 8, NTHR = 512;
constexpr int D = 2048, S = 8192, AW = 1024, CW = 1024, INC = 5120, NH = 8, DH = 64, CK = 31;
constexpr int PH = 8, PKEYS = 128, PTOP = 16, PKD = 256, NEXP = 16384;
constexpr float EPS = 1e-6f, LAMBDA_INIT = 0.2f;
constexpr float LOG2E = 1.4426950408889634f;
constexpr float C2 = 0.125f * LOG2E;

constexpr size_t MiB = 1u << 20;
constexpr size_t WS_CTL = 0, CTL_ZERO_BYTES = 1 * MiB;
constexpr size_t WS_MOD = 1 * MiB;
constexpr size_t WS_MODP = 2 * MiB;
constexpr size_t WS_IDX = 5 * MiB, WS_GATE = 9 * MiB;
constexpr size_t WS_WIN = 16 * MiB, WS_WOUT = 36 * MiB, WS_WQ = 44 * MiB;
constexpr size_t WS_UB = 52 * MiB, WS_VB = 116 * MiB;
constexpr size_t WS_XN = 180 * MiB;
constexpr size_t WS_PROJ = 212 * MiB;
constexpr size_t WS_MIX = 212 * MiB;
constexpr size_t WS_Y = 292 * MiB;
constexpr size_t WS_QP = 292 * MiB;
constexpr size_t WS_X1 = 324 * MiB;
constexpr size_t WS_END = 388 * MiB;
constexpr int CW_BAR = 4096, CW_PEERQ = 8192;

constexpr int RING_OFF = 0, RING_BYTES = 131072;
constexpr int LDSCTL_OFF = RING_BYTES, MISC_OFF = LDSCTL_OFF + 320, XTRA_OFF = LDSCTL_OFF + 512;
constexpr int LDS_BYTES = 147456;

__device__ __forceinline__ float bf2f(unsigned short b) { return __uint_as_float((unsigned)b << 16); }
__device__ __forceinline__ float bflo(unsigned u) { return __uint_as_float(u << 16); }
__device__ __forceinline__ float bfhi(unsigned u) { return __uint_as_float(u & 0xffff0000u); }
template <int X> __device__ __forceinline__ float swz_xor(float v) { return __int_as_float(__builtin_amdgcn_ds_swizzle(__float_as_int(v), (X << 10) | 0x1f)); }
template <int X> __device__ __forceinline__ int swz_xor_i(int v) { return __builtin_amdgcn_ds_swizzle(v, (X << 10) | 0x1f); }
__device__ __forceinline__ float xor32_f(float v) { auto rr = __builtin_amdgcn_permlane32_swap(__float_as_uint(v), __float_as_uint(v), false, false); return __uint_as_float((threadIdx.x & 32) ? rr[0] : rr[1]); }
__device__ __forceinline__ int xor32_i(int v) { auto rr = __builtin_amdgcn_permlane32_swap((unsigned)v, (unsigned)v, false, false); return (int)((threadIdx.x & 32) ? rr[0] : rr[1]); }
__device__ __forceinline__ float wave_sum(float v) {
    v += swz_xor<1>(v); v += swz_xor<2>(v); v += swz_xor<4>(v); v += swz_xor<8>(v); v += swz_xor<16>(v);
    auto rr = __builtin_amdgcn_permlane32_swap(__float_as_uint(v), __float_as_uint(v), false, false); return __uint_as_float(rr[0]) + __uint_as_float(rr[1]);
}
__device__ __forceinline__ float wave_max(float v) {
    v = fmaxf(v, swz_xor<1>(v)); v = fmaxf(v, swz_xor<2>(v)); v = fmaxf(v, swz_xor<4>(v)); v = fmaxf(v, swz_xor<8>(v)); v = fmaxf(v, swz_xor<16>(v));
    auto rr = __builtin_amdgcn_permlane32_swap(__float_as_uint(v), __float_as_uint(v), false, false); return fmaxf(__uint_as_float(rr[0]), __uint_as_float(rr[1]));
}
__device__ __forceinline__ float silu_f(float v) { return v / (1.f + __expf(-v)); }

struct Args { const float* in[24]; float* out; unsigned char* ws; };

__device__ __forceinline__ void p0_transpose_item(const float* W, int K, int N, bf16* WT, int row_off, LAS float* scr, int item, int lane) {
    const int nblk = N / 32, kb = item / nblk, nb = item % nblk, k0 = 64 * kb, n0 = 32 * nb;
#pragma unroll 8
    for (int i = 0; i < 32; ++i) { const int kk = 2 * i + (lane >> 5); scr[kk * 33 + (lane & 31)] = W[(size_t)(k0 + kk) * N + n0 + (lane & 31)]; }
    LDS_WAIT(); asm volatile("" ::: "memory");
    const int c = lane & 7;
#pragma unroll
    for (int j = 0; j < 4; ++j) { const int n = (lane >> 3) + 8 * j; const LAS float* s = scr + (8 * c) * 33 + n;
        v4u o; o.x = pk2(s[0 * 33], s[1 * 33]); o.y = pk2(s[2 * 33], s[3 * 33]); o.z = pk2(s[4 * 33], s[5 * 33]); o.w = pk2(s[6 * 33], s[7 * 33]);
        *(GAS v4u*)(WT + (size_t)(row_off + n0 + n) * K + k0 + 8 * c) = o; }
    LDS_WAIT(); asm volatile("" ::: "memory");
}
__device__ __forceinline__ void p0_mod_block(const float* c, const float* w_ada, const float* b_ada, float* mod, LAS float* red, int cb, int tid, int wave, int lane) {
    const int slot = lane / 12, q = lane % 12;
    f32x4 acc = (f32x4){0.f, 0.f, 0.f, 0.f};
    if (slot < 5) {
        const float* wp = w_ada + (size_t)(wave * 256) * (6 * D) + cb * 48 + q * 4;
#pragma unroll 4
        for (int i = 0; i < 52; ++i) { const int r = i * 5 + slot;
            if (r < 256) { const float s = silu_f(c[wave * 256 + r]); const f32x4 w = *(const f32x4*)(wp + (size_t)r * (6 * D)); acc += w * s; } }
        *(LAS f32x4*)(red + (wave * 5 + slot) * 48 + q * 4) = acc;
    }
    __syncthreads();
    if (tid < 48) { float s = b_ada[cb * 48 + tid];
#pragma unroll 8
        for (int p = 0; p < 40; ++p) s += red[p * 48 + tid];
        mod[cb * 48 + tid] = s; }
    __syncthreads();
}
__device__ __forceinline__ void p0_cvt_row_fp6(const float* src, unsigned char* dst, float scale, int lane) {
    typedef float f32x16v __attribute__((ext_vector_type(16))); typedef unsigned u32x6 __attribute__((ext_vector_type(6))); typedef unsigned u32x2 __attribute__((ext_vector_type(2)));
    f32x4 v[8];
#pragma unroll
    for (int j = 0; j < 4; ++j) { v[j] = *(const f32x4*)(src + lane * 16 + 4 * j); v[4 + j] = *(const f32x4*)(src + 1024 + lane * 16 + 4 * j); }
    f32x16v a, b;
#pragma unroll
    for (int j = 0; j < 4; ++j) { a[4 * j] = v[j].x * scale; a[4 * j + 1] = v[j].y * scale; a[4 * j + 2] = v[j].z * scale; a[4 * j + 3] = v[j].w * scale;
                                  b[4 * j] = v[4 + j].x * scale; b[4 * j + 1] = v[4 + j].y * scale; b[4 * j + 2] = v[4 + j].z * scale; b[4 * j + 3] = v[4 + j].w * scale; }
    const u32x6 w = __builtin_amdgcn_cvt_scalef32_2xpk16_fp6_f32(a, b, 1.0f);
    asm volatile("" :: "v"(a), "v"(b));
    u32x2* o = (u32x2*)(dst + lane * 24);
    o[0] = (u32x2){w[0], w[1]}; o[1] = (u32x2){w[2], w[3]}; o[2] = (u32x2){w[4], w[5]};
}

__device__ __forceinline__ void convert_tables(const Args& a, int r0, int r1, int cw, int ncw, int lane) {
    for (int r = r0 + cw; r < r1; r += ncw) {
        if (r < NEXP) p0_cvt_row_fp6(a.in[22] + (size_t)r * D, (unsigned char*)(a.ws + WS_UB) + (size_t)r * 1536, 64.f, lane);
        else p0_cvt_row_fp6(a.in[23] + (size_t)(r - NEXP) * D, (unsigned char*)(a.ws + WS_VB) + (size_t)(r - NEXP) * 1536, 16.f, lane);
    }
}
constexpr int CVT_EARLY_ROWS = 0;

__device__ __forceinline__ void phase_p0a(const Args& a, LAS unsigned char* lds, int vcu, int G, int tid, int wave, int lane) {
    const float* c = a.in[1]; const float* w_ada = a.in[2];
    for (int cb = vcu; cb < 6 * D / 48; cb += G) p0_mod_block(c, w_ada, a.in[3], (float*)(a.ws + WS_MOD), (LAS float*)(lds + XTRA_OFF + 64), cb, tid, wave, lane);
    LAS float* scr = (LAS float*)(lds + RING_OFF + wave * 16384);
    const int gw = vcu * NWAVES + wave, NGW = G * NWAVES;
    constexpr int I_WIN = (D / 64) * (INC / 32), I_WOUT = (D / 64) * (D / 32), I_WQ = I_WOUT, I_TAB = NEXP;
    constexpr int NITEMS = I_WIN + I_WOUT + I_WQ;
    for (int it = gw; it < NITEMS; it += NGW) {
        int r = it;
        if (r < I_WIN) { p0_transpose_item(a.in[8], D, INC, (bf16*)(a.ws + WS_WIN), 0, scr, r, lane); continue; } r -= I_WIN;
        if (r < I_WOUT) { p0_transpose_item(a.in[18], D, D, (bf16*)(a.ws + WS_WOUT), 0, scr, r, lane); continue; } r -= I_WOUT;
        p0_transpose_item(a.in[19], D, D, (bf16*)(a.ws + WS_WQ), 0, scr, r, lane);
    }
}

__device__ __forceinline__ void phase_p0b(const Args& a, LAS unsigned char* lds, int vcu, int G, int tid, int wave, int lane) {
    const float* mod = (const float*)(a.ws + WS_MOD); const float* g_pre = a.in[4];
    LAS float* gm = (LAS float*)(lds + RING_OFF); LAS float* sh = gm + D;
#pragma unroll
    for (int i = 0; i < 4; ++i) { const int k = tid + NTHR * i; sh[k] = mod[k]; gm[k] = g_pre[k] * (1.f + mod[D + k]); }
    __syncthreads();
    const float* x = a.in[0]; bf16* XN = (bf16*)(a.ws + WS_XN);
    const int gw = vcu * NWAVES + wave, NGW = G * NWAVES;
    for (int row = gw; row < S; row += NGW) {
        const float* xr = x + (size_t)row * D + lane * 4;
        f32x4 v[8]; float ss = 0.f;
#pragma unroll
        for (int j = 0; j < 8; ++j) { v[j] = *(const f32x4*)(xr + 256 * j); ss += (v[j].x * v[j].x + v[j].y * v[j].y) + (v[j].z * v[j].z + v[j].w * v[j].w); }
        const float r = rsqrtf(wave_sum(ss) * (1.f / D) + EPS);
#pragma unroll
        for (int j = 0; j < 8; ++j) { const f32x4 g4 = *(const LAS f32x4*)(gm + lane * 4 + 256 * j), s4 = *(const LAS f32x4*)(sh + lane * 4 + 256 * j);
            const f32x4 o = v[j] * r * g4 + s4;
            *(unsigned long long*)(XN + (size_t)row * D + lane * 4 + 256 * j) = (unsigned long long)pk2(o.x, o.y) | ((unsigned long long)pk2(o.z, o.w) << 32); }
    }
}

struct EpiF32 {
    static constexpr bool PERM = false, AFTER_DRAIN = false;
    float* O; int ldc;
    __device__ __forceinline__ void operator()(const pg8::f32x4 (&acc)[2][2][4][2], const pg8::Unit& u, int wr, int wc, int fr, int fq) const {
        const int row0 = u.pm * pg8::BM + wr * 64 + fr, col0 = u.pn * pg8::BM + wc * 32 + 4 * fq;
#pragma unroll
        for (int ai = 0; ai < 2; ++ai)
#pragma unroll
            for (int m = 0; m < 4; ++m) { float* rowp = O + (size_t)(row0 + ai * pg8::HALF + m * 16) * ldc + col0;
#pragma unroll
                for (int bj = 0; bj < 2; ++bj)
#pragma unroll
                    for (int n = 0; n < 2; ++n) *(pg8::f32x4*)(rowp + bj * pg8::HALF + n * 16) = acc[ai][bj][m][n]; }
    }
};

__device__ __forceinline__ void phase_attn_simple(const Args& a, LAS unsigned char* lds, int vcu, int G, int wave, int lane) {
    const bf16* proj = (const bf16*)(a.ws + WS_PROJ); bf16* Y = (bf16*)(a.ws + WS_Y);
    const float* g_subln = a.in[13];
    LAS float* qs = (LAS float*)(lds + RING_OFF) + wave * 128;
    const float lam = __expf(wave_sum(a.in[9][lane] * a.in[10][lane])) - __expf(wave_sum(a.in[11][lane] * a.in[12][lane])) + LAMBDA_INIT;
    const int gw = vcu * NWAVES + wave, NGW = G * NWAVES;
    for (int gid = gw; gid < NH * S; gid += NGW) {
        const int h = gid & 7, qpos = gid >> 3;
        const float slope = exp2f(-(float)(h + 1)) * LOG2E;
        const bf16* qrow = proj + (size_t)qpos * INC + h * 128;
        LDS_WAIT(); asm volatile("" ::: "memory");
        qs[lane] = bf2f(qrow[lane]); qs[64 + lane] = bf2f(qrow[64 + lane]);
        LDS_WAIT(); asm volatile("" ::: "memory");
        float res0 = 0.f, res1 = 0.f;
        for (int m = 0; m < 2; ++m) {
            float mx = -INFINITY, l = 0.f, o0 = 0.f, o1 = 0.f;
            for (int kb = 0; kb <= qpos; kb += 64) {
                const int kpos = kb + lane;
                float sdot = -INFINITY;
                if (kpos <= qpos) {
                    const v4u* kr = (const v4u*)(proj + (size_t)kpos * INC + AW + h * 128 + m * 64);
                    float acc = 0.f;
#pragma unroll
                    for (int i = 0; i < 8; ++i) { const v4u kv = kr[i]; const LAS float* qq = qs + m * 64 + 8 * i;
                        acc += bflo(kv.x) * qq[0] + bfhi(kv.x) * qq[1] + bflo(kv.y) * qq[2] + bfhi(kv.y) * qq[3] + bflo(kv.z) * qq[4] + bfhi(kv.z) * qq[5] + bflo(kv.w) * qq[6] + bfhi(kv.w) * qq[7]; }
                    sdot = acc - slope * (float)(qpos - kpos);
                }
                const float mn = fmaxf(mx, wave_max(sdot));
                const float alpha = exp2f(mx - mn);
                const float p = (kpos <= qpos) ? exp2f(sdot - mn) : 0.f;
                l = l * alpha + wave_sum(p);
                o0 *= alpha; o1 *= alpha;
                const int nk = min(64, qpos - kb + 1);
                for (int j = 0; j < nk; ++j) {
                    const float pj = __shfl(p, j);
                    const unsigned vv = *((const unsigned*)(proj + (size_t)(kb + j) * INC + 2 * AW + h * 128) + lane);
                    o0 += pj * bflo(vv); o1 += pj * bfhi(vv);
                }
                mx = mn;
            }
            const float inv = 1.f / l;
            if (m == 0) { res0 = o0 * inv; res1 = o1 * inv; } else { res0 -= lam * o0 * inv; res1 -= lam * o1 * inv; }
        }
        const float ss = wave_sum(res0 * res0 + res1 * res1);
        const float r = rsqrtf(ss * (1.f / 128.f) + EPS) * (1.f - LAMBDA_INIT);
        *((unsigned*)(Y + (size_t)qpos * D + h * 128) + lane) = pk2(res0 * r * g_subln[2 * lane], res1 * r * g_subln[2 * lane + 1]);
    }
}

__device__ __forceinline__ void block_sum2(float& a, float& b, LAS float* red, int wave, int lane) {
    a = wave_sum(a); b = wave_sum(b);
    __syncthreads();
    if (lane == 0) { red[wave] = a; red[8 + wave] = b; }
    __syncthreads();
    float sa = 0.f, sb = 0.f;
#pragma unroll
    for (int i = 0; i < 8; ++i) { sa += red[i]; sb += red[8 + i]; }
    a = sa; b = sb;
}

__device__ __forceinline__ void phase_conv_simple(const Args& a, LAS unsigned char* lds, int vcu, int G, int tid, int wave, int lane) {
    const bf16* proj = (const bf16*)(a.ws + WS_PROJ); bf16* Y = (bf16*)(a.ws + WS_Y);
    const float* conv_w = a.in[14]; const float* conv_b = a.in[15]; const float* ln_g = a.in[16]; const float* ln_b = a.in[17];
    LAS float* red = (LAS float*)(lds + XTRA_OFF);
    const int per = S / G;
    for (int t = vcu * per; t < (vcu + 1) * per; ++t) {
        float acc0 = 0.f, acc1 = 0.f;
        for (int j = 0; j < CK; ++j) {
            const int tt = t - (CK - 1) + j;
            if (tt < 0) continue;
            const unsigned av = *((const unsigned*)(proj + (size_t)tt * INC + 3 * AW) + tid);
            const unsigned gv = *((const unsigned*)(proj + (size_t)tt * INC + 3 * AW + CW) + tid);
            const float u0 = bflo(av) / (1.f + __expf(-bflo(gv))), u1 = bfhi(av) / (1.f + __expf(-bfhi(gv)));
            acc0 += conv_w[j * CW + 2 * tid] * u0; acc1 += conv_w[j * CW + 2 * tid + 1] * u1;
        }
        acc0 += conv_b[2 * tid]; acc1 += conv_b[2 * tid + 1];
        float s1 = acc0 + acc1, s2 = acc0 * acc0 + acc1 * acc1;
        block_sum2(s1, s2, red, wave, lane);
        const float mu = s1 * (1.f / CW), var = fmaxf(s2 * (1.f / CW) - mu * mu, 0.f), r = rsqrtf(var + EPS);
        const float v0 = (acc0 - mu) * r * ln_g[2 * tid] + ln_b[2 * tid], v1 = (acc1 - mu) * r * ln_g[2 * tid + 1] + ln_b[2 * tid + 1];
        *((unsigned*)(Y + (size_t)t * D + AW) + tid) = pk2(silu_f(v0), silu_f(v1));
    }
}

__device__ __forceinline__ void phase_p3b(const Args& a, LAS unsigned char* lds, int vcu, int G, int tid, int wave, int lane) {
    const float* mod = (const float*)(a.ws + WS_MOD);
    LAS float* gA = (LAS float*)(lds + RING_OFF); LAS float* gB = gA + D; LAS float* sB = gB + D;
#pragma unroll
    for (int i = 0; i < 4; ++i) { const int k = tid + NTHR * i; gA[k] = mod[2 * D + k] * a.in[5][k]; gB[k] = a.in[6][k] * (1.f + mod[4 * D + k]); sB[k] = mod[3 * D + k]; }
    __syncthreads();
    const float* x = a.in[0]; const bf16* mix = (const bf16*)(a.ws + WS_MIX); bf16* XN = (bf16*)(a.ws + WS_XN); float* x1o = (float*)(a.ws + WS_X1);
    const int gw = vcu * NWAVES + wave, NGW = G * NWAVES;
    for (int row = gw; row < S; row += NGW) {
        const size_t ro = (size_t)row * D + lane * 4;
        unsigned long long mv[8]; f32x4 xv[8];
#pragma unroll
        for (int j = 0; j < 8; ++j) { mv[j] = *(const unsigned long long*)(mix + ro + 256 * j); xv[j] = *(const f32x4*)(x + ro + 256 * j); }
        f32x4 v[8]; float ss = 0.f;
#pragma unroll
        for (int j = 0; j < 8; ++j) { const unsigned lo = (unsigned)mv[j], hi = (unsigned)(mv[j] >> 32); v[j] = (f32x4){bflo(lo), bfhi(lo), bflo(hi), bfhi(hi)};
            ss += (v[j].x * v[j].x + v[j].y * v[j].y) + (v[j].z * v[j].z + v[j].w * v[j].w); }
        const float r = rsqrtf(wave_sum(ss) * (1.f / D) + EPS);
        float s2 = 0.f;
#pragma unroll
        for (int j = 0; j < 8; ++j) { const f32x4 g4 = *(const LAS f32x4*)(gA + lane * 4 + 256 * j);
            v[j] = xv[j] + v[j] * r * g4; *(f32x4*)(x1o + ro + 256 * j) = v[j]; s2 += (v[j].x * v[j].x + v[j].y * v[j].y) + (v[j].z * v[j].z + v[j].w * v[j].w); }
        const float r2 = rsqrtf(wave_sum(s2) * (1.f / D) + EPS);
#pragma unroll
        for (int j = 0; j < 8; ++j) { const f32x4 g4 = *(const LAS f32x4*)(gB + lane * 4 + 256 * j), s4 = *(const LAS f32x4*)(sB + lane * 4 + 256 * j);
            const f32x4 o = v[j] * r2 * g4 + s4;
            *(unsigned long long*)(XN + ro + 256 * j) = (unsigned long long)pk2(o.x, o.y) | ((unsigned long long)pk2(o.z, o.w) << 32); }
    }
}

#define ARGMAX_STEP(OV, OI) do { const float ov_ = (OV); const int oi_ = (OI); if (ov_ > v || (ov_ == v && oi_ < i)) { v = ov_; i = oi_; } } while (0)
__device__ __forceinline__ void wave_argmax(float v, int i, float& bv, int& bi) {
    ARGMAX_STEP(swz_xor<1>(v), swz_xor_i<1>(i)); ARGMAX_STEP(swz_xor<2>(v), swz_xor_i<2>(i)); ARGMAX_STEP(swz_xor<4>(v), swz_xor_i<4>(i));
    ARGMAX_STEP(swz_xor<8>(v), swz_xor_i<8>(i)); ARGMAX_STEP(swz_xor<16>(v), swz_xor_i<16>(i)); ARGMAX_STEP(xor32_f(v), xor32_i(i));
    bv = v; bi = i;
}
__device__ __forceinline__ void phase_topk_simple(const Args& a, LAS unsigned char* lds, int vcu, int G, int tid, int wave, int lane) {
    LAS float* kt = (LAS float*)(lds + RING_OFF);
    for (int e = tid; e < 2 * PKEYS * 128; e += NTHR) { const int half = e >> 14, key = (e >> 7) & 127, d = e & 127; kt[half * 16384 + d * 128 + key] = a.in[20 + half][key * 128 + d]; }
    LAS float* qs = (LAS float*)(lds + XTRA_OFF + 64) + wave * 256;
    LAS float* tv = (LAS float*)(lds + XTRA_OFF + 64 + 8192) + wave * 32;
    LAS int* ti = (LAS int*)(lds + XTRA_OFF + 64 + 8192 + 1024) + wave * 32;
    __syncthreads();
    const bf16* QP = (const bf16*)(a.ws + WS_QP); int* idx_out = (int*)(a.ws + WS_IDX); float* g_out = (float*)(a.ws + WS_GATE);
    const int gw = vcu * NWAVES + wave, NGW = G * NWAVES;
    for (int gid = gw; gid < S * PH; gid += NGW) {
        const bf16* qr = QP + (size_t)gid * PKD;
        LDS_WAIT(); asm volatile("" ::: "memory");
#pragma unroll
        for (int i = 0; i < 4; ++i) qs[lane + 64 * i] = bf2f(qr[lane + 64 * i]);
        LDS_WAIT(); asm volatile("" ::: "memory");
        for (int half = 0; half < 2; ++half) {
            const LAS float* kk = kt + half * 16384;
            float s0 = 0.f, s1 = 0.f;
#pragma unroll 8
            for (int d = 0; d < 128; ++d) { const float qv = qs[half * 128 + d]; s0 += qv * kk[d * 128 + lane]; s1 += qv * kk[d * 128 + 64 + lane]; }
            for (int r = 0; r < PTOP; ++r) {
                float lv; int li;
                if (s0 >= s1) { lv = s0; li = lane; } else { lv = s1; li = lane + 64; }
                float bv; int bi; wave_argmax(lv, li, bv, bi);
                if (lane == 0) { tv[half * 16 + r] = bv; ti[half * 16 + r] = bi; }
                if (bi == lane) s0 = -INFINITY;
                if (bi == lane + 64) s1 = -INFINITY;
            }
        }
        LDS_WAIT(); asm volatile("" ::: "memory");
        float cv[4];
#pragma unroll
        for (int e = 0; e < 4; ++e) { const int f = lane * 4 + e; cv[e] = tv[f >> 4] + tv[16 + (f & 15)]; }
        float myv = 0.f; int myi = 0; float mx = 0.f, den = 0.f;
        for (int r = 0; r < PTOP; ++r) {
            float lv = cv[0]; int li = lane * 4;
#pragma unroll
            for (int e = 1; e < 4; ++e) if (cv[e] > lv) { lv = cv[e]; li = lane * 4 + e; }
            float bv; int bi; wave_argmax(lv, li, bv, bi);
            if (r == 0) mx = bv;
            den += __expf(bv - mx);
            if (r == lane) { myv = bv; myi = bi; }
#pragma unroll
            for (int e = 0; e < 4; ++e) if (bi == lane * 4 + e) cv[e] = -INFINITY;
        }
        if (lane < PTOP) {
            const int e = ti[myi >> 4] * PKEYS + ti[16 + (myi & 15)];
            idx_out[(size_t)gid * PTOP + lane] = e;
            g_out[(size_t)gid * PTOP + lane] = __expf(myv - mx) / den;
        }
    }
}

__device__ __forceinline__ void phase_peer_simple(const Args& a, LAS unsigned char* lds, int vcu, int G, int tid, int wave, int lane) {
    const float* mod = (const float*)(a.ws + WS_MOD);
    const bf16* XN = (const bf16*)(a.ws + WS_XN); const bf16* Ub = (const bf16*)(a.ws + WS_UB); const bf16* Vb = (const bf16*)(a.ws + WS_VB);
    const int* IDX = (const int*)(a.ws + WS_IDX); const float* GATE = (const float*)(a.ws + WS_GATE);
    LAS float* act = (LAS float*)(lds + RING_OFF); LAS int* eidx = (LAS int*)(lds + RING_OFF + 512); LAS float* red = (LAS float*)(lds + XTRA_OFF);
    const f32x4 gfin = (f32x4){mod[5 * D + 4 * tid] * a.in[7][4 * tid], mod[5 * D + 4 * tid + 1] * a.in[7][4 * tid + 1], mod[5 * D + 4 * tid + 2] * a.in[7][4 * tid + 2], mod[5 * D + 4 * tid + 3] * a.in[7][4 * tid + 3]};
    const int per = S / G;
    for (int t = vcu * per; t < (vcu + 1) * per; ++t) {
        __syncthreads();
        if (tid < 128) eidx[tid] = IDX[(size_t)t * 128 + tid];
        v4u hv[4];
#pragma unroll
        for (int j = 0; j < 4; ++j) hv[j] = *(const v4u*)(XN + (size_t)t * D + lane * 8 + 512 * j);
        __syncthreads();
#pragma unroll 2
        for (int ee = 0; ee < 16; ++ee) {
            const int e = wave * 16 + ee;
            const bf16* ur = Ub + (size_t)eidx[e] * D + lane * 8;
            float acc = 0.f;
#pragma unroll
            for (int j = 0; j < 4; ++j) { const v4u uv = *(const v4u*)(ur + 512 * j);
                acc += bflo(uv.x) * bflo(hv[j].x) + bfhi(uv.x) * bfhi(hv[j].x) + bflo(uv.y) * bflo(hv[j].y) + bfhi(uv.y) * bfhi(hv[j].y)
                     + bflo(uv.z) * bflo(hv[j].z) + bfhi(uv.z) * bfhi(hv[j].z) + bflo(uv.w) * bflo(hv[j].w) + bfhi(uv.w) * bfhi(hv[j].w); }
            acc = wave_sum(acc);
            if (lane == 0) act[e] = 0.5f * acc * (1.f + erff(acc * 0.70710678118654752f)) * GATE[(size_t)t * 128 + e];
        }
        __syncthreads();
        f32x4 o = (f32x4){0.f, 0.f, 0.f, 0.f};
#pragma unroll 8
        for (int e = 0; e < 128; ++e) {
            const unsigned long long vv = *(const unsigned long long*)(Vb + (size_t)eidx[e] * D + 4 * tid);
            const float av = act[e]; const unsigned lo = (unsigned)vv, hi = (unsigned)(vv >> 32);
            o.x += av * bflo(lo); o.y += av * bfhi(lo); o.z += av * bflo(hi); o.w += av * bfhi(hi);
        }
        float ss = (o.x * o.x + o.y * o.y) + (o.z * o.z + o.w * o.w), dummy = 0.f;
        block_sum2(ss, dummy, red, wave, lane);
        const float r = rsqrtf(ss * (1.f / D) + EPS);
        float* op = a.out + (size_t)t * D + 4 * tid;
        const f32x4 x1 = *(const f32x4*)op;
        *(f32x4*)op = x1 + o * r * gfin;
    }
}


namespace att {
using f32x16 = __attribute__((ext_vector_type(16))) float;
using s16x4 = __attribute__((ext_vector_type(4))) short;
typedef __attribute__((address_space(3))) const char* lds_cptr;
constexpr int KSLOT = 16384, NKS = 3, VSLOT = 16384, NVS = 4, KVB = 64, QBR = 128;
constexpr int LDS_KR = 0, LDS_VR = NKS * KSLOT, LDS_O2 = 0, LDS_OST = 65536, LDS_WS = LDS_VR + NVS * VSLOT, LDS_FLAG = LDS_WS + 2048, ATT_LDS_BYTES = LDS_FLAG + 64;
__device__ __forceinline__ int crow(int r, int hi) { return (r & 3) + 8 * (r >> 2) + 4 * hi; }
__device__ __forceinline__ void glds16(const void* gsrc, unsigned lds_dst) { unsigned keep;
    asm volatile("s_mov_b32 %0, m0\n\ts_mov_b32 m0, %2\n\ts_nop 0\n\tglobal_load_lds_dwordx4 %1, off\n\ts_mov_b32 m0, %0" : "=&s"(keep) : "v"(gsrc), "s"(lds_dst) : "memory"); }
#define ATT_WAIT_BAR(N) asm volatile("s_waitcnt vmcnt(" #N ") lgkmcnt(0)\n\ts_barrier" ::: "memory")
typedef float f32x2_t __attribute__((ext_vector_type(2))); typedef __bf16 bf16x2_t __attribute__((ext_vector_type(2)));
__device__ __forceinline__ unsigned cvtpk(float lo, float hi) { f32x2_t v = {lo, hi}; bf16x2_t b = __builtin_convertvector(v, bf16x2_t); return __builtin_bit_cast(unsigned, b); }
__device__ __forceinline__ float swap_max(float m) { auto rr = __builtin_amdgcn_permlane32_swap(__float_as_uint(m), __float_as_uint(m), false, false); return fmaxf(__uint_as_float(rr[0]), __uint_as_float(rr[1])); }
__device__ __forceinline__ float swap_sum(float m) { auto rr = __builtin_amdgcn_permlane32_swap(__float_as_uint(m), __float_as_uint(m), false, false); return __uint_as_float(rr[0]) + __uint_as_float(rr[1]); }
__device__ __forceinline__ float max3a(float a, float b, float c) { float r; asm("v_max3_f32 %0, %1, %2, %3" : "=v"(r) : "v"(a), "v"(b), "v"(c)); return r; }
#define ATT_VRD(dst, off) asm volatile("ds_read_b64_tr_b16 %0, %1 offset:%c2" : "=v"(dst) : "v"(vaddr), "i"(off) : "memory")
#define ATT_VF(i) (bf16x8){vlo[i][0], vlo[i][1], vlo[i][2], vlo[i][3], vhi[i][0], vhi[i][1], vhi[i][2], vhi[i][3]}

struct UnitCtx {
    const bf16* ksrc; const bf16* vsrc; unsigned kdst, vdst; unsigned lds0; lds_cptr shm3;
    int NT, q0, wq, m, r32, hi, lane, qrow; float ch;
};
#define ATT_DMA(t, ko_, vo_) do { const size_t ro_ = (size_t)(t) * KVB * INC; \
        glds16(c.ksrc + ro_, (unsigned)__builtin_amdgcn_readfirstlane(c.kdst + (ko_))); glds16(c.ksrc + ro_ + (size_t)32 * INC, (unsigned)__builtin_amdgcn_readfirstlane(c.kdst + (ko_) + 8192)); \
        glds16(c.vsrc + ro_, (unsigned)__builtin_amdgcn_readfirstlane(c.vdst + (vo_))); glds16(c.vsrc + ro_ + 64, (unsigned)__builtin_amdgcn_readfirstlane(c.vdst + (vo_) + 8192)); } while (0)

__device__ __forceinline__ void qk_tile(const UnitCtx& c, const bf16x8 (&qr)[4], float m0, int t, int ko, f32x16& p0, f32x16& p1) {
    const int hi = c.hi;
    const float tm = c.ch * (float)(t * KVB + 4 * hi - c.qrow) - m0, c32 = c.ch * 32.f;
#pragma unroll
    for (int r = 0; r < 16; ++r) { p0[r] = c.ch * (float)((r & 3) + 8 * (r >> 2)) + tm; p1[r] = p0[r] + c32; }
    const lds_cptr kp = c.shm3 + LDS_KR + ko + c.r32 * 256;
    bf16x8 ka[4], kb[4];
#pragma unroll
    for (int d0 = 0; d0 < 4; ++d0) { const int off = (((8 * c.m + hi + 2 * d0) ^ (c.r32 & 15)) * 16);
        ka[d0] = *(const __attribute__((address_space(3))) bf16x8*)(kp + off); kb[d0] = *(const __attribute__((address_space(3))) bf16x8*)(kp + off + 8192); }
    asm volatile("" : "+v"(ka[0]), "+v"(ka[1]), "+v"(ka[2]), "+v"(ka[3]), "+v"(kb[0]), "+v"(kb[1]), "+v"(kb[2]), "+v"(kb[3]));
#pragma unroll
    for (int d0 = 0; d0 < 4; ++d0) p0 = __builtin_amdgcn_mfma_f32_32x32x16_bf16(ka[d0], qr[d0], p0, 0, 0, 0);
#pragma unroll
    for (int d0 = 0; d0 < 4; ++d0) p1 = __builtin_amdgcn_mfma_f32_32x32x16_bf16(kb[d0], qr[d0], p1, 0, 0, 0);
    if (t * KVB + KVB - 1 > c.q0 + 32 * c.wq) {
        const int kb_ = t * KVB + 4 * hi;
#pragma unroll
        for (int r = 0; r < 16; ++r) { const int kv = kb_ + (r & 3) + 8 * (r >> 2); if (kv > c.qrow) p0[r] = -INFINITY; if (kv + 32 > c.qrow) p1[r] = -INFINITY; }
    }
}
__device__ __forceinline__ void exp_half(f32x16& p, float& sa, float& sb, v4u& wA, v4u& wB) {
#pragma unroll
    for (int r = 0; r < 16; r += 2) { p[r] = __builtin_amdgcn_exp2f(p[r]); p[r + 1] = __builtin_amdgcn_exp2f(p[r + 1]); sa += p[r]; sb += p[r + 1]; }
    wA = (v4u){cvtpk(p[0], p[1]), cvtpk(p[2], p[3]), cvtpk(p[4], p[5]), cvtpk(p[6], p[7])};
    wB = (v4u){cvtpk(p[8], p[9]), cvtpk(p[10], p[11]), cvtpk(p[12], p[13]), cvtpk(p[14], p[15])};
}
template <int H> __device__ __forceinline__ void pv_half(unsigned vaddr, const v4u& wA, const v4u& wB, f32x16 (&o)[4]) {
    s16x4 vlo[8], vhi[8];
#pragma unroll
    for (int d0 = 0; d0 < 4; ++d0) { ATT_VRD(vlo[d0], d0 * 4096 + H * 2048); ATT_VRD(vhi[d0], d0 * 4096 + H * 2048 + 512); }
#pragma unroll
    for (int d0 = 0; d0 < 4; ++d0) { ATT_VRD(vlo[4 + d0], d0 * 4096 + H * 2048 + 1024); ATT_VRD(vhi[4 + d0], d0 * 4096 + H * 2048 + 1024 + 512); }
    asm volatile("s_waitcnt lgkmcnt(8)" ::: "memory"); __builtin_amdgcn_sched_barrier(0);
#pragma unroll
    for (int d0 = 0; d0 < 4; ++d0) o[d0] = __builtin_amdgcn_mfma_f32_32x32x16_bf16(__builtin_bit_cast(bf16x8, wA), ATT_VF(d0), o[d0], 0, 0, 0);
    asm volatile("s_waitcnt lgkmcnt(0)" ::: "memory"); __builtin_amdgcn_sched_barrier(0);
#pragma unroll
    for (int d0 = 0; d0 < 4; ++d0) o[d0] = __builtin_amdgcn_mfma_f32_32x32x16_bf16(__builtin_bit_cast(bf16x8, wB), ATT_VF(4 + d0), o[d0], 0, 0, 0);
    __builtin_amdgcn_sched_barrier(0);
}

template <int MODE, bool STAG>
__device__ __forceinline__ void sweep(const UnitCtx& c, const bf16x8 (&qr)[4], float m0, f32x16 (&o)[4], float& lsum, float& rmax) {
    const int NT = c.NT;
    ATT_DMA(0, 0, 0); ATT_DMA(1, KSLOT, VSLOT);
    const unsigned vbase = c.lds0 + LDS_VR + ((c.lane >> 4) & 1) * 32 + (c.lane & 3) * 8 + (4 * c.hi + ((c.lane & 15) >> 2)) * 64;
    int ko = 0, vo = 0;
    v4u pw0 = (v4u){0u, 0u, 0u, 0u}, pw1 = pw0, pw2 = pw0, pw3 = pw0;
    unsigned vprev = vbase;
    for (int t = 0; t < NT; ++t) {
        if (t + 1 < NT) ATT_WAIT_BAR(4); else ATT_WAIT_BAR(0);
        { const int t2 = t + 2; if (t2 < NT) { int k2 = ko + 2 * KSLOT; if (k2 >= NKS * KSLOT) k2 -= NKS * KSLOT; int v2 = vo + 2 * VSLOT; if (v2 >= NVS * VSLOT) v2 -= NVS * VSLOT; ATT_DMA(t2, k2, v2); } }
        f32x16 p0, p1;
        if constexpr (MODE == 1) {
            qk_tile(c, qr, m0, t, ko, p0, p1);
            float a = max3a(p0[0], p0[1], p1[0]), b = max3a(p0[2], p0[3], p1[1]); a = max3a(a, p1[2], p1[3]);
#pragma unroll
            for (int r = 4; r < 16; r += 4) { a = max3a(a, p0[r], p0[r + 1]); b = max3a(b, p0[r + 2], p0[r + 3]); a = max3a(a, p1[r], p1[r + 1]); b = max3a(b, p1[r + 2], p1[r + 3]); }
            rmax = max3a(rmax, a, b);
        } else if constexpr (!STAG) {
            qk_tile(c, qr, m0, t, ko, p0, p1);
            const unsigned vaddr = vbase + (unsigned)vo;
            float sa = 0.f, sb = 0.f;
            exp_half(p0, sa, sb, pw0, pw1);
            {
                s16x4 vlo[8], vhi[8];
#pragma unroll
                for (int d0 = 0; d0 < 4; ++d0) { ATT_VRD(vlo[d0], d0 * 4096); ATT_VRD(vhi[d0], d0 * 4096 + 512); }
#pragma unroll
                for (int d0 = 0; d0 < 4; ++d0) { ATT_VRD(vlo[4 + d0], d0 * 4096 + 1024); ATT_VRD(vhi[4 + d0], d0 * 4096 + 1024 + 512); }
                asm volatile("s_waitcnt lgkmcnt(8)" ::: "memory"); __builtin_amdgcn_sched_barrier(0);
#pragma unroll
                for (int d0 = 0; d0 < 4; ++d0) o[d0] = __builtin_amdgcn_mfma_f32_32x32x16_bf16(__builtin_bit_cast(bf16x8, pw0), ATT_VF(d0), o[d0], 0, 0, 0);
                exp_half(p1, sa, sb, pw2, pw3);
                asm volatile("s_waitcnt lgkmcnt(0)" ::: "memory"); __builtin_amdgcn_sched_barrier(0);
#pragma unroll
                for (int d0 = 0; d0 < 4; ++d0) o[d0] = __builtin_amdgcn_mfma_f32_32x32x16_bf16(__builtin_bit_cast(bf16x8, pw1), ATT_VF(4 + d0), o[d0], 0, 0, 0);
                __builtin_amdgcn_sched_barrier(0);
            }
            lsum += sa + sb;
            pv_half<1>(vaddr, pw2, pw3, o);
        } else {
            if (t > 0) { pv_half<0>(vprev, pw0, pw1, o); pv_half<1>(vprev, pw2, pw3, o); }
            qk_tile(c, qr, m0, t, ko, p0, p1);
            float sa = 0.f, sb = 0.f;
            exp_half(p0, sa, sb, pw0, pw1);
            exp_half(p1, sa, sb, pw2, pw3);
            lsum += sa + sb;
            vprev = vbase + (unsigned)vo;
        }
        ko += KSLOT; if (ko >= NKS * KSLOT) ko = 0;
        vo += VSLOT; if (vo >= NVS * VSLOT) vo = 0;
    }
    if constexpr (MODE == 0 && STAG) { pv_half<0>(vprev, pw0, pw1, o); pv_half<1>(vprev, pw2, pw3, o); }
}

__device__ __forceinline__ void attn_unit(int h, int qb, const bf16* PROJ, bf16* Y, const float* g_subln, float lam, LAS unsigned char* shm) {
    int tid_ = threadIdx.x; asm volatile("" : "+v"(tid_)); const int tid = tid_, lane = tid & 63, r32 = lane & 31, hi = lane >> 5; const int w = __builtin_amdgcn_readfirstlane(tid >> 6);
    UnitCtx c;
    c.m = w >> 2; c.wq = w & 3; c.q0 = qb * QBR; c.r32 = r32; c.hi = hi; c.lane = lane;
    c.lds0 = (unsigned)(uintptr_t)shm; c.shm3 = (lds_cptr)shm;
    LAS float* wsf = (LAS float*)(shm + LDS_WS) + w * 64;
    LAS int* flags = (LAS int*)(shm + LDS_FLAG);
    c.ksrc = PROJ + AW + h * 128 + (size_t)(4 * w + (lane >> 4)) * INC + (((lane & 15) ^ ((4 * w + (lane >> 4)) & 15)) * 8);
    c.vsrc = PROJ + 2 * AW + h * 128 + (size_t)(16 * (w & 3) + (lane >> 2)) * INC + (w >> 2) * 32 + (lane & 3) * 8;
    c.kdst = c.lds0 + LDS_KR + w * 1024; c.vdst = c.lds0 + LDS_VR + w * 1024;
    c.NT = c.q0 / KVB + 2;
    c.qrow = c.q0 + 32 * c.wq + r32;
    c.ch = exp2f(-(float)(h + 1)) * LOG2E;
    bf16x8 qr[4];
    { const bf16* Qw = PROJ + (size_t)c.qrow * INC + h * 128 + c.m * 64 + hi * 8;
#pragma unroll
      for (int d0 = 0; d0 < 4; ++d0) qr[d0] = *(const bf16x8*)(Qw + d0 * 16); }
    asm volatile("" : "+v"(qr[0]), "+v"(qr[1]), "+v"(qr[2]), "+v"(qr[3]));
    f32x16 o[4]; float lsum, m0 = 0.f;
#pragma unroll 1
    for (int pass = 0; ; ++pass) {
#pragma unroll
        for (int d = 0; d < 4; ++d) o[d] = f32x16{};
        lsum = 0.f; float dummy = 0.f;
        if (c.m == 0) sweep<0, false>(c, qr, m0, o, lsum, dummy); else sweep<0, true>(c, qr, m0, o, lsum, dummy);
        lsum = swap_sum(lsum);
        const bool bad = !(lsum > 0.f) || !(lsum < 3.0e38f);
        if (lane == 0) flags[w] = 0;
        if (bad) flags[w] = 1;
        ATT_WAIT_BAR(0);
        int anybad = 0;
#pragma unroll
        for (int i = 0; i < 8; ++i) anybad |= flags[i];
        if (anybad == 0 || pass >= 1) break;
        float rmax = -INFINITY;
        ATT_WAIT_BAR(0);
        sweep<1, false>(c, qr, 0.f, o, lsum, rmax);
        m0 = swap_max(rmax);
        ATT_WAIT_BAR(0);
    }
    if (hi == 0) wsf[32 + r32] = 1.f / lsum;
    asm volatile("s_waitcnt lgkmcnt(0)" ::: "memory");
    { const f32x4 fa = *(const LAS f32x4*)(wsf + 32 + 4 * hi), fb = *(const LAS f32x4*)(wsf + 40 + 4 * hi), fc = *(const LAS f32x4*)(wsf + 48 + 4 * hi), fd = *(const LAS f32x4*)(wsf + 56 + 4 * hi);
      const f32x16 fv = (f32x16){fa.x, fa.y, fa.z, fa.w, fb.x, fb.y, fb.z, fb.w, fc.x, fc.y, fc.z, fc.w, fd.x, fd.y, fd.z, fd.w};
#pragma unroll
      for (int d = 0; d < 4; ++d) o[d] = o[d] * fv; }
    LAS float* o2 = (LAS float*)(shm + LDS_O2) + c.wq * 4096 + lane;
    if (c.m == 1) {
#pragma unroll
        for (int d = 0; d < 4; ++d)
#pragma unroll
            for (int r = 0; r < 16; ++r) o2[(d * 16 + r) * 64] = o[d][r];
    }
    ATT_WAIT_BAR(0);
    if (c.m == 0) {
        float ssq[16];
#pragma unroll
        for (int r = 0; r < 16; ++r) ssq[r] = 0.f;
#pragma unroll
        for (int d = 0; d < 4; ++d)
#pragma unroll
            for (int r = 0; r < 16; ++r) { const float v = o[d][r] - lam * o2[(d * 16 + r) * 64]; o[d][r] = v; ssq[r] += v * v; }
#pragma unroll
        for (int r = 0; r < 16; ++r) {
            float s = ssq[r];
            s += swz_xor<1>(s); s += swz_xor<2>(s); s += swz_xor<4>(s); s += swz_xor<8>(s); s += swz_xor<16>(s);
            ssq[r] = rsqrtf(s * (1.f / 128.f) + EPS) * (1.f - LAMBDA_INIT);
        }
        LAS bf16* stg = (LAS bf16*)(shm + LDS_OST) + c.wq * 4096;
#pragma unroll
        for (int d = 0; d < 4; ++d) { const float gd = g_subln[d * 32 + r32];
#pragma unroll
            for (int r = 0; r < 16; ++r) stg[crow(r, hi) * 128 + d * 32 + r32] = (bf16)f2bf(o[d][r] * ssq[r] * gd); }
        asm volatile("s_waitcnt lgkmcnt(0)" ::: "memory");
        bf16* Yw = Y + (size_t)(c.q0 + 32 * c.wq) * D + h * 128;
#pragma unroll
        for (int i = 0; i < 8; ++i) { const int row = i * 4 + (lane >> 4), chn = lane & 15; const v4u v = *(const LAS v4u*)(stg + row * 128 + chn * 8); *(v4u*)(Yw + (size_t)row * D + chn * 8) = v; }
    }
    ATT_WAIT_BAR(0);
}

__device__ __forceinline__ void attn_phase(const Args& a, LAS unsigned char* lds, int vcu, int G, int lane) {
    const bf16* PROJ = (const bf16*)(a.ws + WS_PROJ); bf16* Y = (bf16*)(a.ws + WS_Y);
    const float lam = __expf(wave_sum(a.in[9][lane] * a.in[10][lane])) - __expf(wave_sum(a.in[11][lane] * a.in[12][lane])) + LAMBDA_INIT;
    for (int u = vcu; u < NH * 32; u += G) {
        const int h = u >> 5, s = u & 31;
#pragma unroll 1
        for (int k = 0; k < 2; ++k) attn_unit(h, k == 0 ? 63 - s : s, PROJ, Y, a.in[13], lam, lds);
    }
}
#undef ATT_VRD
#undef ATT_VF
#undef ATT_DMA
}

namespace peer {
typedef int i32x16 __attribute__((ext_vector_type(16)));
typedef float f32x16s __attribute__((ext_vector_type(16)));
typedef float f32x2 __attribute__((ext_vector_type(2)));
typedef unsigned u32x6 __attribute__((ext_vector_type(6)));
typedef float f32x32 __attribute__((ext_vector_type(32)));
typedef float f32x16v __attribute__((ext_vector_type(16)));
constexpr int ROWB = 1536;
constexpr float U_SCALE = 64.f, V_SCALE = 16.f;
template <int N> __device__ __forceinline__ float dpp_ror(float v) { return __int_as_float(__builtin_amdgcn_update_dpp(0, __float_as_int(v), 0x120 + N, 0xf, 0xf, false)); }
__device__ __forceinline__ void dma_row(const char* rowbase, unsigned lds_dst, unsigned voff) {
    unsigned keep; unsigned long long ex; const unsigned v1 = voff + 1024u;
    asm volatile("s_nop 4\n\ts_mov_b32 %0, m0\n\ts_mov_b32 m0, %3\n\ts_nop 0\n\tglobal_load_lds_dwordx4 %4, %2\n\t"
                 "s_add_u32 m0, m0, 0x400\n\ts_mov_b64 %1, exec\n\ts_mov_b64 exec, 0xffffffff\n\tglobal_load_lds_dwordx4 %5, %2\n\t"
                 "s_mov_b64 exec, %1\n\ts_mov_b32 m0, %0" : "=&s"(keep), "=&s"(ex) : "s"(rowbase), "s"(lds_dst), "v"(voff), "v"(v1) : "memory", "scc");
}
__device__ __forceinline__ void sload16(i32x16& d, const void* p) { asm volatile("s_load_dwordx16 %0, %1, 0x0\n\ts_waitcnt lgkmcnt(0)" : "=&s"(d) : "s"(p) : "memory"); }
__device__ __forceinline__ void sload16x2(i32x16& d0, const void* p0, i32x16& d1, const void* p1) {
    asm volatile("s_load_dwordx16 %0, %2, 0x0\n\ts_load_dwordx16 %1, %3, 0x0\n\ts_waitcnt lgkmcnt(0)" : "=&s"(d0), "=&s"(d1) : "s"(p0), "s"(p1) : "memory"); }
#define PIN16(x, o) asm volatile("" : "+v"(x[o]), "+v"(x[o+1]), "+v"(x[o+2]), "+v"(x[o+3]), "+v"(x[o+4]), "+v"(x[o+5]), "+v"(x[o+6]), "+v"(x[o+7]), "+v"(x[o+8]), "+v"(x[o+9]), "+v"(x[o+10]), "+v"(x[o+11]), "+v"(x[o+12]), "+v"(x[o+13]), "+v"(x[o+14]), "+v"(x[o+15]))
#define PEER_SWAIT() asm volatile("s_waitcnt lgkmcnt(0)" ::: "memory")
#define PEER_VWAIT(N) asm volatile("s_waitcnt vmcnt(" #N ")" ::: "memory")
#define PEER_VWAIT_PF() do { if (PEER_PF == 8) PEER_VWAIT(12); else if (PEER_PF == 6) PEER_VWAIT(8); else if (PEER_PF == 4) PEER_VWAIT(4); else PEER_VWAIT(0); } while (0)
__device__ __forceinline__ f32x32 row32(const LAS unsigned char* slot, int lane) {
    typedef unsigned u32x2 __attribute__((ext_vector_type(2)));
    const LAS u32x2* p = (const LAS u32x2*)(slot + lane * 24);
    const u32x2 d0 = p[0], d1 = p[1], d2 = p[2];
    const u32x6 src = (u32x6){d0.x, d0.y, d1.x, d1.y, d2.x, d2.y};
    const f32x32 f = __builtin_amdgcn_cvt_scalef32_pk32_f32_fp6(src, 1.0f);
    asm volatile("" :: "v"(src));
    return f;
}

__device__ __forceinline__ void phase_peer(const Args& a, LAS unsigned char* lds, int vcu, int G, int tid, int wave, int lane, float* dst, int imask = -1) {
    const float* mod = (const float*)(a.ws + WS_MOD);
    const bf16* XN = (const bf16*)(a.ws + WS_XN); const char* Ub = (const char*)(a.ws + WS_UB); const char* Vb = (const char*)(a.ws + WS_VB);
    const int* IDX = (const int*)(a.ws + WS_IDX); const float* GATE = (const float*)(a.ws + WS_GATE);
    LAS float* gfin = (LAS float*)(lds + XTRA_OFF + 64);
#pragma unroll
    for (int i = 0; i < 4; ++i) { const int k = tid + NTHR * i; gfin[k] = mod[5 * D + k] * a.in[7][k]; }
    __syncthreads();
    const int gw = vcu * NWAVES + wave, NGW = G * NWAVES;
    const int ntok = (S - gw + NGW - 1) / NGW;
    if (ntok <= 0) return;
    const int nbb = ntok * 8;
    const unsigned ring = (unsigned)(uintptr_t)(lds + RING_OFF) + (unsigned)wave * 16384u;
    const LAS unsigned char* ringp = lds + RING_OFF + wave * 16384;
    const unsigned voff = (unsigned)lane * 16u;
    i32x16 ic, in_; f32x16s gc;
    sload16(ic, IDX + (size_t)gw * 128);
    in_ = ic;
#define ROWU(v, e) (Ub + (size_t)(unsigned)((v)[e] & imask) * ROWB)
#define ROWV(v, e) (Vb + (size_t)(unsigned)((v)[e] & imask) * ROWB)
#ifndef PEER_PF
#define PEER_PF 8
#endif
#define SLOT(n) (((n) % PEER_PF) * 2048)
#pragma unroll
    for (int e = 0; e < PEER_PF; ++e) dma_row(ROWU(ic, e), ring + SLOT(e), voff);
    int eo[32];
    {
        f32x16v ta, tb;
#pragma unroll
        for (int i = 0; i < 16; ++i) { ta[i] = 0.125f * (float)i; tb[i] = (i < 8) ? 2.f + 0.25f * (float)i : 4.f + 0.5f * (float)(i - 8); }
        const u32x6 tp = __builtin_amdgcn_cvt_scalef32_2xpk16_fp6_f32(ta, tb, 1.0f);
        asm volatile("" :: "v"(ta), "v"(tb));
        const f32x32 tf = __builtin_amdgcn_cvt_scalef32_pk32_f32_fp6(tp, 1.0f);
        asm volatile("" :: "v"(tp));
#pragma unroll
        for (int p = 0; p < 32; ++p) { const float v = tf[p]; const int i = (v < 2.f) ? (int)(v * 8.f) : (v < 4.f) ? 16 + (int)((v - 2.f) * 4.f) : 24 + (int)((v - 4.f) * 2.f);
            eo[p] = ((i & 16) ? 1024 : 0) + lane * 16 + (i & 15); }
    }
    float hp[32];
    float op[32];
    int tok = gw;
    for (int bb = 0; bb < nbb; ++bb) {
        const int b = bb & 7;
        if (b == 0) {
            tok = gw + (bb >> 3) * NGW;
#pragma unroll
            for (int p = 0; p < 32; ++p) hp[p] = bf2f(XN[(size_t)tok * D + eo[p]]);
            PIN16(hp, 0); PIN16(hp, 16);
#pragma unroll
            for (int p = 0; p < 32; ++p) op[p] = 0.f;
        }
        {
            const int nb = (bb + 1 < nbb) ? bb + 1 : bb;
            const size_t nofs = (size_t)(gw + (nb >> 3) * NGW) * 128 + (nb & 7) * 16;
            i32x16 gtmp;
            sload16x2(gtmp, GATE + (size_t)tok * 128 + b * 16, in_, IDX + nofs);
            gc = __builtin_bit_cast(f32x16s, gtmp);
        }
        float s[16];
#pragma unroll
        for (int st = 0; st < 8; ++st) {
            PEER_VWAIT_PF();
            const f32x32 f0 = row32(ringp + SLOT(2 * st), lane), f1 = row32(ringp + SLOT(2 * st + 1), lane);
            PEER_SWAIT();
            {
                const int e8 = 2 * st + PEER_PF;
                if (e8 < 16) { dma_row(ROWU(ic, e8), ring + SLOT(2 * st), voff); dma_row(ROWU(ic, e8 + 1), ring + SLOT(2 * st + 1), voff); }
                else { dma_row(ROWV(ic, e8 - 16), ring + SLOT(2 * st), voff); dma_row(ROWV(ic, e8 - 15), ring + SLOT(2 * st + 1), voff); }
            }
            float a0 = 0.f, a1 = 0.f, b0 = 0.f, b1 = 0.f;
#pragma unroll
            for (int p = 0; p < 32; p += 2) { a0 += f0[p] * hp[p]; b0 += f0[p + 1] * hp[p + 1]; a1 += f1[p] * hp[p]; b1 += f1[p + 1] * hp[p + 1]; }
            s[2 * st] = a0 + b0; s[2 * st + 1] = a1 + b1;
            asm volatile("" : "+v"(s[2 * st]), "+v"(s[2 * st + 1]));
        }
        float u[4];
        {
            float t8[8];
#pragma unroll
            for (int e = 0; e < 8; ++e) { auto rr = __builtin_amdgcn_permlane32_swap(__float_as_uint(s[e]), __float_as_uint(s[e + 8]), false, false); t8[e] = __uint_as_float(rr[0]) + __uint_as_float(rr[1]); }
#pragma unroll
            for (int e = 0; e < 4; ++e) { auto rr = __builtin_amdgcn_permlane16_swap(__float_as_uint(t8[e]), __float_as_uint(t8[e + 4]), false, false); u[e] = __uint_as_float(rr[0]) + __uint_as_float(rr[1]); }
#pragma unroll
            for (int e = 0; e < 4; ++e) { u[e] += dpp_ror<8>(u[e]); u[e] += dpp_ror<4>(u[e]); u[e] += dpp_ror<2>(u[e]); u[e] += dpp_ror<1>(u[e]); }
        }
        if (b == 7) {
            const float* xp = (const float*)(a.ws + WS_X1) + (size_t)tok * D;
#pragma unroll
            for (int p = 0; p < 32; ++p) hp[p] = xp[eo[p]];
        }
        float actv;
        { const int k = lane & 3; const float d = ((k == 0) ? u[0] : (k == 1) ? u[1] : (k == 2) ? u[2] : u[3]) * (1.f / U_SCALE);
          actv = 0.5f * d * (1.f + erff(d * 0.70710678118654752f)) * (1.f / V_SCALE); }
#pragma unroll
        for (int st = 0; st < 8; ++st) {
            PEER_VWAIT_PF();
            const f32x32 f0 = row32(ringp + SLOT(2 * st), lane), f1 = row32(ringp + SLOT(2 * st + 1), lane);
            PEER_SWAIT();
            {
                const int e8 = 2 * st + PEER_PF;
                if (e8 < 16) { dma_row(ROWV(ic, e8), ring + SLOT(2 * st), voff); dma_row(ROWV(ic, e8 + 1), ring + SLOT(2 * st + 1), voff); }
                else { dma_row(ROWU(in_, e8 - 16), ring + SLOT(2 * st), voff); dma_row(ROWU(in_, e8 - 15), ring + SLOT(2 * st + 1), voff); }
            }
            const int e0 = 2 * st, e1 = 2 * st + 1;
            const float g0 = __int_as_float(__builtin_amdgcn_readlane(__float_as_int(actv), 16 * (e0 >> 2) + (e0 & 3))) * gc[e0], g1 = __int_as_float(__builtin_amdgcn_readlane(__float_as_int(actv), 16 * (e1 >> 2) + (e1 & 3))) * gc[e1];
#pragma unroll
            for (int p = 0; p < 32; ++p) op[p] += g0 * f0[p] + g1 * f1[p];
            PIN16(op, 16);
            PIN16(op, 0);
        }
        ic = in_;
        if (b == 7) {
            float ss = 0.f;
#pragma unroll
            for (int p = 0; p < 32; ++p) ss += op[p] * op[p];
            const float r = rsqrtf(wave_sum(ss) * (1.f / D) + EPS);
            float* dp = dst + (size_t)tok * D;
#pragma unroll
            for (int p = 0; p < 32; ++p) dp[eo[p]] = hp[p] + op[p] * r * gfin[eo[p]];
        }
    }
    PEER_VWAIT(0);
#undef ROWU
#undef ROWV
#undef SLOT
}
#undef PEER_SWAIT
#undef PEER_VWAIT
}

namespace peer3 {
using peer::i32x16; using peer::f32x16s; using peer::u32x6; using peer::f32x32; using peer::f32x16v; using peer::ROWB; using peer::U_SCALE; using peer::V_SCALE; using peer::dpp_ror;
using peer::sload16; using peer::sload16x2;
typedef unsigned u32x2 __attribute__((ext_vector_type(2)));
struct Raw { u32x2 a, b, c; };
__device__ __forceinline__ Raw load_row(const char* lanebase, int idx) {
    const u32x2* gp = (const u32x2*)(lanebase + (size_t)(unsigned)idx * ROWB);
    Raw r; r.a = gp[0]; r.b = gp[1]; r.c = gp[2]; return r;
}
__device__ __forceinline__ f32x32 decode(const Raw& r) {
    const u32x6 src = (u32x6){r.a.x, r.a.y, r.b.x, r.b.y, r.c.x, r.c.y};
    const f32x32 f = __builtin_amdgcn_cvt_scalef32_pk32_f32_fp6(src, 1.0f);
    asm volatile("" :: "v"(src));
    return f;
}
__device__ __forceinline__ void calibrate(int (&eo)[32], int lane, float zero) {
    f32x16v ta, tb;
#pragma unroll
    for (int i = 0; i < 16; ++i) { ta[i] = 0.125f * (float)i + zero; tb[i] = ((i < 8) ? 2.f + 0.25f * (float)i : 4.f + 0.5f * (float)(i - 8)) + zero; }
    const u32x6 tp = __builtin_amdgcn_cvt_scalef32_2xpk16_fp6_f32(ta, tb, 1.0f);
    asm volatile("" :: "v"(ta), "v"(tb));
    const f32x32 tf = __builtin_amdgcn_cvt_scalef32_pk32_f32_fp6(tp, 1.0f);
    asm volatile("" :: "v"(tp));
#pragma unroll
    for (int p = 0; p < 32; ++p) { const float v = tf[p]; const int i = (v < 2.f) ? (int)(v * 8.f) : (v < 4.f) ? 16 + (int)((v - 2.f) * 4.f) : 24 + (int)((v - 4.f) * 2.f);
        eo[p] = ((i & 16) ? 1024 : 0) + lane * 16 + (i & 15); }
}
#define PIN16(x, o) asm volatile("" : "+v"(x[o]), "+v"(x[o+1]), "+v"(x[o+2]), "+v"(x[o+3]), "+v"(x[o+4]), "+v"(x[o+5]), "+v"(x[o+6]), "+v"(x[o+7]), "+v"(x[o+8]), "+v"(x[o+9]), "+v"(x[o+10]), "+v"(x[o+11]), "+v"(x[o+12]), "+v"(x[o+13]), "+v"(x[o+14]), "+v"(x[o+15]))

template <int MODE = 0>
__device__ __forceinline__ void phase_peer(const Args& a, LAS unsigned char* lds, int vcu, int G, int tid, int wave, int lane, float* dst, int imask = -1) {
    const float* mod = (const float*)(a.ws + WS_MOD);
    const bf16* XN = (const bf16*)(a.ws + WS_XN); const char* Ul = (const char*)(a.ws + WS_UB) + lane * 24; const char* Vl = (const char*)(a.ws + WS_VB) + lane * 24;
    const int* IDX = (const int*)(a.ws + WS_IDX); const float* GATE = (const float*)(a.ws + WS_GATE);
    LAS float* gfin = (LAS float*)(lds + XTRA_OFF + 64);
#pragma unroll
    for (int i = 0; i < 4; ++i) { const int k = tid + NTHR * i; gfin[k] = mod[5 * D + k] * a.in[7][k]; }
    __syncthreads();
    const int gw = vcu * NWAVES + wave, NGW = G * NWAVES;
    const int ntok = (S - gw + NGW - 1) / NGW;
    if (ntok <= 0) return;
    const int nbb = ntok * 8;
    i32x16 ic, in_; f32x16s gc;
    sload16(ic, IDX + (size_t)gw * 128);
    in_ = ic;
#define ROWU(v, e) load_row(Ul, (v)[e] & imask)
#define ROWV(v, e) load_row(Vl, (v)[e] & imask)
    Raw raw[8];
#pragma unroll
    for (int e = 0; e < 8; ++e) raw[e] = ROWU(ic, e);
    float hp[32];
    float op[32];
    int tok = gw;
    for (int bb = 0; bb < nbb; ++bb) {
        const int b = bb & 7;
        if (b == 0) {
            tok = gw + (bb >> 3) * NGW;
            int eo[32]; { int l2 = lane; float z = 0.f; asm volatile("" : "+v"(l2), "+v"(z)); calibrate(eo, l2, z); }
#pragma unroll
            for (int p = 0; p < 32; ++p) hp[p] = bf2f(XN[(size_t)tok * D + eo[p]]);
            PIN16(hp, 0); PIN16(hp, 16);
#pragma unroll
            for (int p = 0; p < 32; ++p) op[p] = 0.f;
        }
        {
            const int nb = (bb + 1 < nbb) ? bb + 1 : bb;
            const size_t nofs = (size_t)(gw + (nb >> 3) * NGW) * 128 + (nb & 7) * 16;
            i32x16 gtmp;
            sload16x2(gtmp, GATE + (size_t)tok * 128 + b * 16, in_, IDX + nofs);
            gc = __builtin_bit_cast(f32x16s, gtmp);
        }
        float s[16];
#pragma unroll
        for (int n = 0; n < 16; ++n) {
            f32x32 f = decode(raw[n & 7]);
            asm volatile("" : "+v"(f) :: "memory");
            if (MODE != 2) raw[n & 7] = (n + 8 < 16) ? ROWU(ic, n + 8) : ROWV(ic, n - 8);
            float a0 = 0.f, a1 = 0.f, a2 = 0.f, a3 = 0.f;
#pragma unroll
            for (int p = 0; p < (MODE == 1 ? 4 : 32); p += 4) { a0 += f[p] * hp[p]; a1 += f[p + 1] * hp[p + 1]; a2 += f[p + 2] * hp[p + 2]; a3 += f[p + 3] * hp[p + 3]; }
            s[n] = (a0 + a1) + (a2 + a3);
            asm volatile("" : "+v"(s[n]));
        }
        float u[4];
        {
            float t8[8];
#pragma unroll
            for (int e = 0; e < 8; ++e) { auto rr = __builtin_amdgcn_permlane32_swap(__float_as_uint(s[e]), __float_as_uint(s[e + 8]), false, false); t8[e] = __uint_as_float(rr[0]) + __uint_as_float(rr[1]); }
#pragma unroll
            for (int e = 0; e < 4; ++e) { auto rr = __builtin_amdgcn_permlane16_swap(__float_as_uint(t8[e]), __float_as_uint(t8[e + 4]), false, false); u[e] = __uint_as_float(rr[0]) + __uint_as_float(rr[1]); }
#pragma unroll
            for (int e = 0; e < 4; ++e) { u[e] += dpp_ror<8>(u[e]); u[e] += dpp_ror<4>(u[e]); u[e] += dpp_ror<2>(u[e]); u[e] += dpp_ror<1>(u[e]); }
        }
        int eo[32];
        if (b == 7) {
            { int l2 = lane; float z = 0.f; asm volatile("" : "+v"(l2), "+v"(z)); calibrate(eo, l2, z); }
            const float* xp = (const float*)(a.ws + WS_X1) + (size_t)tok * D;
#pragma unroll
            for (int p = 0; p < 32; ++p) hp[p] = xp[eo[p]];
        }
        float actv;
        { const int k = lane & 3; const float d = ((k == 0) ? u[0] : (k == 1) ? u[1] : (k == 2) ? u[2] : u[3]) * (1.f / U_SCALE);
          actv = 0.5f * d * (1.f + erff(d * 0.70710678118654752f)) * (1.f / V_SCALE); }
#pragma unroll
        for (int n = 0; n < 16; ++n) {
            f32x32 f = decode(raw[n & 7]);
            asm volatile("" : "+v"(f) :: "memory");
            if (MODE != 2) raw[n & 7] = (n + 8 < 16) ? ROWV(ic, n + 8) : ROWU(in_, n - 8);
            const float g = __int_as_float(__builtin_amdgcn_readlane(__float_as_int(actv), 16 * (n >> 2) + (n & 3))) * gc[n];
#pragma unroll
            for (int p = 0; p < (MODE == 1 ? 2 : 32); ++p) op[p] += g * f[p];
            if (n & 1) { PIN16(op, 16); PIN16(op, 0); }
        }
        ic = in_;
        if (b == 7) {
            float ss = 0.f;
#pragma unroll
            for (int p = 0; p < 32; ++p) ss += op[p] * op[p];
            const float r = rsqrtf(wave_sum(ss) * (1.f / D) + EPS);
            float* dp = dst + (size_t)tok * D;
#pragma unroll
            for (int p = 0; p < 32; ++p) dp[eo[p]] = hp[p] + op[p] * r * gfin[eo[p]];
        }
    }
#undef ROWU
#undef ROWV
}
#undef PIN16
}

namespace topk {
using f32x16 = __attribute__((ext_vector_type(16))) float;
constexpr int LDS_KIMG = 0, LDS_TK = 65536;
__device__ __forceinline__ float swapf(float m) { auto rr = __builtin_amdgcn_permlane32_swap(__float_as_uint(m), __float_as_uint(m), false, false); return (threadIdx.x & 32) ? __uint_as_float(rr[0]) : __uint_as_float(rr[1]); }
__device__ __forceinline__ float max3(float a, float b, float c) { return fmaxf(fmaxf(a, b), c); }

__device__ __forceinline__ void half_topk(const bf16* qrow  , const LAS unsigned char* kimg, int r32, int hi, float (&vals)[16]) {
    bf16x8 qf[8];
#pragma unroll
    for (int ks = 0; ks < 8; ++ks) qf[ks] = *(const bf16x8*)(qrow + ks * 16 + hi * 8);
    float p[64];
#pragma unroll
    for (int blk = 0; blk < 4; ++blk) {
        f32x16 acc = f32x16{};
#pragma unroll
        for (int ks = 0; ks < 8; ++ks) {
            const bf16x8 kf = *(const LAS bf16x8*)(kimg + (ks * 2 + hi) * 2048 + (32 * blk + r32) * 16);
            acc = __builtin_amdgcn_mfma_f32_32x32x16_bf16(kf, qf[ks], acc, 0, 0, 0);
        }
#pragma unroll
        for (int r = 0; r < 16; ++r) { const int key = 32 * blk + (r & 3) + 8 * (r >> 2) + 4 * hi; p[blk * 16 + r] = __uint_as_float((__float_as_uint(acc[r]) & 0xffffff80u) | (unsigned)(127 - key)); }
    }
#pragma unroll
    for (int rd = 0; rd < 16; ++rd) {
        float m = max3(p[0], p[1], p[2]);
#pragma unroll
        for (int i = 3; i < 63; i += 2) m = max3(m, p[i], p[i + 1]);
        m = fmaxf(m, p[63]);
        const float g = fmaxf(m, swapf(m));
        vals[rd] = g;
#pragma unroll
        for (int i = 0; i < 64; ++i) p[i] = (__float_as_uint(p[i]) == __float_as_uint(g)) ? -INFINITY : p[i];
    }
}

__device__ __forceinline__ void phase_topk(const Args& a, LAS unsigned char* lds, int vcu, int G, int tid, int wave, int lane) {
    for (int e = tid; e < 2 * 128 * 16; e += NTHR) {
        const int half = e >> 11, key = (e >> 4) & 127, c = e & 15;
        const float* src = a.in[20 + half] + key * 128 + c * 8;
        const f32x4 x0 = *(const f32x4*)src, x1 = *(const f32x4*)(src + 4);
        v4u o; o.x = pk2(x0.x, x0.y); o.y = pk2(x0.z, x0.w); o.z = pk2(x1.x, x1.y); o.w = pk2(x1.z, x1.w);
        *(LAS v4u*)(lds + LDS_KIMG + half * 32768 + c * 2048 + key * 16) = o;
    }
    __syncthreads();
    const bf16* QP = (const bf16*)(a.ws + WS_QP); int* idx_out = (int*)(a.ws + WS_IDX); float* g_out = (float*)(a.ws + WS_GATE);
    const int r32 = lane & 31, hi = lane >> 5;
    LAS int* tk = (LAS int*)(lds + LDS_TK + wave * 4096) + r32 * 32;
    const int gw = vcu * NWAVES + wave, NGW = G * NWAVES;
    if (wave < 4) convert_tables(a, CVT_EARLY_ROWS, 2 * NEXP, gw, NGW, lane);
    for (int task = gw; task < (S / 32) * PH; task += NGW) {
        const int tb = task >> 3, h = task & 7, token = tb * 32 + r32;
        const bf16* qrow = QP + (size_t)token * D + h * PKD;
        float v1[16], v2[16];
        half_topk(qrow, lds + LDS_KIMG, r32, hi, v1);
        half_topk(qrow + 128, lds + LDS_KIMG + 32768, r32, hi, v2);
        if (hi == 0) {
#pragma unroll
            for (int i = 0; i < 16; ++i) { tk[i] = 127 - (int)(__float_as_uint(v1[i]) & 0x7fu); tk[16 + i] = 127 - (int)(__float_as_uint(v2[i]) & 0x7fu); }
        }
        float c[25];
        {
            int k = 0;
#pragma unroll
            for (int ai = 0; ai < 16; ++ai)
#pragma unroll
                for (int bi = 0; bi < 16; ++bi) if ((ai + 1) * (bi + 1) <= 16) {
                    const float sm = __uint_as_float(__float_as_uint(v1[ai]) & 0xffffff80u) + __uint_as_float(__float_as_uint(v2[bi]) & 0xffffff80u);
                    const float pk = __uint_as_float((__float_as_uint(sm) & 0xffffff00u) | (unsigned)(255 - (ai * 16 + bi)));
                    if ((k & 1) == 0) c[k >> 1] = pk; else c[k >> 1] = hi ? pk : c[k >> 1];
                    ++k;
                }
        }
        float top[16];
#pragma unroll
        for (int rd = 0; rd < 16; ++rd) {
            float m = c[0];
#pragma unroll
            for (int i = 1; i < 25; i += 2) m = max3(m, c[i], c[i + 1]);
            const float g = fmaxf(m, swapf(m));
            top[rd] = g;
#pragma unroll
            for (int i = 0; i < 25; ++i) c[i] = (__float_as_uint(c[i]) == __float_as_uint(g)) ? -INFINITY : c[i];
        }
        asm volatile("s_waitcnt lgkmcnt(0)" ::: "memory");
        const float mx = __uint_as_float(__float_as_uint(top[0]) & 0xffffff00u);
        float ev[16], den = 0.f;
#pragma unroll
        for (int i = 0; i < 16; ++i) { ev[i] = __expf(__uint_as_float(__float_as_uint(top[i]) & 0xffffff00u) - mx); den += ev[i]; }
        const float rden = 1.f / den;
        if (hi == 0) {
            const size_t ob = ((size_t)token * PH + h) * PTOP;
#pragma unroll
            for (int q4 = 0; q4 < 4; ++q4) {
                int oi[4]; float og[4];
#pragma unroll
                for (int i = 0; i < 4; ++i) { const int flat = 255 - (int)(__float_as_uint(top[q4 * 4 + i]) & 0xffu); oi[i] = tk[flat >> 4] * PKEYS + tk[16 + (flat & 15)]; og[i] = ev[q4 * 4 + i] * rden; }
                *(v4u*)(idx_out + ob + q4 * 4) = (v4u){(unsigned)oi[0], (unsigned)oi[1], (unsigned)oi[2], (unsigned)oi[3]};
                *(f32x4*)(g_out + ob + q4 * 4) = (f32x4){og[0], og[1], og[2], og[3]};
            }
        }
        asm volatile("s_waitcnt lgkmcnt(0)" ::: "memory");
    }
    if (wave >= 4) convert_tables(a, CVT_EARLY_ROWS, 2 * NEXP, gw, NGW, lane);
}
}

namespace conv {
constexpr int TCH = 32, ROWS = TCH + CK - 1;
constexpr int LDS_U = 0, LDS_PART = ROWS * CW * 2, LDS_STAT = LDS_PART + 8 * 64 * 4;
template <int N> __device__ __forceinline__ float dpp_ror(float v) { return __int_as_float(__builtin_amdgcn_update_dpp(0, __float_as_int(v), 0x120 + N, 0xf, 0xf, false)); }

__device__ __forceinline__ void phase_conv(const Args& a, LAS unsigned char* lds, int vcu, int G, int tid, int wave, int lane) {
    const bf16* PROJ = (const bf16*)(a.ws + WS_PROJ); bf16* Y = (bf16*)(a.ws + WS_Y);
    const float* conv_w = a.in[14]; const float* conv_b = a.in[15]; const float* ln_g = a.in[16]; const float* ln_b = a.in[17];
    LAS unsigned* ut = (LAS unsigned*)(lds + LDS_U);
    LAS float* part = (LAS float*)(lds + LDS_PART);
    LAS float* stat = (LAS float*)(lds + LDS_STAT);
    float w0[CK], w1[CK];
#pragma unroll
    for (int j = 0; j < CK; ++j) { const float2 wv = *(const float2*)(conv_w + j * CW + 2 * tid); w0[j] = wv.x; w1[j] = wv.y; }
    const float2 cb = *(const float2*)(conv_b + 2 * tid), lg = *(const float2*)(ln_g + 2 * tid), lb = *(const float2*)(ln_b + 2 * tid);
    for (int ch = vcu; ch < S / TCH; ch += G) {
        const int t0 = ch * TCH;
        __syncthreads();
#pragma unroll 8
        for (int r = 0; r < ROWS; ++r) {
            const int tt = t0 - (CK - 1) + r;
            unsigned pk = 0u;
            if (tt >= 0) {
                const unsigned av = *((const unsigned*)(PROJ + (size_t)tt * INC + 3 * AW) + tid);
                const unsigned gv = *((const unsigned*)(PROJ + (size_t)tt * INC + 3 * AW + CW) + tid);
                pk = pk2(bflo(av) * __builtin_amdgcn_rcpf(1.f + __expf(-bflo(gv))), bfhi(av) * __builtin_amdgcn_rcpf(1.f + __expf(-bfhi(gv))));
            }
            ut[r * 512 + tid] = pk;
        }
        __syncthreads();
        float y0[TCH], y1[TCH];
#pragma unroll
        for (int g8 = 0; g8 < 4; ++g8) {
            unsigned uu[38];
#pragma unroll
            for (int r = 0; r < 38; ++r) uu[r] = ut[(g8 * 8 + r) * 512 + tid];
#pragma unroll
            for (int t = 0; t < 8; ++t) {
                float s0 = cb.x, s1 = cb.y;
#pragma unroll
                for (int j = 0; j < CK; ++j) { s0 += w0[j] * bflo(uu[t + j]); s1 += w1[j] * bfhi(uu[t + j]); }
                y0[g8 * 8 + t] = s0; y1[g8 * 8 + t] = s1;
            }
        }
#pragma unroll
        for (int hf = 0; hf < 2; ++hf) {
            float v[32];
#pragma unroll
            for (int t = 0; t < 16; ++t) { const float a0 = y0[hf * 16 + t], a1 = y1[hf * 16 + t]; v[2 * t] = a0 + a1; v[2 * t + 1] = a0 * a0 + a1 * a1; }
            float h16[16];
#pragma unroll
            for (int i = 0; i < 16; ++i) { auto rr = __builtin_amdgcn_permlane32_swap(__float_as_uint(v[i]), __float_as_uint(v[i + 16]), false, false); h16[i] = __uint_as_float(rr[0]) + __uint_as_float(rr[1]); }
            float h8[8];
#pragma unroll
            for (int i = 0; i < 8; ++i) { auto rr = __builtin_amdgcn_permlane16_swap(__float_as_uint(h16[i]), __float_as_uint(h16[i + 8]), false, false); h8[i] = __uint_as_float(rr[0]) + __uint_as_float(rr[1]); }
#pragma unroll
            for (int i = 0; i < 8; ++i) { h8[i] += dpp_ror<8>(h8[i]); h8[i] += dpp_ror<4>(h8[i]); h8[i] += dpp_ror<2>(h8[i]); h8[i] += dpp_ror<1>(h8[i]); }
            if ((lane & 15) == 0) {
                *(LAS f32x4*)(part + wave * 64 + hf * 32 + 8 * (lane >> 4)) = (f32x4){h8[0], h8[1], h8[2], h8[3]};
                *(LAS f32x4*)(part + wave * 64 + hf * 32 + 8 * (lane >> 4) + 4) = (f32x4){h8[4], h8[5], h8[6], h8[7]};
            }
        }
        __syncthreads();
        if (tid < TCH) {
            float s = 0.f, ss = 0.f;
#pragma unroll
            for (int w = 0; w < 8; ++w) { s += part[w * 64 + 2 * tid]; ss += part[w * 64 + 2 * tid + 1]; }
            const float mu = s * (1.f / CW), var = fmaxf(ss * (1.f / CW) - mu * mu, 0.f);
            stat[2 * tid] = mu; stat[2 * tid + 1] = rsqrtf(var + EPS);
        }
        __syncthreads();
#pragma unroll
        for (int t = 0; t < TCH; ++t) {
            const float mu = stat[2 * t], rs = stat[2 * t + 1];
            const float v0 = (y0[t] - mu) * rs * lg.x + lb.x, v1 = (y1[t] - mu) * rs * lg.y + lb.y;
            *((unsigned*)(Y + (size_t)(t0 + t) * D + AW) + tid) = pk2(v0 * __builtin_amdgcn_rcpf(1.f + __expf(-v0)), v1 * __builtin_amdgcn_rcpf(1.f + __expf(-v1)));
        }
    }
}
}
#ifndef PROBE_ID
#define PROBE_ID (-1)
#endif
#ifndef PROBE_K
#define PROBE_K 8
#endif
#define TICK(k) do { if (PROBE_ID >= 0) { const unsigned long long now_ = __builtin_amdgcn_s_memrealtime(); if (PROBE_ID == (k)) tsel_ = now_ - tprev_; tprev_ = now_; } } while (0)
#define TOCK() do { if (PROBE_ID >= 0) tprev_ = __builtin_amdgcn_s_memrealtime(); } while (0)
#ifndef REP_P0A
#define REP_P0A 1
#endif
#ifndef REP_P0B
#define REP_P0B 1
#endif
#ifndef REP_P1
#define REP_P1 1
#endif
#ifndef REP_CONV
#define REP_CONV 1
#endif
#ifndef REP_ATT
#define REP_ATT 1
#endif
#ifndef REP_P3
#define REP_P3 1
#endif
#ifndef REP_P3B
#define REP_P3B 1
#endif
#ifndef REP_P4
#define REP_P4 1
#endif
#ifndef REP_P5
#define REP_P5 1
#endif
#ifndef REP_P6
#define REP_P6 1
#endif
#ifndef REP_BAR
#define REP_BAR 1
#endif
#define REPEAT(n) _Pragma("unroll 1") for (int rep_ = 0; rep_ < (n); ++rep_)
__global__ void __launch_bounds__(NTHR, 2) mega_fwd(Args args) {
    extern __shared__ __attribute__((aligned(16))) unsigned char lds_raw[];
    LAS unsigned char* lds = (LAS unsigned char*)lds_raw;
    int tid = threadIdx.x, lane = tid & 63, wave = __builtin_amdgcn_readfirstlane(tid >> 6);
    const int G = gridDim.x; const int bx = blockIdx.x; const int vcu = (G % 8 == 0) ? (bx % 8) * (G / 8) + bx / 8 : bx;
    for (int u = tid; u < (LDS_BYTES - LDSCTL_OFF) / 4; u += NTHR) ((LAS unsigned*)(lds + LDSCTL_OFF))[u] = 0u;
    __syncthreads();
    gu32* ctl = (gu32*)(args.ws + WS_CTL);
    XcdBarrier bar = xcd_barrier_post((unsigned*)(ctl + CW_BAR), (volatile LAS unsigned*)(lds + MISC_OFF) + 8);

    unsigned long long tprev_ = 0, tsel_ = 0;
#define RETID() do { int t_ = threadIdx.x; asm volatile("" : "+v"(t_)); tid = t_; lane = tid & 63; wave = __builtin_amdgcn_readfirstlane(tid >> 6); } while (0)
    TOCK(); REPEAT(REP_P0A) { RETID(); phase_p0a(args, lds, vcu, G, tid, wave, lane); }
    TICK(0);
    REPEAT(REP_BAR) xcd_barrier(bar);
    TICK(10);
    TOCK(); REPEAT(REP_P0B) { RETID(); phase_p0b(args, lds, vcu, G, tid, wave, lane); }
    TICK(1);
    xcd_barrier(bar);
    TICK(11);
    TOCK(); REPEAT(REP_P1) {
        pg8::Gemm g{(const pg8::bf16_t*)(args.ws + WS_XN), (const pg8::bf16_t*)(args.ws + WS_WIN), S, INC, D};
        pg8::StaticOrder So; So.init(S, INC, G, bx);
        pg8::EpiBf16<0> E{(pg8::bf16_t*)(args.ws + WS_PROJ), INC, nullptr, AW, (size_t)AW, C2};
        pg8::gemm_phase<pg8::EpiBf16<0>, pg8::StaticOrder, true, true>(lds + RING_OFF, g, So, E);
    }
    TICK(2);
    xcd_barrier(bar);
    TICK(12);
    TOCK(); REPEAT(REP_CONV) { RETID(); conv::phase_conv(args, lds, vcu, G, tid, wave, lane); }
    TICK(3);
    TOCK(); REPEAT(REP_ATT) { RETID(); att::attn_phase(args, lds, vcu, G, lane); }
    TICK(4);
    xcd_barrier(bar);
    TICK(13);
    TOCK(); REPEAT(REP_P3) {
        pg8::Gemm g{(const pg8::bf16_t*)(args.ws + WS_Y), (const pg8::bf16_t*)(args.ws + WS_WOUT), S, D, D};
        pg8::StaticOrder So; So.init(S, D, G, bx);
        pg8::EpiBf16<0> E{(pg8::bf16_t*)(args.ws + WS_MIX), D, nullptr, 0, 0, 1.f};
        pg8::gemm_phase<pg8::EpiBf16<0>, pg8::StaticOrder, true, true>(lds + RING_OFF, g, So, E);
    }
    TICK(5);
    xcd_barrier(bar);
    TICK(14);
    TOCK(); REPEAT(REP_P3B) { RETID(); phase_p3b(args, lds, vcu, G, tid, wave, lane); }
    TICK(6);
    xcd_barrier(bar);
    TICK(15);
    TOCK(); REPEAT(REP_P4) {
        pg8::Gemm g{(const pg8::bf16_t*)(args.ws + WS_XN), (const pg8::bf16_t*)(args.ws + WS_WQ), S, D, D};
        pg8::StaticOrder So; So.init(S, D, G, bx);
        pg8::EpiBf16<0> E{(pg8::bf16_t*)(args.ws + WS_QP), D, nullptr, 0, 0, 1.f};
        pg8::gemm_phase<pg8::EpiBf16<0>, pg8::StaticOrder, true, true>(lds + RING_OFF, g, So, E);
    }
    TICK(7);
    xcd_barrier(bar);
    TICK(16);
    TOCK(); REPEAT(REP_P5) { RETID(); topk::phase_topk(args, lds, vcu, G, tid, wave, lane); }
    TICK(8);
    xcd_barrier(bar);
    TICK(17);
#ifdef P6_PROBE_MASK
    { RETID(); peer3::phase_peer<P6_PROBE_MODE>(args, lds, vcu, G, tid, wave, lane, (float*)(args.ws + WS_MIX), P6_PROBE_MASK); } __syncthreads();
#endif
    TOCK(); REPEAT(REP_P6) { RETID(); peer3::phase_peer(args, lds, vcu, G, tid, wave, lane, (rep_ + 1 < REP_P6) ? (float*)(args.ws + WS_MIX) : args.out); }
    TICK(9);
    if (PROBE_ID >= 0 && blockIdx.x == 0) { const unsigned long long t0_ = __builtin_amdgcn_s_memrealtime(); while (__builtin_amdgcn_s_memrealtime() - t0_ < tsel_ * PROBE_K) __builtin_amdgcn_s_sleep(8); }
}

extern "C" void kernel_launch(void* const* d_in, const int* in_sizes, int n_in, void* d_out, int out_size, void* d_ws, size_t ws_size, hipStream_t stream) {
    static int grid = 0;
    if (grid == 0) {
        if (n_in != 24 || out_size != S * D || ws_size < WS_END) { fprintf(stderr, "kernel_launch: unexpected problem shape (n_in %d, out %d, ws %zu)\n", n_in, out_size, ws_size); grid = -1; return; }
        int dev = 0, cus = 0;
        if (hipGetDevice(&dev) != hipSuccess || hipDeviceGetAttribute(&cus, hipDeviceAttributeMultiprocessorCount, dev) != hipSuccess) { grid = -1; return; }
        if (hipFuncSetAttribute((const void*)mega_fwd, hipFuncAttributeMaxDynamicSharedMemorySize, LDS_BYTES) != hipSuccess) { fprintf(stderr, "kernel_launch: hipFuncSetAttribute failed\n"); grid = -1; return; }
        int per_cu = 0;
        if (hipOccupancyMaxActiveBlocksPerMultiprocessor(&per_cu, (const void*)mega_fwd, NTHR, LDS_BYTES) != hipSuccess || per_cu < 1) fprintf(stderr, "kernel_launch: occupancy query reports %d\n", per_cu);
        (void)hipGetLastError();
        grid = cus;
    }
    if (grid < 0) return;
    if (hipMemsetAsync((char*)d_ws + WS_CTL, 0, CTL_ZERO_BYTES, stream) != hipSuccess) return;
    Args a{};
    for (int i = 0; i < 24; ++i) a.in[i] = (const float*)d_in[i];
    a.out = (float*)d_out; a.ws = (unsigned char*)d_ws;
    hipLaunchKernelGGL(mega_fwd, dim3(grid), dim3(NTHR), LDS_BYTES, stream, a);
}
```

```cpp
#include <hip/hip_runtime.h>
#include <cstdio>
#include <cstdint>
#include <cmath>
namespace pg8 {
#define PG8_LAS __attribute__((address_space(3)))
typedef unsigned short bf16_t;
typedef short bf16x8 __attribute__((ext_vector_type(8)));
typedef float f32x4 __attribute__((ext_vector_type(4)));
typedef unsigned u32x4 __attribute__((ext_vector_type(4)));
constexpr int BM = 256, BK = 64, HALF = 128, HTB = HALF * BK * 2  , STAGE_BYTES = 8 * HTB, NXCD = 8, WGM = 8;

__host__ __device__ __forceinline__ int lds_byte(int r, int c) { const int st = (r >> 4) * 2 + (c >> 5), rr = r & 15, cc = c & 31, ob = rr * 64 + cc * 2; return st * 1024 + (ob ^ (((ob >> 9) & 1) << 5)); }
__host__ __device__ __forceinline__ void stage_rc(int b, int& R, int& C) { const int st = b / 1024, sb = b % 1024, swz = sb ^ (((sb >> 9) & 1) << 5); R = (st >> 1) * 16 + swz / 64; C = (st & 1) * 32 + (swz % 64) / 2; }
__host__ __device__ __forceinline__ int perm32(int rho) { const int n = rho >> 4, i = rho & 15; return 8 * (i >> 2) + 4 * n + (i & 3); }

struct Unit { int pm, pn; };
struct Gemm { const bf16_t* A; const bf16_t* Bt; int M, N, K; };

struct StaticOrder {
    int nM, nN, nwg, G, c;
    __host__ __device__ void init(int M, int N, int G_, int c_) { nM = M / BM; nN = N / BM; nwg = nM * nN; G = G_; c = c_; }
    __host__ __device__ bool next(int i, Unit& u) const {
        const long L = (long)i * G + c; if (L >= nwg) return false;
        int wgid = (int)L; { const int q = nwg / NXCD, r = nwg % NXCD, xcd = wgid % NXCD, off = wgid / NXCD; wgid = (xcd < r ? xcd * (q + 1) : r * (q + 1) + (xcd - r) * q) + off; }
        const int nig = WGM * nN, gid = wgid / nig, fm = gid * WGM, gsz = (nM - fm) < WGM ? (nM - fm) : WGM;
        u.pm = fm + ((wgid % nig) % gsz); u.pn = (wgid % nig) / gsz; return true;
    }
    __device__ __forceinline__ void a_ready(const Unit&) const {}
    __device__ __forceinline__ void done(const Unit&) const {}
};

__device__ __forceinline__ unsigned cvt_pk_bf16(float lo, float hi) { unsigned r; asm volatile("v_cvt_pk_bf16_f32 %0, %1, %2" : "=v"(r) : "v"(lo), "v"(hi)); return r; }
typedef float f32x2 __attribute__((ext_vector_type(2)));
__device__ __forceinline__ f32x2 gelu_pk(f32x2 v) {
    const f32x2 av = __builtin_elementwise_abs(v), d = av * 0.2316418882f + 1.0f;
    f32x2 t; t.x = __builtin_amdgcn_rcpf(d.x); t.y = __builtin_amdgcn_rcpf(d.y);
    f32x2 q = t * 0.5307027145f + (-0.7265760135f); q = q * t + 0.7107068705f; q = q * t + (-0.142248368f); q = q * t + 0.127414796f; q = q * t;
    const f32x2 s = (v * v) * (-0.72134752044f);
    f32x2 e; e.x = __builtin_amdgcn_exp2f(s.x); e.y = __builtin_amdgcn_exp2f(s.y);
    const f32x2 m = v * (q * e), r = v - m;
    f32x2 o; o.x = v.x < 0.f ? m.x : r.x; o.y = v.y < 0.f ? m.y : r.y; return o;
}

template <int ACT  > struct EpiBf16 {
    static constexpr bool PERM = true, AFTER_DRAIN = false; static_assert(ACT == 0 || ACT == 1, "EpiBf16: ACT is 0 (none) or 1 (gelu_pk)");
    bf16_t* O; int ldc; const float* bias; int split_cols; size_t split_stride; float scale0;
    __device__ __forceinline__ void operator()(const f32x4 (&acc)[2][2][4][2], const Unit& u, int wr, int wc, int fr, int fq) const {
        const int row0 = u.pm * BM + wr * 64 + fr; int colt = u.pn * BM; bf16_t* base = O;
        float sc = 1.f; if (split_cols) { const int t = colt / split_cols; base += (size_t)t * split_stride; colt -= t * split_cols; if (t == 0) sc = scale0; }
        const int col0 = colt + wc * 32 + 8 * fq, bcol0 = u.pn * BM + wc * 32 + 8 * fq;
        f32x4 bv[2][2];
#pragma unroll
        for (int bj = 0; bj < 2; ++bj)
#pragma unroll
            for (int n = 0; n < 2; ++n) bv[bj][n] = bias ? *(const f32x4*)(bias + bcol0 + bj * HALF + 4 * n) : (f32x4){0.f, 0.f, 0.f, 0.f};
#pragma unroll
        for (int ai = 0; ai < 2; ++ai)
#pragma unroll
            for (int m = 0; m < 4; ++m) { bf16_t* rowp = base + (size_t)(row0 + ai * HALF + m * 16) * ldc + col0;
#pragma unroll
                for (int bj = 0; bj < 2; ++bj) { f32x4 v0 = acc[ai][bj][m][0] + bv[bj][0], v1 = acc[ai][bj][m][1] + bv[bj][1];
                    if (ACT == 1) { f32x2 a = gelu_pk((f32x2){v0[0], v0[1]}), b = gelu_pk((f32x2){v0[2], v0[3]}), c = gelu_pk((f32x2){v1[0], v1[1]}), d = gelu_pk((f32x2){v1[2], v1[3]});
                        v0 = (f32x4){a.x, a.y, b.x, b.y}; v1 = (f32x4){c.x, c.y, d.x, d.y}; }
                    v0 = v0 * sc; v1 = v1 * sc; u32x4 w; w.x = cvt_pk_bf16(v0[0], v0[1]); w.y = cvt_pk_bf16(v0[2], v0[3]); w.z = cvt_pk_bf16(v1[0], v1[1]); w.w = cvt_pk_bf16(v1[2], v1[3]);
                    *(u32x4*)(rowp + bj * HALF) = w; } }
    }
};
template <class Epi, class Sched, bool ALIGN_EPI = false, bool SP2 = false>
__device__ __forceinline__ void gemm_phase(PG8_LAS unsigned char* lds, const Gemm g, const Sched& S, const Epi& E) {
    int tid_ = threadIdx.x; asm volatile("" : "+v"(tid_)); const int tid = tid_, wid = __builtin_amdgcn_readfirstlane(tid >> 6), lane = tid & 63, wr = wid >> 2, wc = wid & 3, fr = lane & 15, fq = lane >> 4;
    const int K = g.K, nt = K / BK;
    unsigned voffA[2], voffB[2];
#pragma unroll
    for (int i = 0; i < 2; ++i) { int R, C; stage_rc(tid * 16 + i * 8192, R, C); const int Rb = Epi::PERM ? ((R & ~31) + perm32(R & 31)) : R;
        voffA[i] = (unsigned)(R * K + C) * 2u; voffB[i] = (unsigned)(Rb * K + C) * 2u; }
    const size_t kstep = (size_t)(BK * 2);
    const size_t hstep = (size_t)HALF * K * 2;
    const size_t tstep = 2 * hstep;
    const unsigned ldsw = (unsigned)wid * 1024u;
    const int aoff = lds_byte(wr * 64 + fr, fq * 8), boff = lds_byte(wc * 32 + fr, fq * 8);
#define PG8_SA(b, h) (((b) * 2 + (h)) * HTB)
#define PG8_SB(b, h) ((4 + (b) * 2 + (h)) * HTB)
#define PG8_STAGE(bufoff, gbase, voff) do { _Pragma("unroll") for (int _i = 0; _i < 2; ++_i) \
        __builtin_amdgcn_global_load_lds((const unsigned*)((const char*)(gbase) + (voff)[_i]), (PG8_LAS unsigned*)(lds + (bufoff) + ldsw + _i * 8192), 16, 0, 0); } while (0)
#define PG8_LDA(dst, b, h) do { _Pragma("unroll") for (int m = 0; m < 4; ++m) _Pragma("unroll") for (int k = 0; k < 2; ++k) dst[m][k] = *(const PG8_LAS bf16x8*)(lds + PG8_SA(b, h) + aoff + m * 2048 + k * 1024); } while (0)
#define PG8_LDB(dst, b, h) do { _Pragma("unroll") for (int n = 0; n < 2; ++n) _Pragma("unroll") for (int k = 0; k < 2; ++k) dst[n][k] = *(const PG8_LAS bf16x8*)(lds + PG8_SB(b, h) + boff + n * 2048 + k * 1024); } while (0)
#define PG8_MMA(ai, bj, At, Bt) do { __builtin_amdgcn_s_setprio(1); _Pragma("unroll") for (int m = 0; m < 4; ++m) _Pragma("unroll") for (int n = 0; n < 2; ++n) _Pragma("unroll") for (int k = 0; k < 2; ++k) \
        acc[ai][bj][m][n] = __builtin_amdgcn_mfma_f32_16x16x32_bf16(Bt[n][k], At[m][k], acc[ai][bj][m][n], 0, 0, 0); __builtin_amdgcn_s_setprio(0); } while (0)
#define PG8_WAIT_V(n) asm volatile("s_waitcnt vmcnt(" #n ")" ::: "memory")
#define PG8_WAIT_L(n) asm volatile("s_waitcnt lgkmcnt(" #n ")" ::: "memory")
#define PG8_BAR __builtin_amdgcn_s_barrier()
#define PG8_SCHED __builtin_amdgcn_sched_barrier(0)
    Unit cur, nxt; int ui = 0;
    if (!S.next(0, cur)) return;
    f32x4 acc[2][2][4][2];
#pragma unroll
    for (int a = 0; a < 2; ++a)
#pragma unroll
        for (int b = 0; b < 2; ++b)
#pragma unroll
            for (int m = 0; m < 4; ++m)
#pragma unroll
                for (int n = 0; n < 2; ++n) acc[a][b][m][n] = (f32x4){0.f, 0.f, 0.f, 0.f};
    bf16x8 At[4][2], B0[2][2], B1[2][2];
    const char* cA = (const char*)g.A + (size_t)cur.pm * tstep; const char* cB = (const char*)g.Bt + (size_t)cur.pn * tstep;
    S.a_ready(cur);
    if constexpr (SP2) {
        PG8_STAGE(PG8_SB(0, 0), cB, voffB); PG8_STAGE(PG8_SB(0, 1), cB + hstep, voffB); PG8_STAGE(PG8_SA(0, 0), cA, voffA); PG8_STAGE(PG8_SA(0, 1), cA + hstep, voffA);
        if (wr == 1) PG8_BAR;
        PG8_WAIT_V(2); PG8_BAR;
        PG8_STAGE(PG8_SB(1, 0), cB + kstep, voffB); PG8_STAGE(PG8_SA(1, 0), cA + kstep, voffA); PG8_STAGE(PG8_SB(1, 1), cB + hstep + kstep, voffB);
        PG8_WAIT_V(6); PG8_BAR;
    } else {
        PG8_STAGE(PG8_SB(0, 0), cB, voffB); PG8_STAGE(PG8_SA(0, 0), cA, voffA); PG8_STAGE(PG8_SB(0, 1), cB + hstep, voffB); PG8_STAGE(PG8_SA(0, 1), cA + hstep, voffA);
        if (wr == 1) PG8_BAR;
        PG8_WAIT_V(4); PG8_BAR;
        PG8_STAGE(PG8_SB(1, 0), cB + kstep, voffB); PG8_STAGE(PG8_SA(1, 0), cA + kstep, voffA); PG8_STAGE(PG8_SB(1, 1), cB + hstep + kstep, voffB);
        PG8_WAIT_V(6); PG8_BAR;
    }
    for (;;) {
        const bool has_next = S.next(ui + 1, nxt);
        const char* nA = has_next ? (const char*)g.A + (size_t)nxt.pm * tstep : cA; const char* nB = has_next ? (const char*)g.Bt + (size_t)nxt.pn * tstep : cB;
        for (int t = 0; t < nt; t += 2) {
            const bool last = (t == nt - 2);
            const char* a1 = cA + (size_t)(t + 1) * kstep;
            const char* a2 = last ? nA : cA + (size_t)(t + 2) * kstep; const char* b2 = last ? nB : cB + (size_t)(t + 2) * kstep;
            const char* a3 = a2 + kstep; const char* b3 = b2 + kstep;
            if (last && has_next) S.a_ready(nxt);
            if constexpr (SP2) {
            PG8_LDB(B0, 0, 0); PG8_LDB(B1, 0, 1); PG8_SCHED; PG8_LDA(At, 0, 0); PG8_STAGE(PG8_SA(1, 1), a1 + hstep, voffA);
            PG8_WAIT_V(8); PG8_WAIT_L(0); PG8_BAR; PG8_MMA(0, 0, At, B0); PG8_MMA(0, 1, At, B1); PG8_BAR; PG8_SCHED;
            PG8_LDA(At, 0, 1); PG8_STAGE(PG8_SB(0, 0), b2, voffB); PG8_STAGE(PG8_SB(0, 1), b2 + hstep, voffB); PG8_STAGE(PG8_SA(0, 0), a2, voffA);
            PG8_WAIT_V(8); PG8_WAIT_L(0); PG8_BAR; PG8_MMA(1, 0, At, B0); PG8_MMA(1, 1, At, B1); PG8_BAR; PG8_SCHED;
            PG8_LDB(B0, 1, 0); PG8_LDB(B1, 1, 1); PG8_SCHED; PG8_LDA(At, 1, 0); PG8_STAGE(PG8_SA(0, 1), a2 + hstep, voffA);
            PG8_WAIT_V(8); PG8_WAIT_L(0); PG8_BAR; PG8_MMA(0, 0, At, B0); PG8_MMA(0, 1, At, B1); PG8_BAR; PG8_SCHED;
            PG8_LDA(At, 1, 1); PG8_STAGE(PG8_SB(1, 0), b3, voffB); PG8_STAGE(PG8_SB(1, 1), b3 + hstep, voffB); PG8_STAGE(PG8_SA(1, 0), a3, voffA);
            PG8_WAIT_V(8); PG8_WAIT_L(0); PG8_BAR; PG8_MMA(1, 0, At, B0); PG8_MMA(1, 1, At, B1); PG8_BAR; PG8_SCHED;
            } else {
            PG8_LDB(B0, 0, 0); PG8_SCHED; PG8_LDA(At, 0, 0); PG8_STAGE(PG8_SA(1, 1), a1 + hstep, voffA);
            PG8_WAIT_L(8); PG8_BAR; PG8_WAIT_L(0); PG8_MMA(0, 0, At, B0); PG8_BAR; PG8_SCHED;
            PG8_LDB(B1, 0, 1); PG8_STAGE(PG8_SB(0, 0), b2, voffB);
            PG8_BAR; PG8_WAIT_L(0); PG8_MMA(0, 1, At, B1); PG8_BAR;
            PG8_LDA(At, 0, 1); PG8_STAGE(PG8_SA(0, 0), a2, voffA);
            PG8_BAR; PG8_WAIT_L(0); PG8_MMA(1, 0, At, B0); PG8_BAR; PG8_SCHED;
            PG8_STAGE(PG8_SB(0, 1), b2 + hstep, voffB);
            PG8_WAIT_V(6); PG8_BAR; PG8_MMA(1, 1, At, B1); PG8_BAR;
            PG8_LDB(B0, 1, 0); PG8_SCHED; PG8_LDA(At, 1, 0); PG8_STAGE(PG8_SA(0, 1), a2 + hstep, voffA);
            PG8_WAIT_L(8); PG8_BAR; PG8_WAIT_L(0); PG8_MMA(0, 0, At, B0); PG8_BAR; PG8_SCHED;
            PG8_LDB(B1, 1, 1); PG8_STAGE(PG8_SB(1, 0), b3, voffB);
            PG8_BAR; PG8_WAIT_L(0); PG8_MMA(0, 1, At, B1); PG8_BAR;
            PG8_LDA(At, 1, 1); PG8_STAGE(PG8_SA(1, 0), a3, voffA);
            PG8_BAR; PG8_WAIT_L(0); PG8_MMA(1, 0, At, B0); PG8_BAR; PG8_SCHED;
            PG8_STAGE(PG8_SB(1, 1), b3 + hstep, voffB);
            PG8_WAIT_V(6); PG8_BAR; PG8_MMA(1, 1, At, B1); PG8_BAR;
            }
        }
        if constexpr (ALIGN_EPI) { if (wr == 0) PG8_BAR; }
        if constexpr (!Epi::AFTER_DRAIN) { E(acc, cur, wr, wc, fr, fq); S.done(cur); }
        if (!has_next) break;
#pragma unroll
        for (int a = 0; a < 2; ++a)
#pragma unroll
            for (int b = 0; b < 2; ++b)
#pragma unroll
                for (int m = 0; m < 4; ++m)
#pragma unroll
                    for (int n = 0; n < 2; ++n) acc[a][b][m][n] = (f32x4){0.f, 0.f, 0.f, 0.f};
        cur = nxt; cA = nA; cB = nB; ++ui;
        if constexpr (ALIGN_EPI) { if (wr == 1) PG8_BAR; }
    }
    PG8_WAIT_V(0);
    if constexpr (!ALIGN_EPI) { if (wr == 0) PG8_BAR; }
    PG8_BAR;
    if constexpr (Epi::AFTER_DRAIN) { E.fused(acc, cur, wr, wc, fr, fq, lds, wid, lane); S.done(cur); }
#undef PG8_SA
#undef PG8_SB
#undef PG8_STAGE
#undef PG8_LDA
#undef PG8_LDB
#undef PG8_MMA
#undef PG8_WAIT_V
#undef PG8_WAIT_L
#undef PG8_BAR
#undef PG8_SCHED
}
}
#define GAS __attribute__((address_space(1)))
#define LAS __attribute__((address_space(3)))
typedef unsigned short bf16;
typedef unsigned v4u __attribute__((ext_vector_type(4)));
typedef float f32x4 __attribute__((ext_vector_type(4)));
typedef short bf16x8 __attribute__((ext_vector_type(8)));
typedef GAS unsigned gu32;
typedef GAS unsigned long long gu64;
#define RLX_AGENT __ATOMIC_RELAXED, __HIP_MEMORY_SCOPE_AGENT
#define LDS_WAIT() asm volatile("s_waitcnt lgkmcnt(0)" ::: "memory")
#define VM_WAIT() asm volatile("s_waitcnt vmcnt(0)" ::: "memory")
__device__ __forceinline__ unsigned long long rt() { return __builtin_amdgcn_s_memrealtime(); }
__device__ __forceinline__ unsigned f2bf(float f) { unsigned u = __builtin_bit_cast(unsigned, f); return (u + 0x7fffu + ((u >> 16) & 1u)) >> 16; }
__device__ __forceinline__ unsigned pk2(float lo, float hi) { return f2bf(lo) | (f2bf(hi) << 16); }

#define XB_TMO      128
#define XB_XCNT(j)  (256  + 64 * (j))
#define XB_XSUB(j)  (1280 + 64 * (j))
#define XB_XGEN(j)  (2304 + 64 * (j))
#define XB_TOP      3328
#define XB_TOPGEN   3392
#define XCD_BAR_WORDS 3456
#define XB_SPIN_CAP (1u << 18)

__device__ __forceinline__ unsigned xb_ld(unsigned* p)              { return __hip_atomic_load(p, __ATOMIC_RELAXED, __HIP_MEMORY_SCOPE_AGENT); }
__device__ __forceinline__ unsigned xb_add(unsigned* p, unsigned v) { return __hip_atomic_fetch_add(p, v, __ATOMIC_RELAXED, __HIP_MEMORY_SCOPE_AGENT); }
__device__ __forceinline__ unsigned xb_xcc_id() { return (unsigned)__builtin_amdgcn_s_getreg((3 << 11) | 20) & 0xFu; }
#define XB_SPIN(cond, bar) do { unsigned _sp = 0; while (cond) { __builtin_amdgcn_s_sleep(1); \
    if ((++_sp & 255u) == 0u) { if (xb_ld(&(bar)[XB_TMO])) break; if (_sp > XB_SPIN_CAP) { atomicAdd(&(bar)[XB_TMO], 1u); break; } } } } while (0)

struct XcdBarrier {
    unsigned* bar; unsigned x;
    volatile LAS unsigned* st;
};

__device__ __forceinline__ XcdBarrier xcd_barrier_post(unsigned* bar, volatile LAS unsigned* st) {
    XcdBarrier b; b.bar = bar; b.x = xb_xcc_id(); b.st = st;
    if (threadIdx.x == 0) (void)xb_add(&bar[XB_XCNT(b.x)], 1u);
    return b;
}
__device__ __forceinline__ void xcd_barrier_complete(unsigned* bar, unsigned x, unsigned& nloc, unsigned& nx) {
    const unsigned G = gridDim.x * gridDim.y * gridDim.z;
    unsigned sum, cnt, mine, sp = 0u;
    for (;;) {
        sum = 0u; cnt = 0u; mine = 0u;
#pragma unroll
        for (unsigned j = 0; j < 16; ++j) { const unsigned c = xb_ld(&bar[XB_XCNT(j)]); sum += c; cnt += (c > 0u) ? 1u : 0u; mine = (j == x) ? c : mine; }
        if (sum == G) break;
        __builtin_amdgcn_s_sleep(1);
        if ((++sp & 255u) == 0u) { if (xb_ld(&bar[XB_TMO])) break; if (sp > XB_SPIN_CAP) { atomicAdd(&bar[XB_TMO], 1u); break; } }
    }
    nloc = mine > 0u ? mine : 1u; nx = cnt > 0u ? cnt : 1u;
}

__device__ __forceinline__ void xcd_barrier(const XcdBarrier& b) {
    asm volatile("s_waitcnt vmcnt(0)" ::: "memory");
    __syncthreads();
    if (threadIdx.x == 0) {
        unsigned* bar = b.bar;
        __builtin_amdgcn_s_waitcnt(0);
        unsigned nloc = b.st[0], nx = b.st[1];
        if (nloc == 0u) { xcd_barrier_complete(bar, b.x, nloc, nx); b.st[0] = nloc; b.st[1] = nx; }
        const unsigned old = xb_add(&bar[XB_XSUB(b.x)], 1u);
        const unsigned gen = old / nloc;
        if (old + 1u == (gen + 1u) * nloc) {
            __builtin_amdgcn_fence(__ATOMIC_RELEASE, "agent");
            asm volatile("s_waitcnt vmcnt(0)" ::: "memory");
            const unsigned og = xb_add(&bar[XB_TOP], 1u);
            const unsigned tg = og / nx;
            if (og + 1u == (tg + 1u) * nx) xb_add(&bar[XB_TOPGEN], 1u);
            else XB_SPIN(xb_ld(&bar[XB_TOPGEN]) == tg, bar);
            __builtin_amdgcn_fence(__ATOMIC_ACQUIRE, "agent");
            xb_add(&bar[XB_XGEN(b.x)], 1u);
            asm volatile("s_waitcnt vmcnt(0)" ::: "memory");
        } else {
            XB_SPIN(xb_ld(&bar[XB_XGEN(b.x)]) == gen, bar);
            __builtin_amdgcn_fence(__ATOMIC_ACQUIRE, "agent");
            asm volatile("s_waitcnt vmcnt(0)" ::: "memory");
        }
    }
    __syncthreads();
}

constexpr int NWAVES = 8, NTHR = 512;
constexpr int D = 2048, S = 8192, AW = 1024, CW = 1024, INC = 5120, NH = 8, DH = 64, CK = 31;
constexpr int PH = 8, PKEYS = 128, PTOP = 16, PKD = 256, NEXP = 16384;
constexpr float EPS = 1e-6f, LAMBDA_INIT = 0.2f;
constexpr float LOG2E = 1.4426950408889634f;
constexpr float C2 = 0.125f * LOG2E;

constexpr size_t MiB = 1u << 20;
constexpr size_t WS_CTL = 0, CTL_ZERO_BYTES = 1 * MiB;
constexpr size_t WS_MOD = 1 * MiB;
constexpr size_t WS_MODP = 2 * MiB;
constexpr size_t WS_IDX = 5 * MiB, WS_GATE = 9 * MiB;
constexpr size_t WS_WIN = 16 * MiB, WS_WOUT = 36 * MiB, WS_WQ = 44 * MiB;
constexpr size_t WS_UB = 52 * MiB, WS_VB = 116 * MiB;
constexpr size_t WS_XN = 180 * MiB;
constexpr size_t WS_PROJ = 212 * MiB;
constexpr size_t WS_MIX = 212 * MiB;
constexpr size_t WS_Y = 292 * MiB;
constexpr size_t WS_QP = 292 * MiB;
constexpr size_t WS_X1 = 324 * MiB;
constexpr size_t WS_END = 388 * MiB;
constexpr int CW_BAR = 4096, CW_PEERQ = 8192;

constexpr int RING_OFF = 0, RING_BYTES = 131072;
constexpr int LDSCTL_OFF = RING_BYTES, MISC_OFF = LDSCTL_OFF + 320, XTRA_OFF = LDSCTL_OFF + 512;
constexpr int LDS_BYTES = 147456;

__device__ __forceinline__ float bf2f(unsigned short b) { return __uint_as_float((unsigned)b << 16); }
__device__ __forceinline__ float bflo(unsigned u) { return __uint_as_float(u << 16); }
__device__ __forceinline__ float bfhi(unsigned u) { return __uint_as_float(u & 0xffff0000u); }
template <int X> __device__ __forceinline__ float swz_xor(float v) { return __int_as_float(__builtin_amdgcn_ds_swizzle(__float_as_int(v), (X << 10) | 0x1f)); }
template <int X> __device__ __forceinline__ int swz_xor_i(int v) { return __builtin_amdgcn_ds_swizzle(v, (X << 10) | 0x1f); }
__device__ __forceinline__ float xor32_f(float v) { auto rr = __builtin_amdgcn_permlane32_swap(__float_as_uint(v), __float_as_uint(v), false, false); return __uint_as_float((threadIdx.x & 32) ? rr[0] : rr[1]); }
__device__ __forceinline__ int xor32_i(int v) { auto rr = __builtin_amdgcn_permlane32_swap((unsigned)v, (unsigned)v, false, false); return (int)((threadIdx.x & 32) ? rr[0] : rr[1]); }
__device__ __forceinline__ float wave_sum(float v) {
    v += swz_xor<1>(v); v += swz_xor<2>(v); v += swz_xor<4>(v); v += swz_xor<8>(v); v += swz_xor<16>(v);
    auto rr = __builtin_amdgcn_permlane32_swap(__float_as_uint(v), __float_as_uint(v), false, false); return __uint_as_float(rr[0]) + __uint_as_float(rr[1]);
}
__device__ __forceinline__ float wave_max(float v) {
    v = fmaxf(v, swz_xor<1>(v)); v = fmaxf(v, swz_xor<2>(v)); v = fmaxf(v, swz_xor<4>(v)); v = fmaxf(v, swz_xor<8>(v)); v = fmaxf(v, swz_xor<16>(v));
    auto rr = __builtin_amdgcn_permlane32_swap(__float_as_uint(v), __float_as_uint(v), false, false); return fmaxf(__uint_as_float(rr[0]), __uint_as_float(rr[1]));
}
__device__ __forceinline__ float silu_f(float v) { return v / (1.f + __expf(-v)); }

struct Args { const float* in[24]; float* out; unsigned char* ws; };

__device__ __forceinline__ void p0_transpose_item(const float* W, int K, int N, bf16* WT, int row_off, LAS float* scr, int item, int lane) {
    const int nblk = N / 32, kb = item / nblk, nb = item % nblk, k0 = 64 * kb, n0 = 32 * nb;
#pragma unroll 8
    for (int i = 0; i < 32; ++i) { const int kk = 2 * i + (lane >> 5); scr[kk * 33 + (lane & 31)] = W[(size_t)(k0 + kk) * N + n0 + (lane & 31)]; }
    LDS_WAIT(); asm volatile("" ::: "memory");
    const int c = lane & 7;
#pragma unroll
    for (int j = 0; j < 4; ++j) { const int n = (lane >> 3) + 8 * j; const LAS float* s = scr + (8 * c) * 33 + n;
        v4u o; o.x = pk2(s[0 * 33], s[1 * 33]); o.y = pk2(s[2 * 33], s[3 * 33]); o.z = pk2(s[4 * 33], s[5 * 33]); o.w = pk2(s[6 * 33], s[7 * 33]);
        *(GAS v4u*)(WT + (size_t)(row_off + n0 + n) * K + k0 + 8 * c) = o; }
    LDS_WAIT(); asm volatile("" ::: "memory");
}
__device__ __forceinline__ void p0_mod_block(const float* c, const float* w_ada, const float* b_ada, float* mod, LAS float* red, int cb, int tid, int wave, int lane) {
    const int slot = lane / 12, q = lane % 12;
    f32x4 acc = (f32x4){0.f, 0.f, 0.f, 0.f};
    if (slot < 5) {
        const float* wp = w_ada + (size_t)(wave * 256) * (6 * D) + cb * 48 + q * 4;
#pragma unroll 4
        for (int i = 0; i < 52; ++i) { const int r = i * 5 + slot;
            if (r < 256) { const float s = silu_f(c[wave * 256 + r]); const f32x4 w = *(const f32x4*)(wp + (size_t)r * (6 * D)); acc += w * s; } }
        *(LAS f32x4*)(red + (wave * 5 + slot) * 48 + q * 4) = acc;
    }
    __syncthreads();
    if (tid < 48) { float s = b_ada[cb * 48 + tid];
#pragma unroll 8
        for (int p = 0; p < 40; ++p) s += red[p * 48 + tid];
        mod[cb * 48 + tid] = s; }
    __syncthreads();
}
__device__ __forceinline__ void p0_cvt_row_fp6(const float* src, unsigned char* dst, float scale, int lane) {
    typedef float f32x16v __attribute__((ext_vector_type(16))); typedef unsigned u32x6 __attribute__((ext_vector_type(6))); typedef unsigned u32x2 __attribute__((ext_vector_type(2)));
    f32x4 v[8];
#pragma unroll
    for (int j = 0; j < 4; ++j) { v[j] = *(const f32x4*)(src + lane * 16 + 4 * j); v[4 + j] = *(const f32x4*)(src + 1024 + lane * 16 + 4 * j); }
    f32x16v a, b;
#pragma unroll
    for (int j = 0; j < 4; ++j) { a[4 * j] = v[j].x * scale; a[4 * j + 1] = v[j].y * scale; a[4 * j + 2] = v[j].z * scale; a[4 * j + 3] = v[j].w * scale;
                                  b[4 * j] = v[4 + j].x * scale; b[4 * j + 1] = v[4 + j].y * scale; b[4 * j + 2] = v[4 + j].z * scale; b[4 * j + 3] = v[4 + j].w * scale; }
    const u32x6 w = __builtin_amdgcn_cvt_scalef32_2xpk16_fp6_f32(a, b, 1.0f);
    asm volatile("" :: "v"(a), "v"(b));
    u32x2* o = (u32x2*)(dst + lane * 24);
    o[0] = (u32x2){w[0], w[1]}; o[1] = (u32x2){w[2], w[3]}; o[2] = (u32x2){w[4], w[5]};
}

__device__ __forceinline__ void convert_tables(const Args& a, int r0, int r1, int cw, int ncw, int lane) {
    for (int r = r0 + cw; r < r1; r += ncw) {
        if (r < NEXP) p0_cvt_row_fp6(a.in[22] + (size_t)r * D, (unsigned char*)(a.ws + WS_UB) + (size_t)r * 1536, 64.f, lane);
        else p0_cvt_row_fp6(a.in[23] + (size_t)(r - NEXP) * D, (unsigned char*)(a.ws + WS_VB) + (size_t)(r - NEXP) * 1536, 16.f, lane);
    }
}
constexpr int CVT_EARLY_ROWS = 0;

__device__ __forceinline__ void phase_p0a(const Args& a, LAS unsigned char* lds, int vcu, int G, int tid, int wave, int lane) {
    const float* c = a.in[1]; const float* w_ada = a.in[2];
    for (int cb = vcu; cb < 6 * D / 48; cb += G) p0_mod_block(c, w_ada, a.in[3], (float*)(a.ws + WS_MOD), (LAS float*)(lds + XTRA_OFF + 64), cb, tid, wave, lane);
    LAS float* scr = (LAS float*)(lds + RING_OFF + wave * 16384);
    const int gw = vcu * NWAVES + wave, NGW = G * NWAVES;
    constexpr int I_WIN = (D / 64) * (INC / 32), I_WOUT = (D / 64) * (D / 32), I_WQ = I_WOUT, I_TAB = NEXP;
    constexpr int NITEMS = I_WIN + I_WOUT + I_WQ;
    for (int it = gw; it < NITEMS; it += NGW) {
        int r = it;
        if (r < I_WIN) { p0_transpose_item(a.in[8], D, INC, (bf16*)(a.ws + WS_WIN), 0, scr, r, lane); continue; } r -= I_WIN;
        if (r < I_WOUT) { p0_transpose_item(a.in[18], D, D, (bf16*)(a.ws + WS_WOUT), 0, scr, r, lane); continue; } r -= I_WOUT;
        p0_transpose_item(a.in[19], D, D, (bf16*)(a.ws + WS_WQ), 0, scr, r, lane);
    }
}

__device__ __forceinline__ void phase_p0b(const Args& a, LAS unsigned char* lds, int vcu, int G, int tid, int wave, int lane) {
    const float* mod = (const float*)(a.ws + WS_MOD); const float* g_pre = a.in[4];
    LAS float* gm = (LAS float*)(lds + RING_OFF); LAS float* sh = gm + D;
#pragma unroll
    for (int i = 0; i < 4; ++i) { const int k = tid + NTHR * i; sh[k] = mod[k]; gm[k] = g_pre[k] * (1.f + mod[D + k]); }
    __syncthreads();
    const float* x = a.in[0]; bf16* XN = (bf16*)(a.ws + WS_XN);
    const int gw = vcu * NWAVES + wave, NGW = G * NWAVES;
    for (int row = gw; row < S; row += NGW) {
        const float* xr = x + (size_t)row * D + lane * 4;
        f32x4 v[8]; float ss = 0.f;
#pragma unroll
        for (int j = 0; j < 8; ++j) { v[j] = *(const f32x4*)(xr + 256 * j); ss += (v[j].x * v[j].x + v[j].y * v[j].y) + (v[j].z * v[j].z + v[j].w * v[j].w); }
        const float r = rsqrtf(wave_sum(ss) * (1.f / D) + EPS);
#pragma unroll
        for (int j = 0; j < 8; ++j) { const f32x4 g4 = *(const LAS f32x4*)(gm + lane * 4 + 256 * j), s4 = *(const LAS f32x4*)(sh + lane * 4 + 256 * j);
            const f32x4 o = v[j] * r * g4 + s4;
            *(unsigned long long*)(XN + (size_t)row * D + lane * 4 + 256 * j) = (unsigned long long)pk2(o.x, o.y) | ((unsigned long long)pk2(o.z, o.w) << 32); }
    }
}

struct EpiF32 {
    static constexpr bool PERM = false, AFTER_DRAIN = false;
    float* O; int ldc;
    __device__ __forceinline__ void operator()(const pg8::f32x4 (&acc)[2][2][4][2], const pg8::Unit& u, int wr, int wc, int fr, int fq) const {
        const int row0 = u.pm * pg8::BM + wr * 64 + fr, col0 = u.pn * pg8::BM + wc * 32 + 4 * fq;
#pragma unroll
        for (int ai = 0; ai < 2; ++ai)
#pragma unroll
            for (int m = 0; m < 4; ++m) { float* rowp = O + (size_t)(row0 + ai * pg8::HALF + m * 16) * ldc + col0;
#pragma unroll
                for (int bj = 0; bj < 2; ++bj)
#pragma unroll
                    for (int n = 0; n < 2; ++n) *(pg8::f32x4*)(rowp + bj * pg8::HALF + n * 16) = acc[ai][bj][m][n]; }
    }
};

__device__ __forceinline__ void phase_attn_simple(const Args& a, LAS unsigned char* lds, int vcu, int G, int wave, int lane) {
    const bf16* proj = (const bf16*)(a.ws + WS_PROJ); bf16* Y = (bf16*)(a.ws + WS_Y);
    const float* g_subln = a.in[13];
    LAS float* qs = (LAS float*)(lds + RING_OFF) + wave * 128;
    const float lam = __expf(wave_sum(a.in[9][lane] * a.in[10][lane])) - __expf(wave_sum(a.in[11][lane] * a.in[12][lane])) + LAMBDA_INIT;
    const int gw = vcu * NWAVES + wave, NGW = G * NWAVES;
    for (int gid = gw; gid < NH * S; gid += NGW) {
        const int h = gid & 7, qpos = gid >> 3;
        const float slope = exp2f(-(float)(h + 1)) * LOG2E;
        const bf16* qrow = proj + (size_t)qpos * INC + h * 128;
        LDS_WAIT(); asm volatile("" ::: "memory");
        qs[lane] = bf2f(qrow[lane]); qs[64 + lane] = bf2f(qrow[64 + lane]);
        LDS_WAIT(); asm volatile("" ::: "memory");
        float res0 = 0.f, res1 = 0.f;
        for (int m = 0; m < 2; ++m) {
            float mx = -INFINITY, l = 0.f, o0 = 0.f, o1 = 0.f;
            for (int kb = 0; kb <= qpos; kb += 64) {
                const int kpos = kb + lane;
                float sdot = -INFINITY;
                if (kpos <= qpos) {
                    const v4u* kr = (const v4u*)(proj + (size_t)kpos * INC + AW + h * 128 + m * 64);
                    float acc = 0.f;
#pragma unroll
                    for (int i = 0; i < 8; ++i) { const v4u kv = kr[i]; const LAS float* qq = qs + m * 64 + 8 * i;
                        acc += bflo(kv.x) * qq[0] + bfhi(kv.x) * qq[1] + bflo(kv.y) * qq[2] + bfhi(kv.y) * qq[3] + bflo(kv.z) * qq[4] + bfhi(kv.z) * qq[5] + bflo(kv.w) * qq[6] + bfhi(kv.w) * qq[7]; }
                    sdot = acc - slope * (float)(qpos - kpos);
                }
                const float mn = fmaxf(mx, wave_max(sdot));
                const float alpha = exp2f(mx - mn);
                const float p = (kpos <= qpos) ? exp2f(sdot - mn) : 0.f;
                l = l * alpha + wave_sum(p);
                o0 *= alpha; o1 *= alpha;
                const int nk = min(64, qpos - kb + 1);
                for (int j = 0; j < nk; ++j) {
                    const float pj = __shfl(p, j);
                    const unsigned vv = *((const unsigned*)(proj + (size_t)(kb + j) * INC + 2 * AW + h * 128) + lane);
                    o0 += pj * bflo(vv); o1 += pj * bfhi(vv);
                }
                mx = mn;
            }
            const float inv = 1.f / l;
            if (m == 0) { res0 = o0 * inv; res1 = o1 * inv; } else { res0 -= lam * o0 * inv; res1 -= lam * o1 * inv; }
        }
        const float ss = wave_sum(res0 * res0 + res1 * res1);
        const float r = rsqrtf(ss * (1.f / 128.f) + EPS) * (1.f - LAMBDA_INIT);
        *((unsigned*)(Y + (size_t)qpos * D + h * 128) + lane) = pk2(res0 * r * g_subln[2 * lane], res1 * r * g_subln[2 * lane + 1]);
    }
}

__device__ __forceinline__ void block_sum2(float& a, float& b, LAS float* red, int wave, int lane) {
    a = wave_sum(a); b = wave_sum(b);
    __syncthreads();
    if (lane == 0) { red[wave] = a; red[8 + wave] = b; }
    __syncthreads();
    float sa = 0.f, sb = 0.f;
#pragma unroll
    for (int i = 0; i < 8; ++i) { sa += red[i]; sb += red[8 + i]; }
    a = sa; b = sb;
}

__device__ __forceinline__ void phase_conv_simple(const Args& a, LAS unsigned char* lds, int vcu, int G, int tid, int wave, int lane) {
    const bf16* proj = (const bf16*)(a.ws + WS_PROJ); bf16* Y = (bf16*)(a.ws + WS_Y);
    const float* conv_w = a.in[14]; const float* conv_b = a.in[15]; const float* ln_g = a.in[16]; const float* ln_b = a.in[17];
    LAS float* red = (LAS float*)(lds + XTRA_OFF);
    const int per = S / G;
    for (int t = vcu * per; t < (vcu + 1) * per; ++t) {
        float acc0 = 0.f, acc1 = 0.f;
        for (int j = 0; j < CK; ++j) {
            const int tt = t - (CK - 1) + j;
            if (tt < 0) continue;
            const unsigned av = *((const unsigned*)(proj + (size_t)tt * INC + 3 * AW) + tid);
            const unsigned gv = *((const unsigned*)(proj + (size_t)tt * INC + 3 * AW + CW) + tid);
            const float u0 = bflo(av) / (1.f + __expf(-bflo(gv))), u1 = bfhi(av) / (1.f + __expf(-bfhi(gv)));
            acc0 += conv_w[j * CW + 2 * tid] * u0; acc1 += conv_w[j * CW + 2 * tid + 1] * u1;
        }
        acc0 += conv_b[2 * tid]; acc1 += conv_b[2 * tid + 1];
        float s1 = acc0 + acc1, s2 = acc0 * acc0 + acc1 * acc1;
        block_sum2(s1, s2, red, wave, lane);
        const float mu = s1 * (1.f / CW), var = fmaxf(s2 * (1.f / CW) - mu * mu, 0.f), r = rsqrtf(var + EPS);
        const float v0 = (acc0 - mu) * r * ln_g[2 * tid] + ln_b[2 * tid], v1 = (acc1 - mu) * r * ln_g[2 * tid + 1] + ln_b[2 * tid + 1];
        *((unsigned*)(Y + (size_t)t * D + AW) + tid) = pk2(silu_f(v0), silu_f(v1));
    }
}

__device__ __forceinline__ void phase_p3b(const Args& a, LAS unsigned char* lds, int vcu, int G, int tid, int wave, int lane) {
    const float* mod = (const float*)(a.ws + WS_MOD);
    LAS float* gA = (LAS float*)(lds + RING_OFF); LAS float* gB = gA + D; LAS float* sB = gB + D;
#pragma unroll
    for (int i = 0; i < 4; ++i) { const int k = tid + NTHR * i; gA[k] = mod[2 * D + k] * a.in[5][k]; gB[k] = a.in[6][k] * (1.f + mod[4 * D + k]); sB[k] = mod[3 * D + k]; }
    __syncthreads();
    const float* x = a.in[0]; const bf16* mix = (const bf16*)(a.ws + WS_MIX); bf16* XN = (bf16*)(a.ws + WS_XN); float* x1o = (float*)(a.ws + WS_X1);
    const int gw = vcu * NWAVES + wave, NGW = G * NWAVES;
    for (int row = gw; row < S; row += NGW) {
        const size_t ro = (size_t)row * D + lane * 4;
        unsigned long long mv[8]; f32x4 xv[8];
#pragma unroll
        for (int j = 0; j < 8; ++j) { mv[j] = *(const unsigned long long*)(mix + ro + 256 * j); xv[j] = *(const f32x4*)(x + ro + 256 * j); }
        f32x4 v[8]; float ss = 0.f;
#pragma unroll
        for (int j = 0; j < 8; ++j) { const unsigned lo = (unsigned)mv[j], hi = (unsigned)(mv[j] >> 32); v[j] = (f32x4){bflo(lo), bfhi(lo), bflo(hi), bfhi(hi)};
            ss += (v[j].x * v[j].x + v[j].y * v[j].y) + (v[j].z * v[j].z + v[j].w * v[j].w); }
        const float r = rsqrtf(wave_sum(ss) * (1.f / D) + EPS);
        float s2 = 0.f;
#pragma unroll
        for (int j = 0; j < 8; ++j) { const f32x4 g4 = *(const LAS f32x4*)(gA + lane * 4 + 256 * j);
            v[j] = xv[j] + v[j] * r * g4; *(f32x4*)(x1o + ro + 256 * j) = v[j]; s2 += (v[j].x * v[j].x + v[j].y * v[j].y) + (v[j].z * v[j].z + v[j].w * v[j].w); }
        const float r2 = rsqrtf(wave_sum(s2) * (1.f / D) + EPS);
#pragma unroll
        for (int j = 0; j < 8; ++j) { const f32x4 g4 = *(const LAS f32x4*)(gB + lane * 4 + 256 * j), s4 = *(const LAS f32x4*)(sB + lane * 4 + 256 * j);
            const f32x4 o = v[j] * r2 * g4 + s4;
            *(unsigned long long*)(XN + ro + 256 * j) = (unsigned long long)pk2(o.x, o.y) | ((unsigned long long)pk2(o.z, o.w) << 32); }
    }
}

#define ARGMAX_STEP(OV, OI) do { const float ov_ = (OV); const int oi_ = (OI); if (ov_ > v || (ov_ == v && oi_ < i)) { v = ov_; i = oi_; } } while (0)
__device__ __forceinline__ void wave_argmax(float v, int i, float& bv, int& bi) {
    ARGMAX_STEP(swz_xor<1>(v), swz_xor_i<1>(i)); ARGMAX_STEP(swz_xor<2>(v), swz_xor_i<2>(i)); ARGMAX_STEP(swz_xor<4>(v), swz_xor_i<4>(i));
    ARGMAX_STEP(swz_xor<8>(v), swz_xor_i<8>(i)); ARGMAX_STEP(swz_xor<16>(v), swz_xor_i<16>(i)); ARGMAX_STEP(xor32_f(v), xor32_i(i));
    bv = v; bi = i;
}
__device__ __forceinline__ void phase_topk_simple(const Args& a, LAS unsigned char* lds, int vcu, int G, int tid, int wave, int lane) {
    LAS float* kt = (LAS float*)(lds + RING_OFF);
    for (int e = tid; e < 2 * PKEYS * 128; e += NTHR) { const int half = e >> 14, key = (e >> 7) & 127, d = e & 127; kt[half * 16384 + d * 128 + key] = a.in[20 + half][key * 128 + d]; }
    LAS float* qs = (LAS float*)(lds + XTRA_OFF + 64) + wave * 256;
    LAS float* tv = (LAS float*)(lds + XTRA_OFF + 64 + 8192) + wave * 32;
    LAS int* ti = (LAS int*)(lds + XTRA_OFF + 64 + 8192 + 1024) + wave * 32;
    __syncthreads();
    const bf16* QP = (const bf16*)(a.ws + WS_QP); int* idx_out = (int*)(a.ws + WS_IDX); float* g_out = (float*)(a.ws + WS_GATE);
    const int gw = vcu * NWAVES + wave, NGW = G * NWAVES;
    for (int gid = gw; gid < S * PH; gid += NGW) {
        const bf16* qr = QP + (size_t)gid * PKD;
        LDS_WAIT(); asm volatile("" ::: "memory");
#pragma unroll
        for (int i = 0; i < 4; ++i) qs[lane + 64 * i] = bf2f(qr[lane + 64 * i]);
        LDS_WAIT(); asm volatile("" ::: "memory");
        for (int half = 0; half < 2; ++half) {
            const LAS float* kk = kt + half * 16384;
            float s0 = 0.f, s1 = 0.f;
#pragma unroll 8
            for (int d = 0; d < 128; ++d) { const float qv = qs[half * 128 + d]; s0 += qv * kk[d * 128 + lane]; s1 += qv * kk[d * 128 + 64 + lane]; }
            for (int r = 0; r < PTOP; ++r) {
                float lv; int li;
                if (s0 >= s1) { lv = s0; li = lane; } else { lv = s1; li = lane + 64; }
                float bv; int bi; wave_argmax(lv, li, bv, bi);
                if (lane == 0) { tv[half * 16 + r] = bv; ti[half * 16 + r] = bi; }
                if (bi == lane) s0 = -INFINITY;
                if (bi == lane + 64) s1 = -INFINITY;
            }
        }
        LDS_WAIT(); asm volatile("" ::: "memory");
        float cv[4];
#pragma unroll
        for (int e = 0; e < 4; ++e) { const int f = lane * 4 + e; cv[e] = tv[f >> 4] + tv[16 + (f & 15)]; }
        float myv = 0.f; int myi = 0; float mx = 0.f, den = 0.f;
        for (int r = 0; r < PTOP; ++r) {
            float lv = cv[0]; int li = lane * 4;
#pragma unroll
            for (int e = 1; e < 4; ++e) if (cv[e] > lv) { lv = cv[e]; li = lane * 4 + e; }
            float bv; int bi; wave_argmax(lv, li, bv, bi);
            if (r == 0) mx = bv;
            den += __expf(bv - mx);
            if (r == lane) { myv = bv; myi = bi; }
#pragma unroll
            for (int e = 0; e < 4; ++e) if (bi == lane * 4 + e) cv[e] = -INFINITY;
        }
        if (lane < PTOP) {
            const int e = ti[myi >> 4] * PKEYS + ti[16 + (myi & 15)];
            idx_out[(size_t)gid * PTOP + lane] = e;
            g_out[(size_t)gid * PTOP + lane] = __expf(myv - mx) / den;
        }
    }
}

__device__ __forceinline__ void phase_peer_simple(const Args& a, LAS unsigned char* lds, int vcu, int G, int tid, int wave, int lane) {
    const float* mod = (const float*)(a.ws + WS_MOD);
    const bf16* XN = (const bf16*)(a.ws + WS_XN); const bf16* Ub = (const bf16*)(a.ws + WS_UB); const bf16* Vb = (const bf16*)(a.ws + WS_VB);
    const int* IDX = (const int*)(a.ws + WS_IDX); const float* GATE = (const float*)(a.ws + WS_GATE);
    LAS float* act = (LAS float*)(lds + RING_OFF); LAS int* eidx = (LAS int*)(lds + RING_OFF + 512); LAS float* red = (LAS float*)(lds + XTRA_OFF);
    const f32x4 gfin = (f32x4){mod[5 * D + 4 * tid] * a.in[7][4 * tid], mod[5 * D + 4 * tid + 1] * a.in[7][4 * tid + 1], mod[5 * D + 4 * tid + 2] * a.in[7][4 * tid + 2], mod[5 * D + 4 * tid + 3] * a.in[7][4 * tid + 3]};
    const int per = S / G;
    for (int t = vcu * per; t < (vcu + 1) * per; ++t) {
        __syncthreads();
        if (tid < 128) eidx[tid] = IDX[(size_t)t * 128 + tid];
        v4u hv[4];
#pragma unroll
        for (int j = 0; j < 4; ++j) hv[j] = *(const v4u*)(XN + (size_t)t * D + lane * 8 + 512 * j);
        __syncthreads();
#pragma unroll 2
        for (int ee = 0; ee < 16; ++ee) {
            const int e = wave * 16 + ee;
            const bf16* ur = Ub + (size_t)eidx[e] * D + lane * 8;
            float acc = 0.f;
#pragma unroll
            for (int j = 0; j < 4; ++j) { const v4u uv = *(const v4u*)(ur + 512 * j);
                acc += bflo(uv.x) * bflo(hv[j].x) + bfhi(uv.x) * bfhi(hv[j].x) + bflo(uv.y) * bflo(hv[j].y) + bfhi(uv.y) * bfhi(hv[j].y)
                     + bflo(uv.z) * bflo(hv[j].z) + bfhi(uv.z) * bfhi(hv[j].z) + bflo(uv.w) * bflo(hv[j].w) + bfhi(uv.w) * bfhi(hv[j].w); }
            acc = wave_sum(acc);
            if (lane == 0) act[e] = 0.5f * acc * (1.f + erff(acc * 0.70710678118654752f)) * GATE[(size_t)t * 128 + e];
        }
        __syncthreads();
        f32x4 o = (f32x4){0.f, 0.f, 0.f, 0.f};
#pragma unroll 8
        for (int e = 0; e < 128; ++e) {
            const unsigned long long vv = *(const unsigned long long*)(Vb + (size_t)eidx[e] * D + 4 * tid);
            const float av = act[e]; const unsigned lo = (unsigned)vv, hi = (unsigned)(vv >> 32);
            o.x += av * bflo(lo); o.y += av * bfhi(lo); o.z += av * bflo(hi); o.w += av * bfhi(hi);
        }
        float ss = (o.x * o.x + o.y * o.y) + (o.z * o.z + o.w * o.w), dummy = 0.f;
        block_sum2(ss, dummy, red, wave, lane);
        const float r = rsqrtf(ss * (1.f / D) + EPS);
        float* op = a.out + (size_t)t * D + 4 * tid;
        const f32x4 x1 = *(const f32x4*)op;
        *(f32x4*)op = x1 + o * r * gfin;
    }
}


namespace att {
using f32x16 = __attribute__((ext_vector_type(16))) float;
using s16x4 = __attribute__((ext_vector_type(4))) short;
typedef __attribute__((address_space(3))) const char* lds_cptr;
constexpr int KSLOT = 16384, NKS = 3, VSLOT = 16384, NVS = 4, KVB = 64, QBR = 128;
constexpr int LDS_KR = 0, LDS_VR = NKS * KSLOT, LDS_O2 = 0, LDS_OST = 65536, LDS_WS = LDS_VR + NVS * VSLOT, LDS_FLAG = LDS_WS + 2048, ATT_LDS_BYTES = LDS_FLAG + 64;
__device__ __forceinline__ int crow(int r, int hi) { return (r & 3) + 8 * (r >> 2) + 4 * hi; }
__device__ __forceinline__ void glds16(const void* gsrc, unsigned lds_dst) { unsigned keep;
    asm volatile("s_mov_b32 %0, m0\n\ts_mov_b32 m0, %2\n\ts_nop 0\n\tglobal_load_lds_dwordx4 %1, off\n\ts_mov_b32 m0, %0" : "=&s"(keep) : "v"(gsrc), "s"(lds_dst) : "memory"); }
#define ATT_WAIT_BAR(N) asm volatile("s_waitcnt vmcnt(" #N ") lgkmcnt(0)\n\ts_barrier" ::: "memory")
typedef float f32x2_t __attribute__((ext_vector_type(2))); typedef __bf16 bf16x2_t __attribute__((ext_vector_type(2)));
__device__ __forceinline__ unsigned cvtpk(float lo, float hi) { f32x2_t v = {lo, hi}; bf16x2_t b = __builtin_convertvector(v, bf16x2_t); return __builtin_bit_cast(unsigned, b); }
__device__ __forceinline__ float swap_max(float m) { auto rr = __builtin_amdgcn_permlane32_swap(__float_as_uint(m), __float_as_uint(m), false, false); return fmaxf(__uint_as_float(rr[0]), __uint_as_float(rr[1])); }
__device__ __forceinline__ float swap_sum(float m) { auto rr = __builtin_amdgcn_permlane32_swap(__float_as_uint(m), __float_as_uint(m), false, false); return __uint_as_float(rr[0]) + __uint_as_float(rr[1]); }
__device__ __forceinline__ float max3a(float a, float b, float c) { float r; asm("v_max3_f32 %0, %1, %2, %3" : "=v"(r) : "v"(a), "v"(b), "v"(c)); return r; }
#define ATT_VRD(dst, off) asm volatile("ds_read_b64_tr_b16 %0, %1 offset:%c2" : "=v"(dst) : "v"(vaddr), "i"(off) : "memory")
#define ATT_VF(i) (bf16x8){vlo[i][0], vlo[i][1], vlo[i][2], vlo[i][3], vhi[i][0], vhi[i][1], vhi[i][2], vhi[i][3]}

struct UnitCtx {
    const bf16* ksrc; const bf16* vsrc; unsigned kdst, vdst; unsigned lds0; lds_cptr shm3;
    int NT, q0, wq, m, r32, hi, lane, qrow; float ch;
};
#define ATT_DMA(t, ko_, vo_) do { const size_t ro_ = (size_t)(t) * KVB * INC; \
        glds16(c.ksrc + ro_, (unsigned)__builtin_amdgcn_readfirstlane(c.kdst + (ko_))); glds16(c.ksrc + ro_ + (size_t)32 * INC, (unsigned)__builtin_amdgcn_readfirstlane(c.kdst + (ko_) + 8192)); \
        glds16(c.vsrc + ro_, (unsigned)__builtin_amdgcn_readfirstlane(c.vdst + (vo_))); glds16(c.vsrc + ro_ + 64, (unsigned)__builtin_amdgcn_readfirstlane(c.vdst + (vo_) + 8192)); } while (0)

__device__ __forceinline__ void qk_tile(const UnitCtx& c, const bf16x8 (&qr)[4], float m0, int t, int ko, f32x16& p0, f32x16& p1) {
    const int hi = c.hi;
    const float tm = c.ch * (float)(t * KVB + 4 * hi - c.qrow) - m0, c32 = c.ch * 32.f;
#pragma unroll
    for (int r = 0; r < 16; ++r) { p0[r] = c.ch * (float)((r & 3) + 8 * (r >> 2)) + tm; p1[r] = p0[r] + c32; }
    const lds_cptr kp = c.shm3 + LDS_KR + ko + c.r32 * 256;
    bf16x8 ka[4], kb[4];
#pragma unroll
    for (int d0 = 0; d0 < 4; ++d0) { const int off = (((8 * c.m + hi + 2 * d0) ^ (c.r32 & 15)) * 16);
        ka[d0] = *(const __attribute__((address_space(3))) bf16x8*)(kp + off); kb[d0] = *(const __attribute__((address_space(3))) bf16x8*)(kp + off + 8192); }
    asm volatile("" : "+v"(ka[0]), "+v"(ka[1]), "+v"(ka[2]), "+v"(ka[3]), "+v"(kb[0]), "+v"(kb[1]), "+v"(kb[2]), "+v"(kb[3]));
#pragma unroll
    for (int d0 = 0; d0 < 4; ++d0) p0 = __builtin_amdgcn_mfma_f32_32x32x16_bf16(ka[d0], qr[d0], p0, 0, 0, 0);
#pragma unroll
    for (int d0 = 0; d0 < 4; ++d0) p1 = __builtin_amdgcn_mfma_f32_32x32x16_bf16(kb[d0], qr[d0], p1, 0, 0, 0);
    if (t * KVB + KVB - 1 > c.q0 + 32 * c.wq) {
        const int kb_ = t * KVB + 4 * hi;
#pragma unroll
        for (int r = 0; r < 16; ++r) { const int kv = kb_ + (r & 3) + 8 * (r >> 2); if (kv > c.qrow) p0[r] = -INFINITY; if (kv + 32 > c.qrow) p1[r] = -INFINITY; }
    }
}
__device__ __forceinline__ void exp_half(f32x16& p, float& sa, float& sb, v4u& wA, v4u& wB) {
#pragma unroll
    for (int r = 0; r < 16; r += 2) { p[r] = __builtin_amdgcn_exp2f(p[r]); p[r + 1] = __builtin_amdgcn_exp2f(p[r + 1]); sa += p[r]; sb += p[r + 1]; }
    wA = (v4u){cvtpk(p[0], p[1]), cvtpk(p[2], p[3]), cvtpk(p[4], p[5]), cvtpk(p[6], p[7])};
    wB = (v4u){cvtpk(p[8], p[9]), cvtpk(p[10], p[11]), cvtpk(p[12], p[13]), cvtpk(p[14], p[15])};
}
template <int H> __device__ __forceinline__ void pv_half(unsigned vaddr, const v4u& wA, const v4u& wB, f32x16 (&o)[4]) {
    s16x4 vlo[8], vhi[8];
#pragma unroll
    for (int d0 = 0; d0 < 4; ++d0) { ATT_VRD(vlo[d0], d0 * 4096 + H * 2048); ATT_VRD(vhi[d0], d0 * 4096 + H * 2048 + 512); }
#pragma unroll
    for (int d0 = 0; d0 < 4; ++d0) { ATT_VRD(vlo[4 + d0], d0 * 4096 + H * 2048 + 1024); ATT_VRD(vhi[4 + d0], d0 * 4096 + H * 2048 + 1024 + 512); }
    asm volatile("s_waitcnt lgkmcnt(8)" ::: "memory"); __builtin_amdgcn_sched_barrier(0);
#pragma unroll
    for (int d0 = 0; d0 < 4; ++d0) o[d0] = __builtin_amdgcn_mfma_f32_32x32x16_bf16(__builtin_bit_cast(bf16x8, wA), ATT_VF(d0), o[d0], 0, 0, 0);
    asm volatile("s_waitcnt lgkmcnt(0)" ::: "memory"); __builtin_amdgcn_sched_barrier(0);
#pragma unroll
    for (int d0 = 0; d0 < 4; ++d0) o[d0] = __builtin_amdgcn_mfma_f32_32x32x16_bf16(__builtin_bit_cast(bf16x8, wB), ATT_VF(4 + d0), o[d0], 0, 0, 0);
    __builtin_amdgcn_sched_barrier(0);
}

template <int MODE, bool STAG>
__device__ __forceinline__ void sweep(const UnitCtx& c, const bf16x8 (&qr)[4], float m0, f32x16 (&o)[4], float& lsum, float& rmax) {
    const int NT = c.NT;
    ATT_DMA(0, 0, 0); ATT_DMA(1, KSLOT, VSLOT);
    const unsigned vbase = c.lds0 + LDS_VR + ((c.lane >> 4) & 1) * 32 + (c.lane & 3) * 8 + (4 * c.hi + ((c.lane & 15) >> 2)) * 64;
    int ko = 0, vo = 0;
    v4u pw0 = (v4u){0u, 0u, 0u, 0u}, pw1 = pw0, pw2 = pw0, pw3 = pw0;
    unsigned vprev = vbase;
    for (int t = 0; t < NT; ++t) {
        if (t + 1 < NT) ATT_WAIT_BAR(4); else ATT_WAIT_BAR(0);
        { const int t2 = t + 2; if (t2 < NT) { int k2 = ko + 2 * KSLOT; if (k2 >= NKS * KSLOT) k2 -= NKS * KSLOT; int v2 = vo + 2 * VSLOT; if (v2 >= NVS * VSLOT) v2 -= NVS * VSLOT; ATT_DMA(t2, k2, v2); } }
        f32x16 p0, p1;
        if constexpr (MODE == 1) {
            qk_tile(c, qr, m0, t, ko, p0, p1);
            float a = max3a(p0[0], p0[1], p1[0]), b = max3a(p0[2], p0[3], p1[1]); a = max3a(a, p1[2], p1[3]);
#pragma unroll
            for (int r = 4; r < 16; r += 4) { a = max3a(a, p0[r], p0[r + 1]); b = max3a(b, p0[r + 2], p0[r + 3]); a = max3a(a, p1[r], p1[r + 1]); b = max3a(b, p1[r + 2], p1[r + 3]); }
            rmax = max3a(rmax, a, b);
        } else if constexpr (!STAG) {
            qk_tile(c, qr, m0, t, ko, p0, p1);
            const unsigned vaddr = vbase + (unsigned)vo;
            float sa = 0.f, sb = 0.f;
            exp_half(p0, sa, sb, pw0, pw1);
            {
                s16x4 vlo[8], vhi[8];
#pragma unroll
                for (int d0 = 0; d0 < 4; ++d0) { ATT_VRD(vlo[d0], d0 * 4096); ATT_VRD(vhi[d0], d0 * 4096 + 512); }
#pragma unroll
                for (int d0 = 0; d0 < 4; ++d0) { ATT_VRD(vlo[4 + d0], d0 * 4096 + 1024); ATT_VRD(vhi[4 + d0], d0 * 4096 + 1024 + 512); }
                asm volatile("s_waitcnt lgkmcnt(8)" ::: "memory"); __builtin_amdgcn_sched_barrier(0);
#pragma unroll
                for (int d0 = 0; d0 < 4; ++d0) o[d0] = __builtin_amdgcn_mfma_f32_32x32x16_bf16(__builtin_bit_cast(bf16x8, pw0), ATT_VF(d0), o[d0], 0, 0, 0);
                exp_half(p1, sa, sb, pw2, pw3);
                asm volatile("s_waitcnt lgkmcnt(0)" ::: "memory"); __builtin_amdgcn_sched_barrier(0);
#pragma unroll
                for (int d0 = 0; d0 < 4; ++d0) o[d0] = __builtin_amdgcn_mfma_f32_32x32x16_bf16(__builtin_bit_cast(bf16x8, pw1), ATT_VF(4 + d0), o[d0], 0, 0, 0);
                __builtin_amdgcn_sched_barrier(0);
            }
            lsum += sa + sb;
            pv_half<1>(vaddr, pw2, pw3, o);
        } else {
            if (t > 0) { pv_half<0>(vprev, pw0, pw1, o); pv_half<1>(vprev, pw2, pw3, o); }
            qk_tile(c, qr, m0, t, ko, p0, p1);
            float sa = 0.f, sb = 0.f;
            exp_half(p0, sa, sb, pw0, pw1);
            exp_half(p1, sa, sb, pw2, pw3);
            lsum += sa + sb;
            vprev = vbase + (unsigned)vo;
        }
        ko += KSLOT; if (ko >= NKS * KSLOT) ko = 0;
        vo += VSLOT; if (vo >= NVS * VSLOT) vo = 0;
    }
    if constexpr (MODE == 0 && STAG) { pv_half<0>(vprev, pw0, pw1, o); pv_half<1>(vprev, pw2, pw3, o); }
}

__device__ __forceinline__ void attn_unit(int h, int qb, const bf16* PROJ, bf16* Y, const float* g_subln, float lam, LAS unsigned char* shm) {
    int tid_ = threadIdx.x; asm volatile("" : "+v"(tid_)); const int tid = tid_, lane = tid & 63, r32 = lane & 31, hi = lane >> 5; const int w = __builtin_amdgcn_readfirstlane(tid >> 6);
    UnitCtx c;
    c.m = w >> 2; c.wq = w & 3; c.q0 = qb * QBR; c.r32 = r32; c.hi = hi; c.lane = lane;
    c.lds0 = (unsigned)(uintptr_t)shm; c.shm3 = (lds_cptr)shm;
    LAS float* wsf = (LAS float*)(shm + LDS_WS) + w * 64;
    LAS int* flags = (LAS int*)(shm + LDS_FLAG);
    c.ksrc = PROJ + AW + h * 128 + (size_t)(4 * w + (lane >> 4)) * INC + (((lane & 15) ^ ((4 * w + (lane >> 4)) & 15)) * 8);
    c.vsrc = PROJ + 2 * AW + h * 128 + (size_t)(16 * (w & 3) + (lane >> 2)) * INC + (w >> 2) * 32 + (lane & 3) * 8;
    c.kdst = c.lds0 + LDS_KR + w * 1024; c.vdst = c.lds0 + LDS_VR + w * 1024;
    c.NT = c.q0 / KVB + 2;
    c.qrow = c.q0 + 32 * c.wq + r32;
    c.ch = exp2f(-(float)(h + 1)) * LOG2E;
    bf16x8 qr[4];
    { const bf16* Qw = PROJ + (size_t)c.qrow * INC + h * 128 + c.m * 64 + hi * 8;
#pragma unroll
      for (int d0 = 0; d0 < 4; ++d0) qr[d0] = *(const bf16x8*)(Qw + d0 * 16); }
    asm volatile("" : "+v"(qr[0]), "+v"(qr[1]), "+v"(qr[2]), "+v"(qr[3]));
    f32x16 o[4]; float lsum, m0 = 0.f;
#pragma unroll 1
    for (int pass = 0; ; ++pass) {
#pragma unroll
        for (int d = 0; d < 4; ++d) o[d] = f32x16{};
        lsum = 0.f; float dummy = 0.f;
        if (c.m == 0) sweep<0, false>(c, qr, m0, o, lsum, dummy); else sweep<0, true>(c, qr, m0, o, lsum, dummy);
        lsum = swap_sum(lsum);
        const bool bad = !(lsum > 0.f) || !(lsum < 3.0e38f);
        if (lane == 0) flags[w] = 0;
        if (bad) flags[w] = 1;
        ATT_WAIT_BAR(0);
        int anybad = 0;
#pragma unroll
        for (int i = 0; i < 8; ++i) anybad |= flags[i];
        if (anybad == 0 || pass >= 1) break;
        float rmax = -INFINITY;
        ATT_WAIT_BAR(0);
        sweep<1, false>(c, qr, 0.f, o, lsum, rmax);
        m0 = swap_max(rmax);
        ATT_WAIT_BAR(0);
    }
    if (hi == 0) wsf[32 + r32] = 1.f / lsum;
    asm volatile("s_waitcnt lgkmcnt(0)" ::: "memory");
    { const f32x4 fa = *(const LAS f32x4*)(wsf + 32 + 4 * hi), fb = *(const LAS f32x4*)(wsf + 40 + 4 * hi), fc = *(const LAS f32x4*)(wsf + 48 + 4 * hi), fd = *(const LAS f32x4*)(wsf + 56 + 4 * hi);
      const f32x16 fv = (f32x16){fa.x, fa.y, fa.z, fa.w, fb.x, fb.y, fb.z, fb.w, fc.x, fc.y, fc.z, fc.w, fd.x, fd.y, fd.z, fd.w};
#pragma unroll
      for (int d = 0; d < 4; ++d) o[d] = o[d] * fv; }
    LAS float* o2 = (LAS float*)(shm + LDS_O2) + c.wq * 4096 + lane;
    if (c.m == 1) {
#pragma unroll
        for (int d = 0; d < 4; ++d)
#pragma unroll
            for (int r = 0; r < 16; ++r) o2[(d * 16 + r) * 64] = o[d][r];
    }
    ATT_WAIT_BAR(0);
    if (c.m == 0) {
        float ssq[16];
#pragma unroll
        for (int r = 0; r < 16; ++r) ssq[r] = 0.f;
#pragma unroll
        for (int d = 0; d < 4; ++d)
#pragma unroll
            for (int r = 0; r < 16; ++r) { const float v = o[d][r] - lam * o2[(d * 16 + r) * 64]; o[d][r] = v; ssq[r] += v * v; }
#pragma unroll
        for (int r = 0; r < 16; ++r) {
            float s = ssq[r];
            s += swz_xor<1>(s); s += swz_xor<2>(s); s += swz_xor<4>(s); s += swz_xor<8>(s); s += swz_xor<16>(s);
            ssq[r] = rsqrtf(s * (1.f / 128.f) + EPS) * (1.f - LAMBDA_INIT);
        }
        LAS bf16* stg = (LAS bf16*)(shm + LDS_OST) + c.wq * 4096;
#pragma unroll
        for (int d = 0; d < 4; ++d) { const float gd = g_subln[d * 32 + r32];
#pragma unroll
            for (int r = 0; r < 16; ++r) stg[crow(r, hi) * 128 + d * 32 + r32] = (bf16)f2bf(o[d][r] * ssq[r] * gd); }
        asm volatile("s_waitcnt lgkmcnt(0)" ::: "memory");
        bf16* Yw = Y + (size_t)(c.q0 + 32 * c.wq) * D + h * 128;
#pragma unroll
        for (int i = 0; i < 8; ++i) { const int row = i * 4 + (lane >> 4), chn = lane & 15; const v4u v = *(const LAS v4u*)(stg + row * 128 + chn * 8); *(v4u*)(Yw + (size_t)row * D + chn * 8) = v; }
    }
    ATT_WAIT_BAR(0);
}

__device__ __forceinline__ void attn_phase(const Args& a, LAS unsigned char* lds, int vcu, int G, int lane) {
    const bf16* PROJ = (const bf16*)(a.ws + WS_PROJ); bf16* Y = (bf16*)(a.ws + WS_Y);
    const float lam = __expf(wave_sum(a.in[9][lane] * a.in[10][lane])) - __expf(wave_sum(a.in[11][lane] * a.in[12][lane])) + LAMBDA_INIT;
    for (int u = vcu; u < NH * 32; u += G) {
        const int h = u >> 5, s = u & 31;
#pragma unroll 1
        for (int k = 0; k < 2; ++k) attn_unit(h, k == 0 ? 63 - s : s, PROJ, Y, a.in[13], lam, lds);
    }
}
#undef ATT_VRD
#undef ATT_VF
#undef ATT_DMA
}

namespace peer {
typedef int i32x16 __attribute__((ext_vector_type(16)));
typedef float f32x16s __attribute__((ext_vector_type(16)));
typedef float f32x2 __attribute__((ext_vector_type(2)));
typedef unsigned u32x6 __attribute__((ext_vector_type(6)));
typedef float f32x32 __attribute__((ext_vector_type(32)));
typedef float f32x16v __attribute__((ext_vector_type(16)));
constexpr int ROWB = 1536;
constexpr float U_SCALE = 64.f, V_SCALE = 16.f;
template <int N> __device__ __forceinline__ float dpp_ror(float v) { return __int_as_float(__builtin_amdgcn_update_dpp(0, __float_as_int(v), 0x120 + N, 0xf, 0xf, false)); }
__device__ __forceinline__ void dma_row(const char* rowbase, unsigned lds_dst, unsigned voff) {
    unsigned keep; unsigned long long ex; const unsigned v1 = voff + 1024u;
    asm volatile("s_nop 4\n\ts_mov_b32 %0, m0\n\ts_mov_b32 m0, %3\n\ts_nop 0\n\tglobal_load_lds_dwordx4 %4, %2\n\t"
                 "s_add_u32 m0, m0, 0x400\n\ts_mov_b64 %1, exec\n\ts_mov_b64 exec, 0xffffffff\n\tglobal_load_lds_dwordx4 %5, %2\n\t"
                 "s_mov_b64 exec, %1\n\ts_mov_b32 m0, %0" : "=&s"(keep), "=&s"(ex) : "s"(rowbase), "s"(lds_dst), "v"(voff), "v"(v1) : "memory", "scc");
}
__device__ __forceinline__ void sload16(i32x16& d, const void* p) { asm volatile("s_load_dwordx16 %0, %1, 0x0\n\ts_waitcnt lgkmcnt(0)" : "=&s"(d) : "s"(p) : "memory"); }
__device__ __forceinline__ void sload16x2(i32x16& d0, const void* p0, i32x16& d1, const void* p1) {
    asm volatile("s_load_dwordx16 %0, %2, 0x0\n\ts_load_dwordx16 %1, %3, 0x0\n\ts_waitcnt lgkmcnt(0)" : "=&s"(d0), "=&s"(d1) : "s"(p0), "s"(p1) : "memory"); }
#define PIN16(x, o) asm volatile("" : "+v"(x[o]), "+v"(x[o+1]), "+v"(x[o+2]), "+v"(x[o+3]), "+v"(x[o+4]), "+v"(x[o+5]), "+v"(x[o+6]), "+v"(x[o+7]), "+v"(x[o+8]), "+v"(x[o+9]), "+v"(x[o+10]), "+v"(x[o+11]), "+v"(x[o+12]), "+v"(x[o+13]), "+v"(x[o+14]), "+v"(x[o+15]))
#define PEER_SWAIT() asm volatile("s_waitcnt lgkmcnt(0)" ::: "memory")
#define PEER_VWAIT(N) asm volatile("s_waitcnt vmcnt(" #N ")" ::: "memory")
#define PEER_VWAIT_PF() do { if (PEER_PF == 8) PEER_VWAIT(12); else if (PEER_PF == 6) PEER_VWAIT(8); else if (PEER_PF == 4) PEER_VWAIT(4); else PEER_VWAIT(0); } while (0)
__device__ __forceinline__ f32x32 row32(const LAS unsigned char* slot, int lane) {
    typedef unsigned u32x2 __attribute__((ext_vector_type(2)));
    const LAS u32x2* p = (const LAS u32x2*)(slot + lane * 24);
    const u32x2 d0 = p[0], d1 = p[1], d2 = p[2];
    const u32x6 src = (u32x6){d0.x, d0.y, d1.x, d1.y, d2.x, d2.y};
    const f32x32 f = __builtin_amdgcn_cvt_scalef32_pk32_f32_fp6(src, 1.0f);
    asm volatile("" :: "v"(src));
    return f;
}

__device__ __forceinline__ void phase_peer(const Args& a, LAS unsigned char* lds, int vcu, int G, int tid, int wave, int lane, float* dst, int imask = -1) {
    const float* mod = (const float*)(a.ws + WS_MOD);
    const bf16* XN = (const bf16*)(a.ws + WS_XN); const char* Ub = (const char*)(a.ws + WS_UB); const char* Vb = (const char*)(a.ws + WS_VB);
    const int* IDX = (const int*)(a.ws + WS_IDX); const float* GATE = (const float*)(a.ws + WS_GATE);
    LAS float* gfin = (LAS float*)(lds + XTRA_OFF + 64);
#pragma unroll
    for (int i = 0; i < 4; ++i) { const int k = tid + NTHR * i; gfin[k] = mod[5 * D + k] * a.in[7][k]; }
    __syncthreads();
    const int gw = vcu * NWAVES + wave, NGW = G * NWAVES;
    const int ntok = (S - gw + NGW - 1) / NGW;
    if (ntok <= 0) return;
    const int nbb = ntok * 8;
    const unsigned ring = (unsigned)(uintptr_t)(lds + RING_OFF) + (unsigned)wave * 16384u;
    const LAS unsigned char* ringp = lds + RING_OFF + wave * 16384;
    const unsigned voff = (unsigned)lane * 16u;
    i32x16 ic, in_; f32x16s gc;
    sload16(ic, IDX + (size_t)gw * 128);
    in_ = ic;
#define ROWU(v, e) (Ub + (size_t)(unsigned)((v)[e] & imask) * ROWB)
#define ROWV(v, e) (Vb + (size_t)(unsigned)((v)[e] & imask) * ROWB)
#ifndef PEER_PF
#define PEER_PF 8
#endif
#define SLOT(n) (((n) % PEER_PF) * 2048)
#pragma unroll
    for (int e = 0; e < PEER_PF; ++e) dma_row(ROWU(ic, e), ring + SLOT(e), voff);
    int eo[32];
    {
        f32x16v ta, tb;
#pragma unroll
        for (int i = 0; i < 16; ++i) { ta[i] = 0.125f * (float)i; tb[i] = (i < 8) ? 2.f + 0.25f * (float)i : 4.f + 0.5f * (float)(i - 8); }
        const u32x6 tp = __builtin_amdgcn_cvt_scalef32_2xpk16_fp6_f32(ta, tb, 1.0f);
        asm volatile("" :: "v"(ta), "v"(tb));
        const f32x32 tf = __builtin_amdgcn_cvt_scalef32_pk32_f32_fp6(tp, 1.0f);
        asm volatile("" :: "v"(tp));
#pragma unroll
        for (int p = 0; p < 32; ++p) { const float v = tf[p]; const int i = (v < 2.f) ? (int)(v * 8.f) : (v < 4.f) ? 16 + (int)((v - 2.f) * 4.f) : 24 + (int)((v - 4.f) * 2.f);
            eo[p] = ((i & 16) ? 1024 : 0) + lane * 16 + (i & 15); }
    }
    float hp[32];
    float op[32];
    int tok = gw;
    for (int bb = 0; bb < nbb; ++bb) {
        const int b = bb & 7;
        if (b == 0) {
            tok = gw + (bb >> 3) * NGW;
#pragma unroll
            for (int p = 0; p < 32; ++p) hp[p] = bf2f(XN[(size_t)tok * D + eo[p]]);
            PIN16(hp, 0); PIN16(hp, 16);
#pragma unroll
            for (int p = 0; p < 32; ++p) op[p] = 0.f;
        }
        {
            const int nb = (bb + 1 < nbb) ? bb + 1 : bb;
            const size_t nofs = (size_t)(gw + (nb >> 3) * NGW) * 128 + (nb & 7) * 16;
            i32x16 gtmp;
            sload16x2(gtmp, GATE + (size_t)tok * 128 + b * 16, in_, IDX + nofs);
            gc = __builtin_bit_cast(f32x16s, gtmp);
        }
        float s[16];
#pragma unroll
        for (int st = 0; st < 8; ++st) {
            PEER_VWAIT_PF();
            const f32x32 f0 = row32(ringp + SLOT(2 * st), lane), f1 = row32(ringp + SLOT(2 * st + 1), lane);
            PEER_SWAIT();
            {
                const int e8 = 2 * st + PEER_PF;
                if (e8 < 16) { dma_row(ROWU(ic, e8), ring + SLOT(2 * st), voff); dma_row(ROWU(ic, e8 + 1), ring + SLOT(2 * st + 1), voff); }
                else { dma_row(ROWV(ic, e8 - 16), ring + SLOT(2 * st), voff); dma_row(ROWV(ic, e8 - 15), ring + SLOT(2 * st + 1), voff); }
            }
            float a0 = 0.f, a1 = 0.f, b0 = 0.f, b1 = 0.f;
#pragma unroll
            for (int p = 0; p < 32; p += 2) { a0 += f0[p] * hp[p]; b0 += f0[p + 1] * hp[p + 1]; a1 += f1[p] * hp[p]; b1 += f1[p + 1] * hp[p + 1]; }
            s[2 * st] = a0 + b0; s[2 * st + 1] = a1 + b1;
            asm volatile("" : "+v"(s[2 * st]), "+v"(s[2 * st + 1]));
        }
        float u[4];
        {
            float t8[8];
#pragma unroll
            for (int e = 0; e < 8; ++e) { auto rr = __builtin_amdgcn_permlane32_swap(__float_as_uint(s[e]), __float_as_uint(s[e + 8]), false, false); t8[e] = __uint_as_float(rr[0]) + __uint_as_float(rr[1]); }
#pragma unroll
            for (int e = 0; e < 4; ++e) { auto rr = __builtin_amdgcn_permlane16_swap(__float_as_uint(t8[e]), __float_as_uint(t8[e + 4]), false, false); u[e] = __uint_as_float(rr[0]) + __uint_as_float(rr[1]); }
#pragma unroll
            for (int e = 0; e < 4; ++e) { u[e] += dpp_ror<8>(u[e]); u[e] += dpp_ror<4>(u[e]); u[e] += dpp_ror<2>(u[e]); u[e] += dpp_ror<1>(u[e]); }
        }
        if (b == 7) {
            const float* xp = (const float*)(a.ws + WS_X1) + (size_t)tok * D;
#pragma unroll
            for (int p = 0; p < 32; ++p) hp[p] = xp[eo[p]];
        }
        float actv;
        { const int k = lane & 3; const float d = ((k == 0) ? u[0] : (k == 1) ? u[1] : (k == 2) ? u[2] : u[3]) * (1.f / U_SCALE);
          actv = 0.5f * d * (1.f + erff(d * 0.70710678118654752f)) * (1.f / V_SCALE); }
#pragma unroll
        for (int st = 0; st < 8; ++st) {
            PEER_VWAIT_PF();
            const f32x32 f0 = row32(ringp + SLOT(2 * st), lane), f1 = row32(ringp + SLOT(2 * st + 1), lane);
            PEER_SWAIT();
            {
                const int e8 = 2 * st + PEER_PF;
                if (e8 < 16) { dma_row(ROWV(ic, e8), ring + SLOT(2 * st), voff); dma_row(ROWV(ic, e8 + 1), ring + SLOT(2 * st + 1), voff); }
                else { dma_row(ROWU(in_, e8 - 16), ring + SLOT(2 * st), voff); dma_row(ROWU(in_, e8 - 15), ring + SLOT(2 * st + 1), voff); }
            }
            const int e0 = 2 * st, e1 = 2 * st + 1;
            const float g0 = __int_as_float(__builtin_amdgcn_readlane(__float_as_int(actv), 16 * (e0 >> 2) + (e0 & 3))) * gc[e0], g1 = __int_as_float(__builtin_amdgcn_readlane(__float_as_int(actv), 16 * (e1 >> 2) + (e1 & 3))) * gc[e1];
#pragma unroll
            for (int p = 0; p < 32; ++p) op[p] += g0 * f0[p] + g1 * f1[p];
            PIN16(op, 16);
            PIN16(op, 0);
        }
        ic = in_;
        if (b == 7) {
            float ss = 0.f;
#pragma unroll
            for (int p = 0; p < 32; ++p) ss += op[p] * op[p];
            const float r = rsqrtf(wave_sum(ss) * (1.f / D) + EPS);
            float* dp = dst + (size_t)tok * D;
#pragma unroll
            for (int p = 0; p < 32; ++p) dp[eo[p]] = hp[p] + op[p] * r * gfin[eo[p]];
        }
    }
    PEER_VWAIT(0);
#undef ROWU
#undef ROWV
#undef SLOT
}
#undef PEER_SWAIT
#undef PEER_VWAIT
}

namespace peer3 {
using peer::i32x16; using peer::f32x16s; using peer::u32x6; using peer::f32x32; using peer::f32x16v; using peer::ROWB; using peer::U_SCALE; using peer::V_SCALE; using peer::dpp_ror;
using peer::sload16; using peer::sload16x2;
typedef unsigned u32x2 __attribute__((ext_vector_type(2)));
struct Raw { u32x2 a, b, c; };
__device__ __forceinline__ Raw load_row(const char* lanebase, int idx) {
    const u32x2* gp = (const u32x2*)(lanebase + (size_t)(unsigned)idx * ROWB);
    Raw r; r.a = gp[0]; r.b = gp[1]; r.c = gp[2]; return r;
}
__device__ __forceinline__ f32x32 decode(const Raw& r) {
    const u32x6 src = (u32x6){r.a.x, r.a.y, r.b.x, r.b.y, r.c.x, r.c.y};
    const f32x32 f = __builtin_amdgcn_cvt_scalef32_pk32_f32_fp6(src, 1.0f);
    asm volatile("" :: "v"(src));
    return f;
}
__device__ __forceinline__ void calibrate(int (&eo)[32], int lane, float zero) {
    f32x16v ta, tb;
#pragma unroll
    for (int i = 0; i < 16; ++i) { ta[i] = 0.125f * (float)i + zero; tb[i] = ((i < 8) ? 2.f + 0.25f * (float)i : 4.f + 0.5f * (float)(i - 8)) + zero; }
    const u32x6 tp = __builtin_amdgcn_cvt_scalef32_2xpk16_fp6_f32(ta, tb, 1.0f);
    asm volatile("" :: "v"(ta), "v"(tb));
    const f32x32 tf = __builtin_amdgcn_cvt_scalef32_pk32_f32_fp6(tp, 1.0f);
    asm volatile("" :: "v"(tp));
#pragma unroll
    for (int p = 0; p < 32; ++p) { const float v = tf[p]; const int i = (v < 2.f) ? (int)(v * 8.f) : (v < 4.f) ? 16 + (int)((v - 2.f) * 4.f) : 24 + (int)((v - 4.f) * 2.f);
        eo[p] = ((i & 16) ? 1024 : 0) + lane * 16 + (i & 15); }
}
#define PIN16(x, o) asm volatile("" : "+v"(x[o]), "+v"(x[o+1]), "+v"(x[o+2]), "+v"(x[o+3]), "+v"(x[o+4]), "+v"(x[o+5]), "+v"(x[o+6]), "+v"(x[o+7]), "+v"(x[o+8]), "+v"(x[o+9]), "+v"(x[o+10]), "+v"(x[o+11]), "+v"(x[o+12]), "+v"(x[o+13]), "+v"(x[o+14]), "+v"(x[o+15]))

template <int MODE = 0>
__device__ __forceinline__ void phase_peer(const Args& a, LAS unsigned char* lds, int vcu, int G, int tid, int wave, int lane, float* dst, int imask = -1) {
    const float* mod = (const float*)(a.ws + WS_MOD);
    const bf16* XN = (const bf16*)(a.ws + WS_XN); const char* Ul = (const char*)(a.ws + WS_UB) + lane * 24; const char* Vl = (const char*)(a.ws + WS_VB) + lane * 24;
    const int* IDX = (const int*)(a.ws + WS_IDX); const float* GATE = (const float*)(a.ws + WS_GATE);
    LAS float* gfin = (LAS float*)(lds + XTRA_OFF + 64);
#pragma unroll
    for (int i = 0; i < 4; ++i) { const int k = tid + NTHR * i; gfin[k] = mod[5 * D + k] * a.in[7][k]; }
    __syncthreads();
    const int gw = vcu * NWAVES + wave, NGW = G * NWAVES;
    const int ntok = (S - gw + NGW - 1) / NGW;
    if (ntok <= 0) return;
    const int nbb = ntok * 8;
    i32x16 ic, in_; f32x16s gc;
    sload16(ic, IDX + (size_t)gw * 128);
    in_ = ic;
#define ROWU(v, e) load_row(Ul, (v)[e] & imask)
#define ROWV(v, e) load_row(Vl, (v)[e] & imask)
    Raw raw[8];
#pragma unroll
    for (int e = 0; e < 8; ++e) raw[e] = ROWU(ic, e);
    float hp[32];
    float op[32];
    int tok = gw;
    for (int bb = 0; bb < nbb; ++bb) {
        const int b = bb & 7;
        if (b == 0) {
            tok = gw + (bb >> 3) * NGW;
            int eo[32]; { int l2 = lane; float z = 0.f; asm volatile("" : "+v"(l2), "+v"(z)); calibrate(eo, l2, z); }
#pragma unroll
            for (int p = 0; p < 32; ++p) hp[p] = bf2f(XN[(size_t)tok * D + eo[p]]);
            PIN16(hp, 0); PIN16(hp, 16);
#pragma unroll
            for (int p = 0; p < 32; ++p) op[p] = 0.f;
        }
        {
            const int nb = (bb + 1 < nbb) ? bb + 1 : bb;
            const size_t nofs = (size_t)(gw + (nb >> 3) * NGW) * 128 + (nb & 7) * 16;
            i32x16 gtmp;
            sload16x2(gtmp, GATE + (size_t)tok * 128 + b * 16, in_, IDX + nofs);
            gc = __builtin_bit_cast(f32x16s, gtmp);
        }
        float s[16];
#pragma unroll
        for (int n = 0; n < 16; ++n) {
            f32x32 f = decode(raw[n & 7]);
            asm volatile("" : "+v"(f) :: "memory");
            if (MODE != 2) raw[n & 7] = (n + 8 < 16) ? ROWU(ic, n + 8) : ROWV(ic, n - 8);
            float a0 = 0.f, a1 = 0.f, a2 = 0.f, a3 = 0.f;
#pragma unroll
            for (int p = 0; p < (MODE == 1 ? 4 : 32); p += 4) { a0 += f[p] * hp[p]; a1 += f[p + 1] * hp[p + 1]; a2 += f[p + 2] * hp[p + 2]; a3 += f[p + 3] * hp[p + 3]; }
            s[n] = (a0 + a1) + (a2 + a3);
            asm volatile("" : "+v"(s[n]));
        }
        float u[4];
        {
            float t8[8];
#pragma unroll
            for (int e = 0; e < 8; ++e) { auto rr = __builtin_amdgcn_permlane32_swap(__float_as_uint(s[e]), __float_as_uint(s[e + 8]), false, false); t8[e] = __uint_as_float(rr[0]) + __uint_as_float(rr[1]); }
#pragma unroll
            for (int e = 0; e < 4; ++e) { auto rr = __builtin_amdgcn_permlane16_swap(__float_as_uint(t8[e]), __float_as_uint(t8[e + 4]), false, false); u[e] = __uint_as_float(rr[0]) + __uint_as_float(rr[1]); }
#pragma unroll
            for (int e = 0; e < 4; ++e) { u[e] += dpp_ror<8>(u[e]); u[e] += dpp_ror<4>(u[e]); u[e] += dpp_ror<2>(u[e]); u[e] += dpp_ror<1>(u[e]); }
        }
        int eo[32];
        if (b == 7) {
            { int l2 = lane; float z = 0.f; asm volatile("" : "+v"(l2), "+v"(z)); calibrate(eo, l2, z); }
            const float* xp = (const float*)(a.ws + WS_X1) + (size_t)tok * D;
#pragma unroll
            for (int p = 0; p < 32; ++p) hp[p] = xp[eo[p]];
        }
        float actv;
        { const int k = lane & 3; const float d = ((k == 0) ? u[0] : (k == 1) ? u[1] : (k == 2) ? u[2] : u[3]) * (1.f / U_SCALE);
          actv = 0.5f * d * (1.f + erff(d * 0.70710678118654752f)) * (1.f / V_SCALE); }
#pragma unroll
        for (int n = 0; n < 16; ++n) {
            f32x32 f = decode(raw[n & 7]);
            asm volatile("" : "+v"(f) :: "memory");
            if (MODE != 2) raw[n & 7] = (n + 8 < 16) ? ROWV(ic, n + 8) : ROWU(in_, n - 8);
            const float g = __int_as_float(__builtin_amdgcn_readlane(__float_as_int(actv), 16 * (n >> 2) + (n & 3))) * gc[n];
#pragma unroll
            for (int p = 0; p < (MODE == 1 ? 2 : 32); ++p) op[p] += g * f[p];
            if (n & 1) { PIN16(op, 16); PIN16(op, 0); }
        }
        ic = in_;
        if (b == 7) {
            float ss = 0.f;
#pragma unroll
            for (int p = 0; p < 32; ++p) ss += op[p] * op[p];
            const float r = rsqrtf(wave_sum(ss) * (1.f / D) + EPS);
            float* dp = dst + (size_t)tok * D;
#pragma unroll
            for (int p = 0; p < 32; ++p) dp[eo[p]] = hp[p] + op[p] * r * gfin[eo[p]];
        }
    }
#undef ROWU
#undef ROWV
}
#undef PIN16
}

namespace peer4 {
using peer::u32x6; using peer::f32x32; using peer::f32x16v; using peer::ROWB; using peer::U_SCALE; using peer::V_SCALE; using peer::dpp_ror;
using peer3::Raw; using peer3::decode; using peer3::calibrate;
typedef unsigned u32x2 __attribute__((ext_vector_type(2)));
constexpr int PF = 4;
#define PIN16(x, o) asm volatile("" : "+v"(x[o]), "+v"(x[o+1]), "+v"(x[o+2]), "+v"(x[o+3]), "+v"(x[o+4]), "+v"(x[o+5]), "+v"(x[o+6]), "+v"(x[o+7]), "+v"(x[o+8]), "+v"(x[o+9]), "+v"(x[o+10]), "+v"(x[o+11]), "+v"(x[o+12]), "+v"(x[o+13]), "+v"(x[o+14]), "+v"(x[o+15]))
__device__ __forceinline__ Raw load_row(const char* tab, int idx, unsigned voff24) {
    const u32x2* gp = (const u32x2*)(tab + (size_t)(unsigned)idx * ROWB + voff24);
    Raw r; r.a = gp[0]; r.b = gp[1]; r.c = gp[2]; return r;
}
struct Ids { int v[16]; };
__device__ __forceinline__ Ids ids_of(int ent) { Ids I;
#pragma unroll
    for (int e = 0; e < 16; ++e) I.v[e] = __builtin_amdgcn_readlane(ent, e);
    return I; }

__device__ __forceinline__ void phase_peer(const Args& a, LAS unsigned char* lds, int vcu, int G, int tid, int wave, int lane, unsigned xcc, float* dst) {
    const float* mod = (const float*)(a.ws + WS_MOD);
    const bf16* XN = (const bf16*)(a.ws + WS_XN); const char* Ub = (const char*)(a.ws + WS_UB); const char* Vb = (const char*)(a.ws + WS_VB);
    const int* IDX = (const int*)(a.ws + WS_IDX); const float* GATE = (const float*)(a.ws + WS_GATE);
    LAS float* gfin = (LAS float*)(lds + XTRA_OFF + 64);
#pragma unroll
    for (int i = 0; i < 4; ++i) { const int k = tid + NTHR * i; gfin[k] = mod[5 * D + k] * a.in[7][k]; }
    __syncthreads();
    const int gw = vcu * NWAVES + wave, NGW = G * NWAVES;
    const int ntok = (S - gw + NGW - 1) / NGW;
    LAS int* SI = (LAS int*)(lds + RING_OFF + wave * 16384);
    LAS float* SG = (LAS float*)(lds + RING_OFF + wave * 16384 + 512);
    LAS float* ACT = (LAS float*)(lds + RING_OFF + wave * 16384 + 1024);
    const unsigned voff24 = (unsigned)lane * 24u;
    float hp[32];
    float op[32];
#pragma unroll 1
    for (int t = 0; t < ntok; ++t) {
        const int tok = gw + t * NGW;
        {
            const int i0 = IDX[(size_t)tok * 128 + lane], i1 = IDX[(size_t)tok * 128 + 64 + lane];
            const float g0 = GATE[(size_t)tok * 128 + lane], g1 = GATE[(size_t)tok * 128 + 64 + lane];
            const int k0 = ((i0 >> 11) - (int)xcc) & 7, k1 = ((i1 >> 11) - (int)xcc) & 7;
            int pos0 = 0, pos1 = 0, off = 0;
#pragma unroll
            for (int j = 0; j < 8; ++j) {
                const unsigned long long m0 = __ballot(k0 == j), m1 = __ballot(k1 == j);
                const int n0 = __builtin_popcountll(m0);
                const int c0 = __builtin_amdgcn_mbcnt_hi((unsigned)(m0 >> 32), __builtin_amdgcn_mbcnt_lo((unsigned)m0, 0u));
                const int c1 = __builtin_amdgcn_mbcnt_hi((unsigned)(m1 >> 32), __builtin_amdgcn_mbcnt_lo((unsigned)m1, 0u));
                pos0 = (k0 == j) ? off + c0 : pos0; pos1 = (k1 == j) ? off + n0 + c1 : pos1;
                off += n0 + __builtin_popcountll(m1);
            }
            SI[pos0] = i0; SI[pos1] = i1; SG[pos0] = g0; SG[pos1] = g1;
        }
        {
            int eo[32]; { int l2 = lane; float z = 0.f; asm volatile("" : "+v"(l2), "+v"(z)); calibrate(eo, l2, z); }
#pragma unroll
            for (int p = 0; p < 32; ++p) hp[p] = bf2f(XN[(size_t)tok * D + eo[p]]);
            PIN16(hp, 0); PIN16(hp, 16);
#pragma unroll
            for (int p = 0; p < 32; ++p) op[p] = 0.f;
        }
        Ids ic = ids_of(SI[lane & 15]), in_ = ic;
        Raw raw[PF];
#pragma unroll
        for (int e = 0; e < PF; ++e) raw[e] = load_row(Ub, ic.v[e], voff24);
#pragma unroll 1
        for (int b = 0; b < 8; ++b) {
            const char* nxt = (b == 7) ? Vb : Ub;
            in_ = ids_of(SI[((b + 1) & 7) * 16 + (lane & 15)]);
            float s[16];
#pragma unroll
            for (int n = 0; n < 16; ++n) {
                f32x32 f = decode(raw[n % PF]);
                asm volatile("" : "+v"(f) :: "memory");
                { const int t2 = n + PF; raw[n % PF] = (t2 < 16) ? load_row(Ub, ic.v[t2 & 15], voff24) : load_row(nxt, in_.v[t2 & 15], voff24); }
                float a0 = 0.f, a1 = 0.f, a2 = 0.f, a3 = 0.f;
#pragma unroll
                for (int p = 0; p < 32; p += 4) { a0 += f[p] * hp[p]; a1 += f[p + 1] * hp[p + 1]; a2 += f[p + 2] * hp[p + 2]; a3 += f[p + 3] * hp[p + 3]; }
                s[n] = (a0 + a1) + (a2 + a3);
                asm volatile("" : "+v"(s[n]));
            }
            float u[4];
            {
                float t8[8];
#pragma unroll
                for (int e = 0; e < 8; ++e) { auto rr = __builtin_amdgcn_permlane32_swap(__float_as_uint(s[e]), __float_as_uint(s[e + 8]), false, false); t8[e] = __uint_as_float(rr[0]) + __uint_as_float(rr[1]); }
#pragma unroll
                for (int e = 0; e < 4; ++e) { auto rr = __builtin_amdgcn_permlane16_swap(__float_as_uint(t8[e]), __float_as_uint(t8[e + 4]), false, false); u[e] = __uint_as_float(rr[0]) + __uint_as_float(rr[1]); }
#pragma unroll
                for (int e = 0; e < 4; ++e) { u[e] += dpp_ror<8>(u[e]); u[e] += dpp_ror<4>(u[e]); u[e] += dpp_ror<2>(u[e]); u[e] += dpp_ror<1>(u[e]); }
            }
            { const int k = lane & 3; const float d = ((k == 0) ? u[0] : (k == 1) ? u[1] : (k == 2) ? u[2] : u[3]) * (1.f / U_SCALE);
              ACT[b * 64 + lane] = 0.5f * d * (1.f + erff(d * 0.70710678118654752f)) * (1.f / V_SCALE); }
            ic = in_;
        }
        int eo[32];
#pragma unroll 1
        for (int b = 0; b < 8; ++b) {
            in_ = ids_of(SI[((b + 1) & 7) * 16 + (lane & 15)]);
            const float coef = ACT[b * 64 + lane] * SG[b * 16 + 4 * (lane >> 4) + (lane & 3)];
            if (b == 7) {
                { int l2 = lane; float z = 0.f; asm volatile("" : "+v"(l2), "+v"(z)); calibrate(eo, l2, z); }
                const float* xp = (const float*)(a.ws + WS_X1) + (size_t)tok * D;
#pragma unroll
                for (int p = 0; p < 32; ++p) hp[p] = xp[eo[p]];
            }
#pragma unroll
            for (int n = 0; n < 16; ++n) {
                f32x32 f = decode(raw[n % PF]);
                asm volatile("" : "+v"(f) :: "memory");
                { const int t2 = n + PF; raw[n % PF] = (t2 < 16) ? load_row(Vb, ic.v[t2 & 15], voff24) : load_row(Vb, in_.v[t2 & 15], voff24); }
                const float g = __int_as_float(__builtin_amdgcn_readlane(__float_as_int(coef), 16 * (n >> 2) + (n & 3)));
#pragma unroll
                for (int p = 0; p < 32; ++p) op[p] += g * f[p];
                if (n & 1) { PIN16(op, 16); PIN16(op, 0); }
            }
            ic = in_;
        }
        {
            float ss = 0.f;
#pragma unroll
            for (int p = 0; p < 32; ++p) ss += op[p] * op[p];
            const float r = rsqrtf(wave_sum(ss) * (1.f / D) + EPS);
            float* dp = dst + (size_t)tok * D;
#pragma unroll
            for (int p = 0; p < 32; ++p) dp[eo[p]] = hp[p] + op[p] * r * gfin[eo[p]];
        }
    }
}
#undef PIN16
}

namespace topk {
using f32x16 = __attribute__((ext_vector_type(16))) float;
constexpr int LDS_KIMG = 0, LDS_TK = 65536;
__device__ __forceinline__ float swapf(float m) { auto rr = __builtin_amdgcn_permlane32_swap(__float_as_uint(m), __float_as_uint(m), false, false); return (threadIdx.x & 32) ? __uint_as_float(rr[0]) : __uint_as_float(rr[1]); }
__device__ __forceinline__ float max3(float a, float b, float c) { return fmaxf(fmaxf(a, b), c); }

__device__ __forceinline__ void half_topk(const bf16* qrow  , const LAS unsigned char* kimg, int r32, int hi, float (&vals)[16]) {
    bf16x8 qf[8];
#pragma unroll
    for (int ks = 0; ks < 8; ++ks) qf[ks] = *(const bf16x8*)(qrow + ks * 16 + hi * 8);
    float p[64];
#pragma unroll
    for (int blk = 0; blk < 4; ++blk) {
        f32x16 acc = f32x16{};
#pragma unroll
        for (int ks = 0; ks < 8; ++ks) {
            const bf16x8 kf = *(const LAS bf16x8*)(kimg + (ks * 2 + hi) * 2048 + (32 * blk + r32) * 16);
            acc = __builtin_amdgcn_mfma_f32_32x32x16_bf16(kf, qf[ks], acc, 0, 0, 0);
        }
#pragma unroll
        for (int r = 0; r < 16; ++r) { const int key = 32 * blk + (r & 3) + 8 * (r >> 2) + 4 * hi; p[blk * 16 + r] = __uint_as_float((__float_as_uint(acc[r]) & 0xffffff80u) | (unsigned)(127 - key)); }
    }
#pragma unroll
    for (int rd = 0; rd < 16; ++rd) {
        float m = max3(p[0], p[1], p[2]);
#pragma unroll
        for (int i = 3; i < 63; i += 2) m = max3(m, p[i], p[i + 1]);
        m = fmaxf(m, p[63]);
        const float g = fmaxf(m, swapf(m));
        vals[rd] = g;
#pragma unroll
        for (int i = 0; i < 64; ++i) p[i] = (__float_as_uint(p[i]) == __float_as_uint(g)) ? -INFINITY : p[i];
    }
}

__device__ __forceinline__ void phase_topk(const Args& a, LAS unsigned char* lds, int vcu, int G, int tid, int wave, int lane) {
    for (int e = tid; e < 2 * 128 * 16; e += NTHR) {
        const int half = e >> 11, key = (e >> 4) & 127, c = e & 15;
        const float* src = a.in[20 + half] + key * 128 + c * 8;
        const f32x4 x0 = *(const f32x4*)src, x1 = *(const f32x4*)(src + 4);
        v4u o; o.x = pk2(x0.x, x0.y); o.y = pk2(x0.z, x0.w); o.z = pk2(x1.x, x1.y); o.w = pk2(x1.z, x1.w);
        *(LAS v4u*)(lds + LDS_KIMG + half * 32768 + c * 2048 + key * 16) = o;
    }
    __syncthreads();
    const bf16* QP = (const bf16*)(a.ws + WS_QP); int* idx_out = (int*)(a.ws + WS_IDX); float* g_out = (float*)(a.ws + WS_GATE);
    const int r32 = lane & 31, hi = lane >> 5;
    LAS int* tk = (LAS int*)(lds + LDS_TK + wave * 4096) + r32 * 32;
    const int gw = vcu * NWAVES + wave, NGW = G * NWAVES;
    if (wave < 4) convert_tables(a, CVT_EARLY_ROWS, 2 * NEXP, gw, NGW, lane);
    for (int task = gw; task < (S / 32) * PH; task += NGW) {
        const int tb = task >> 3, h = task & 7, token = tb * 32 + r32;
        const bf16* qrow = QP + (size_t)token * D + h * PKD;
        float v1[16], v2[16];
        half_topk(qrow, lds + LDS_KIMG, r32, hi, v1);
        half_topk(qrow + 128, lds + LDS_KIMG + 32768, r32, hi, v2);
        if (hi == 0) {
#pragma unroll
            for (int i = 0; i < 16; ++i) { tk[i] = 127 - (int)(__float_as_uint(v1[i]) & 0x7fu); tk[16 + i] = 127 - (int)(__float_as_uint(v2[i]) & 0x7fu); }
        }
        float c[25];
        {
            int k = 0;
#pragma unroll
            for (int ai = 0; ai < 16; ++ai)
#pragma unroll
                for (int bi = 0; bi < 16; ++bi) if ((ai + 1) * (bi + 1) <= 16) {
                    const float sm = __uint_as_float(__float_as_uint(v1[ai]) & 0xffffff80u) + __uint_as_float(__float_as_uint(v2[bi]) & 0xffffff80u);
                    const float pk = __uint_as_float((__float_as_uint(sm) & 0xffffff00u) | (unsigned)(255 - (ai * 16 + bi)));
                    if ((k & 1) == 0) c[k >> 1] = pk; else c[k >> 1] = hi ? pk : c[k >> 1];
                    ++k;
                }
        }
        float top[16];
#pragma unroll
        for (int rd = 0; rd < 16; ++rd) {
            float m = c[0];
#pragma unroll
            for (int i = 1; i < 25; i += 2) m = max3(m, c[i], c[i + 1]);
            const float g = fmaxf(m, swapf(m));
            top[rd] = g;
#pragma unroll
            for (int i = 0; i < 25; ++i) c[i] = (__float_as_uint(c[i]) == __float_as_uint(g)) ? -INFINITY : c[i];
        }
        asm volatile("s_waitcnt lgkmcnt(0)" ::: "memory");
        const float mx = __uint_as_float(__float_as_uint(top[0]) & 0xffffff00u);
        float ev[16], den = 0.f;
#pragma unroll
        for (int i = 0; i < 16; ++i) { ev[i] = __expf(__uint_as_float(__float_as_uint(top[i]) & 0xffffff00u) - mx); den += ev[i]; }
        const float rden = 1.f / den;
        if (hi == 0) {
            const size_t ob = ((size_t)token * PH + h) * PTOP;
#pragma unroll
            for (int q4 = 0; q4 < 4; ++q4) {
                int oi[4]; float og[4];
#pragma unroll
                for (int i = 0; i < 4; ++i) { const int flat = 255 - (int)(__float_as_uint(top[q4 * 4 + i]) & 0xffu); oi[i] = tk[flat >> 4] * PKEYS + tk[16 + (flat & 15)]; og[i] = ev[q4 * 4 + i] * rden; }
                *(v4u*)(idx_out + ob + q4 * 4) = (v4u){(unsigned)oi[0], (unsigned)oi[1], (unsigned)oi[2], (unsigned)oi[3]};
                *(f32x4*)(g_out + ob + q4 * 4) = (f32x4){og[0], og[1], og[2], og[3]};
            }
        }
        asm volatile("s_waitcnt lgkmcnt(0)" ::: "memory");
    }
    if (wave >= 4) convert_tables(a, CVT_EARLY_ROWS, 2 * NEXP, gw, NGW, lane);
}
}

namespace conv {
constexpr int TCH = 32, ROWS = TCH + CK - 1;
constexpr int LDS_U = 0, LDS_PART = ROWS * CW * 2, LDS_STAT = LDS_PART + 8 * 64 * 4;
template <int N> __device__ __forceinline__ float dpp_ror(float v) { return __int_as_float(__builtin_amdgcn_update_dpp(0, __float_as_int(v), 0x120 + N, 0xf, 0xf, false)); }

__device__ __forceinline__ void phase_conv(const Args& a, LAS unsigned char* lds, int vcu, int G, int tid, int wave, int lane) {
    const bf16* PROJ = (const bf16*)(a.ws + WS_PROJ); bf16* Y = (bf16*)(a.ws + WS_Y);
    const float* conv_w = a.in[14]; const float* conv_b = a.in[15]; const float* ln_g = a.in[16]; const float* ln_b = a.in[17];
    LAS unsigned* ut = (LAS unsigned*)(lds + LDS_U);
    LAS float* part = (LAS float*)(lds + LDS_PART);
    LAS float* stat = (LAS float*)(lds + LDS_STAT);
    float w0[CK], w1[CK];
#pragma unroll
    for (int j = 0; j < CK; ++j) { const float2 wv = *(const float2*)(conv_w + j * CW + 2 * tid); w0[j] = wv.x; w1[j] = wv.y; }
    const float2 cb = *(const float2*)(conv_b + 2 * tid), lg = *(const float2*)(ln_g + 2 * tid), lb = *(const float2*)(ln_b + 2 * tid);
    for (int ch = vcu; ch < S / TCH; ch += G) {
        const int t0 = ch * TCH;
        __syncthreads();
#pragma unroll 8
        for (int r = 0; r < ROWS; ++r) {
            const int tt = t0 - (CK - 1) + r;
            unsigned pk = 0u;
            if (tt >= 0) {
                const unsigned av = *((const unsigned*)(PROJ + (size_t)tt * INC + 3 * AW) + tid);
                const unsigned gv = *((const unsigned*)(PROJ + (size_t)tt * INC + 3 * AW + CW) + tid);
                pk = pk2(bflo(av) * __builtin_amdgcn_rcpf(1.f + __expf(-bflo(gv))), bfhi(av) * __builtin_amdgcn_rcpf(1.f + __expf(-bfhi(gv))));
            }
            ut[r * 512 + tid] = pk;
        }
        __syncthreads();
        float y0[TCH], y1[TCH];
#pragma unroll
        for (int g8 = 0; g8 < 4; ++g8) {
            unsigned uu[38];
#pragma unroll
            for (int r = 0; r < 38; ++r) uu[r] = ut[(g8 * 8 + r) * 512 + tid];
#pragma unroll
            for (int t = 0; t < 8; ++t) {
                float s0 = cb.x, s1 = cb.y;
#pragma unroll
                for (int j = 0; j < CK; ++j) { s0 += w0[j] * bflo(uu[t + j]); s1 += w1[j] * bfhi(uu[t + j]); }
                y0[g8 * 8 + t] = s0; y1[g8 * 8 + t] = s1;
            }
        }
#pragma unroll
        for (int hf = 0; hf < 2; ++hf) {
            float v[32];
#pragma unroll
            for (int t = 0; t < 16; ++t) { const float a0 = y0[hf * 16 + t], a1 = y1[hf * 16 + t]; v[2 * t] = a0 + a1; v[2 * t + 1] = a0 * a0 + a1 * a1; }
            float h16[16];
#pragma unroll
            for (int i = 0; i < 16; ++i) { auto rr = __builtin_amdgcn_permlane32_swap(__float_as_uint(v[i]), __float_as_uint(v[i + 16]), false, false); h16[i] = __uint_as_float(rr[0]) + __uint_as_float(rr[1]); }
            float h8[8];
#pragma unroll
            for (int i = 0; i < 8; ++i) { auto rr = __builtin_amdgcn_permlane16_swap(__float_as_uint(h16[i]), __float_as_uint(h16[i + 8]), false, false); h8[i] = __uint_as_float(rr[0]) + __uint_as_float(rr[1]); }
#pragma unroll
            for (int i = 0; i < 8; ++i) { h8[i] += dpp_ror<8>(h8[i]); h8[i] += dpp_ror<4>(h8[i]); h8[i] += dpp_ror<2>(h8[i]); h8[i] += dpp_ror<1>(h8[i]); }
            if ((lane & 15) == 0) {
                *(LAS f32x4*)(part + wave * 64 + hf * 32 + 8 * (lane >> 4)) = (f32x4){h8[0], h8[1], h8[2], h8[3]};
                *(LAS f32x4*)(part + wave * 64 + hf * 32 + 8 * (lane >> 4) + 4) = (f32x4){h8[4], h8[5], h8[6], h8[7]};
            }
        }
        __syncthreads();
        if (tid < TCH) {
            float s = 0.f, ss = 0.f;
#pragma unroll
            for (int w = 0; w < 8; ++w) { s += part[w * 64 + 2 * tid]; ss += part[w * 64 + 2 * tid + 1]; }
            const float mu = s * (1.f / CW), var = fmaxf(ss * (1.f / CW) - mu * mu, 0.f);
            stat[2 * tid] = mu; stat[2 * tid + 1] = rsqrtf(var + EPS);
        }
        __syncthreads();
#pragma unroll
        for (int t = 0; t < TCH; ++t) {
            const float mu = stat[2 * t], rs = stat[2 * t + 1];
            const float v0 = (y0[t] - mu) * rs * lg.x + lb.x, v1 = (y1[t] - mu) * rs * lg.y + lb.y;
            *((unsigned*)(Y + (size_t)(t0 + t) * D + AW) + tid) = pk2(v0 * __builtin_amdgcn_rcpf(1.f + __expf(-v0)), v1 * __builtin_amdgcn_rcpf(1.f + __expf(-v1)));
        }
    }
}
}
#ifndef PROBE_ID
#define PROBE_ID (-1)
#endif
#ifndef PROBE_K
#define PROBE_K 8
#endif
#define TICK(k) do { if (PROBE_ID >= 0) { const unsigned long long now_ = __builtin_amdgcn_s_memrealtime(); if (PROBE_ID == (k)) tsel_ = now_ - tprev_; tprev_ = now_; } } while (0)
#define TOCK() do { if (PROBE_ID >= 0) tprev_ = __builtin_amdgcn_s_memrealtime(); } while (0)
#ifndef REP_P0A
#define REP_P0A 1
#endif
#ifndef REP_P0B
#define REP_P0B 1
#endif
#ifndef REP_P1
#define REP_P1 1
#endif
#ifndef REP_CONV
#define REP_CONV 1
#endif
#ifndef REP_ATT
#define REP_ATT 1
#endif
#ifndef REP_P3
#define REP_P3 1
#endif
#ifndef REP_P3B
#define REP_P3B 1
#endif
#ifndef REP_P4
#define REP_P4 1
#endif
#ifndef REP_P5
#define REP_P5 1
#endif
#ifndef REP_P6
#define REP_P6 1
#endif
#ifndef REP_BAR
#define REP_BAR 1
#endif
#define REPEAT(n) _Pragma("unroll 1") for (int rep_ = 0; rep_ < (n); ++rep_)
__global__ void __launch_bounds__(NTHR, 2) mega_fwd(Args args) {
    extern __shared__ __attribute__((aligned(16))) unsigned char lds_raw[];
    LAS unsigned char* lds = (LAS unsigned char*)lds_raw;
    int tid = threadIdx.x, lane = tid & 63, wave = __builtin_amdgcn_readfirstlane(tid >> 6);
    const int G = gridDim.x; const int bx = blockIdx.x; const int vcu = (G % 8 == 0) ? (bx % 8) * (G / 8) + bx / 8 : bx;
    for (int u = tid; u < (LDS_BYTES - LDSCTL_OFF) / 4; u += NTHR) ((LAS unsigned*)(lds + LDSCTL_OFF))[u] = 0u;
    __syncthreads();
    gu32* ctl = (gu32*)(args.ws + WS_CTL);
    XcdBarrier bar = xcd_barrier_post((unsigned*)(ctl + CW_BAR), (volatile LAS unsigned*)(lds + MISC_OFF) + 8);

    unsigned long long tprev_ = 0, tsel_ = 0;
#define RETID() do { int t_ = threadIdx.x; asm volatile("" : "+v"(t_)); tid = t_; lane = tid & 63; wave = __builtin_amdgcn_readfirstlane(tid >> 6); } while (0)
    TOCK(); REPEAT(REP_P0A) { RETID(); phase_p0a(args, lds, vcu, G, tid, wave, lane); }
    TICK(0);
    REPEAT(REP_BAR) xcd_barrier(bar);
    TICK(10);
    TOCK(); REPEAT(REP_P0B) { RETID(); phase_p0b(args, lds, vcu, G, tid, wave, lane); }
    TICK(1);
    xcd_barrier(bar);
    TICK(11);
    TOCK(); REPEAT(REP_P1) {
        pg8::Gemm g{(const pg8::bf16_t*)(args.ws + WS_XN), (const pg8::bf16_t*)(args.ws + WS_WIN), S, INC, D};
        pg8::StaticOrder So; So.init(S, INC, G, bx);
        pg8::EpiBf16<0> E{(pg8::bf16_t*)(args.ws + WS_PROJ), INC, nullptr, AW, (size_t)AW, C2};
        pg8::gemm_phase<pg8::EpiBf16<0>, pg8::StaticOrder, true, true>(lds + RING_OFF, g, So, E);
    }
    TICK(2);
    xcd_barrier(bar);
    TICK(12);
    TOCK(); REPEAT(REP_CONV) { RETID(); conv::phase_conv(args, lds, vcu, G, tid, wave, lane); }
    TICK(3);
    TOCK(); REPEAT(REP_ATT) { RETID(); att::attn_phase(args, lds, vcu, G, lane); }
    TICK(4);
    xcd_barrier(bar);
    TICK(13);
    TOCK(); REPEAT(REP_P3) {
        pg8::Gemm g{(const pg8::bf16_t*)(args.ws + WS_Y), (const pg8::bf16_t*)(args.ws + WS_WOUT), S, D, D};
        pg8::StaticOrder So; So.init(S, D, G, bx);
        pg8::EpiBf16<0> E{(pg8::bf16_t*)(args.ws + WS_MIX), D, nullptr, 0, 0, 1.f};
        pg8::gemm_phase<pg8::EpiBf16<0>, pg8::StaticOrder, true, true>(lds + RING_OFF, g, So, E);
    }
    TICK(5);
    xcd_barrier(bar);
    TICK(14);
    TOCK(); REPEAT(REP_P3B) { RETID(); phase_p3b(args, lds, vcu, G, tid, wave, lane); }
    TICK(6);
    xcd_barrier(bar);
    TICK(15);
    TOCK(); REPEAT(REP_P4) {
        pg8::Gemm g{(const pg8::bf16_t*)(args.ws + WS_XN), (const pg8::bf16_t*)(args.ws + WS_WQ), S, D, D};
        pg8::StaticOrder So; So.init(S, D, G, bx);
        pg8::EpiBf16<0> E{(pg8::bf16_t*)(args.ws + WS_QP), D, nullptr, 0, 0, 1.f};
        pg8::gemm_phase<pg8::EpiBf16<0>, pg8::StaticOrder, true, true>(lds + RING_OFF, g, So, E);
    }
    TICK(7);
    xcd_barrier(bar);
    TICK(16);
    TOCK(); REPEAT(REP_P5) { RETID(); topk::phase_topk(args, lds, vcu, G, tid, wave, lane); }
    TICK(8);
    xcd_barrier(bar);
    TICK(17);
    TOCK(); REPEAT(REP_P6) { RETID(); peer4::phase_peer(args, lds, vcu, G, tid, wave, lane, bar.x, (rep_ + 1 < REP_P6) ? (float*)(args.ws + WS_MIX) : args.out); }
    TICK(9);
    if (PROBE_ID >= 0 && blockIdx.x == 0) { const unsigned long long t0_ = __builtin_amdgcn_s_memrealtime(); while (__builtin_amdgcn_s_memrealtime() - t0_ < tsel_ * PROBE_K) __builtin_amdgcn_s_sleep(8); }
}

extern "C" void kernel_launch(void* const* d_in, const int* in_sizes, int n_in, void* d_out, int out_size, void* d_ws, size_t ws_size, hipStream_t stream) {
    static int grid = 0;
    if (grid == 0) {
        if (n_in != 24 || out_size != S * D || ws_size < WS_END) { fprintf(stderr, "kernel_launch: unexpected problem shape (n_in %d, out %d, ws %zu)\n", n_in, out_size, ws_size); grid = -1; return; }
        int dev = 0, cus = 0;
        if (hipGetDevice(&dev) != hipSuccess || hipDeviceGetAttribute(&cus, hipDeviceAttributeMultiprocessorCount, dev) != hipSuccess) { grid = -1; return; }
        if (hipFuncSetAttribute((const void*)mega_fwd, hipFuncAttributeMaxDynamicSharedMemorySize, LDS_BYTES) != hipSuccess) { fprintf(stderr, "kernel_launch: hipFuncSetAttribute failed\n"); grid = -1; return; }
        int per_cu = 0;
        if (hipOccupancyMaxActiveBlocksPerMultiprocessor(&per_cu, (const void*)mega_fwd, NTHR, LDS_BYTES) != hipSuccess || per_cu < 1) fprintf(stderr, "kernel_launch: occupancy query reports %d\n", per_cu);
        (void)hipGetLastError();
        grid = cus;
    }
    if (grid < 0) return;
    if (hipMemsetAsync((char*)d_ws + WS_CTL, 0, CTL_ZERO_BYTES, stream) != hipSuccess) return;
    Args a{};
    for (int i = 0; i < 24; ++i) a.in[i] = (const float*)d_in[i];
    a.out = (float*)d_out; a.ws = (unsigned char*)d_ws;
    hipLaunchKernelGGL(mega_fwd, dim3(grid), dim3(NTHR), LDS_BYTES, stream, a);
}
```

```cpp
#include <hip/hip_runtime.h>
#include <cstdio>
#include <cstdint>
#include <cmath>
namespace pg8 {
#define PG8_LAS __attribute__((address_space(3)))
typedef unsigned short bf16_t;
typedef short bf16x8 __attribute__((ext_vector_type(8)));
typedef float f32x4 __attribute__((ext_vector_type(4)));
typedef unsigned u32x4 __attribute__((ext_vector_type(4)));
constexpr int BM = 256, BK = 64, HALF = 128, HTB = HALF * BK * 2  , STAGE_BYTES = 8 * HTB, NXCD = 8, WGM = 8;

__host__ __device__ __forceinline__ int lds_byte(int r, int c) { const int st = (r >> 4) * 2 + (c >> 5), rr = r & 15, cc = c & 31, ob = rr * 64 + cc * 2; return st * 1024 + (ob ^ (((ob >> 9) & 1) << 5)); }
__host__ __device__ __forceinline__ void stage_rc(int b, int& R, int& C) { const int st = b / 1024, sb = b % 1024, swz = sb ^ (((sb >> 9) & 1) << 5); R = (st >> 1) * 16 + swz / 64; C = (st & 1) * 32 + (swz % 64) / 2; }
__host__ __device__ __forceinline__ int perm32(int rho) { const int n = rho >> 4, i = rho & 15; return 8 * (i >> 2) + 4 * n + (i & 3); }

struct Unit { int pm, pn; };
struct Gemm { const bf16_t* A; const bf16_t* Bt; int M, N, K; };

struct StaticOrder {
    int nM, nN, nwg, G, c;
    __host__ __device__ void init(int M, int N, int G_, int c_) { nM = M / BM; nN = N / BM; nwg = nM * nN; G = G_; c = c_; }
    __host__ __device__ bool next(int i, Unit& u) const {
        const long L = (long)i * G + c; if (L >= nwg) return false;
        int wgid = (int)L; { const int q = nwg / NXCD, r = nwg % NXCD, xcd = wgid % NXCD, off = wgid / NXCD; wgid = (xcd < r ? xcd * (q + 1) : r * (q + 1) + (xcd - r) * q) + off; }
        const int nig = WGM * nN, gid = wgid / nig, fm = gid * WGM, gsz = (nM - fm) < WGM ? (nM - fm) : WGM;
        u.pm = fm + ((wgid % nig) % gsz); u.pn = (wgid % nig) / gsz; return true;
    }
    __device__ __forceinline__ void a_ready(const Unit&) const {}
    __device__ __forceinline__ void done(const Unit&) const {}
};

__device__ __forceinline__ unsigned cvt_pk_bf16(float lo, float hi) { unsigned r; asm volatile("v_cvt_pk_bf16_f32 %0, %1, %2" : "=v"(r) : "v"(lo), "v"(hi)); return r; }
typedef float f32x2 __attribute__((ext_vector_type(2)));
__device__ __forceinline__ f32x2 gelu_pk(f32x2 v) {
    const f32x2 av = __builtin_elementwise_abs(v), d = av * 0.2316418882f + 1.0f;
    f32x2 t; t.x = __builtin_amdgcn_rcpf(d.x); t.y = __builtin_amdgcn_rcpf(d.y);
    f32x2 q = t * 0.5307027145f + (-0.7265760135f); q = q * t + 0.7107068705f; q = q * t + (-0.142248368f); q = q * t + 0.127414796f; q = q * t;
    const f32x2 s = (v * v) * (-0.72134752044f);
    f32x2 e; e.x = __builtin_amdgcn_exp2f(s.x); e.y = __builtin_amdgcn_exp2f(s.y);
    const f32x2 m = v * (q * e), r = v - m;
    f32x2 o; o.x = v.x < 0.f ? m.x : r.x; o.y = v.y < 0.f ? m.y : r.y; return o;
}

template <int ACT  > struct EpiBf16 {
    static constexpr bool PERM = true, AFTER_DRAIN = false; static_assert(ACT == 0 || ACT == 1, "EpiBf16: ACT is 0 (none) or 1 (gelu_pk)");
    bf16_t* O; int ldc; const float* bias; int split_cols; size_t split_stride; float scale0;
    __device__ __forceinline__ void operator()(const f32x4 (&acc)[2][2][4][2], const Unit& u, int wr, int wc, int fr, int fq) const {
        const int row0 = u.pm * BM + wr * 64 + fr; int colt = u.pn * BM; bf16_t* base = O;
        float sc = 1.f; if (split_cols) { const int t = colt / split_cols; base += (size_t)t * split_stride; colt -= t * split_cols; if (t == 0) sc = scale0; }
        const int col0 = colt + wc * 32 + 8 * fq, bcol0 = u.pn * BM + wc * 32 + 8 * fq;
        f32x4 bv[2][2];
#pragma unroll
        for (int bj = 0; bj < 2; ++bj)
#pragma unroll
            for (int n = 0; n < 2; ++n) bv[bj][n] = bias ? *(const f32x4*)(bias + bcol0 + bj * HALF + 4 * n) : (f32x4){0.f, 0.f, 0.f, 0.f};
#pragma unroll
        for (int ai = 0; ai < 2; ++ai)
#pragma unroll
            for (int m = 0; m < 4; ++m) { bf16_t* rowp = base + (size_t)(row0 + ai * HALF + m * 16) * ldc + col0;
#pragma unroll
                for (int bj = 0; bj < 2; ++bj) { f32x4 v0 = acc[ai][bj][m][0] + bv[bj][0], v1 = acc[ai][bj][m][1] + bv[bj][1];
                    if (ACT == 1) { f32x2 a = gelu_pk((f32x2){v0[0], v0[1]}), b = gelu_pk((f32x2){v0[2], v0[3]}), c = gelu_pk((f32x2){v1[0], v1[1]}), d = gelu_pk((f32x2){v1[2], v1[3]});
                        v0 = (f32x4){a.x, a.y, b.x, b.y}; v1 = (f32x4){c.x, c.y, d.x, d.y}; }
                    v0 = v0 * sc; v1 = v1 * sc; u32x4 w; w.x = cvt_pk_bf16(v0[0], v0[1]); w.y = cvt_pk_bf16(v0[2], v0[3]); w.z = cvt_pk_bf16(v1[0], v1[1]); w.w = cvt_pk_bf16(v1[2], v1[3]);
                    *(u32x4*)(rowp + bj * HALF) = w; } }
    }
};
template <class Epi, class Sched, bool ALIGN_EPI = false, bool SP2 = false>
__device__ __forceinline__ void gemm_phase(PG8_LAS unsigned char* lds, const Gemm g, const Sched& S, const Epi& E) {
    int tid_ = threadIdx.x; asm volatile("" : "+v"(tid_)); const int tid = tid_, wid = __builtin_amdgcn_readfirstlane(tid >> 6), lane = tid & 63, wr = wid >> 2, wc = wid & 3, fr = lane & 15, fq = lane >> 4;
    const int K = g.K, nt = K / BK;
    unsigned voffA[2], voffB[2];
#pragma unroll
    for (int i = 0; i < 2; ++i) { int R, C; stage_rc(tid * 16 + i * 8192, R, C); const int Rb = Epi::PERM ? ((R & ~31) + perm32(R & 31)) : R;
        voffA[i] = (unsigned)(R * K + C) * 2u; voffB[i] = (unsigned)(Rb * K + C) * 2u; }
    const size_t kstep = (size_t)(BK * 2);
    const size_t hstep = (size_t)HALF * K * 2;
    const size_t tstep = 2 * hstep;
    const unsigned ldsw = (unsigned)wid * 1024u;
    const int aoff = lds_byte(wr * 64 + fr, fq * 8), boff = lds_byte(wc * 32 + fr, fq * 8);
#define PG8_SA(b, h) (((b) * 2 + (h)) * HTB)
#define PG8_SB(b, h) ((4 + (b) * 2 + (h)) * HTB)
#define PG8_STAGE(bufoff, gbase, voff) do { _Pragma("unroll") for (int _i = 0; _i < 2; ++_i) \
        __builtin_amdgcn_global_load_lds((const unsigned*)((const char*)(gbase) + (voff)[_i]), (PG8_LAS unsigned*)(lds + (bufoff) + ldsw + _i * 8192), 16, 0, 0); } while (0)
#define PG8_LDA(dst, b, h) do { _Pragma("unroll") for (int m = 0; m < 4; ++m) _Pragma("unroll") for (int k = 0; k < 2; ++k) dst[m][k] = *(const PG8_LAS bf16x8*)(lds + PG8_SA(b, h) + aoff + m * 2048 + k * 1024); } while (0)
#define PG8_LDB(dst, b, h) do { _Pragma("unroll") for (int n = 0; n < 2; ++n) _Pragma("unroll") for (int k = 0; k < 2; ++k) dst[n][k] = *(const PG8_LAS bf16x8*)(lds + PG8_SB(b, h) + boff + n * 2048 + k * 1024); } while (0)
#define PG8_MMA(ai, bj, At, Bt) do { __builtin_amdgcn_s_setprio(1); _Pragma("unroll") for (int m = 0; m < 4; ++m) _Pragma("unroll") for (int n = 0; n < 2; ++n) _Pragma("unroll") for (int k = 0; k < 2; ++k) \
        acc[ai][bj][m][n] = __builtin_amdgcn_mfma_f32_16x16x32_bf16(Bt[n][k], At[m][k], acc[ai][bj][m][n], 0, 0, 0); __builtin_amdgcn_s_setprio(0); } while (0)
#define PG8_WAIT_V(n) asm volatile("s_waitcnt vmcnt(" #n ")" ::: "memory")
#define PG8_WAIT_L(n) asm volatile("s_waitcnt lgkmcnt(" #n ")" ::: "memory")
#define PG8_BAR __builtin_amdgcn_s_barrier()
#define PG8_SCHED __builtin_amdgcn_sched_barrier(0)
    Unit cur, nxt; int ui = 0;
    if (!S.next(0, cur)) return;
    f32x4 acc[2][2][4][2];
#pragma unroll
    for (int a = 0; a < 2; ++a)
#pragma unroll
        for (int b = 0; b < 2; ++b)
#pragma unroll
            for (int m = 0; m < 4; ++m)
#pragma unroll
                for (int n = 0; n < 2; ++n) acc[a][b][m][n] = (f32x4){0.f, 0.f, 0.f, 0.f};
    bf16x8 At[4][2], B0[2][2], B1[2][2];
    const char* cA = (const char*)g.A + (size_t)cur.pm * tstep; const char* cB = (const char*)g.Bt + (size_t)cur.pn * tstep;
    S.a_ready(cur);
    if constexpr (SP2) {
        PG8_STAGE(PG8_SB(0, 0), cB, voffB); PG8_STAGE(PG8_SB(0, 1), cB + hstep, voffB); PG8_STAGE(PG8_SA(0, 0), cA, voffA); PG8_STAGE(PG8_SA(0, 1), cA + hstep, voffA);
        if (wr == 1) PG8_BAR;
        PG8_WAIT_V(2); PG8_BAR;
        PG8_STAGE(PG8_SB(1, 0), cB + kstep, voffB); PG8_STAGE(PG8_SA(1, 0), cA + kstep, voffA); PG8_STAGE(PG8_SB(1, 1), cB + hstep + kstep, voffB);
        PG8_WAIT_V(6); PG8_BAR;
    } else {
        PG8_STAGE(PG8_SB(0, 0), cB, voffB); PG8_STAGE(PG8_SA(0, 0), cA, voffA); PG8_STAGE(PG8_SB(0, 1), cB + hstep, voffB); PG8_STAGE(PG8_SA(0, 1), cA + hstep, voffA);
        if (wr == 1) PG8_BAR;
        PG8_WAIT_V(4); PG8_BAR;
        PG8_STAGE(PG8_SB(1, 0), cB + kstep, voffB); PG8_STAGE(PG8_SA(1, 0), cA + kstep, voffA); PG8_STAGE(PG8_SB(1, 1), cB + hstep + kstep, voffB);
        PG8_WAIT_V(6); PG8_BAR;
    }
    for (;;) {
        const bool has_next = S.next(ui + 1, nxt);
        const char* nA = has_next ? (const char*)g.A + (size_t)nxt.pm * tstep : cA; const char* nB = has_next ? (const char*)g.Bt + (size_t)nxt.pn * tstep : cB;
        for (int t = 0; t < nt; t += 2) {
            const bool last = (t == nt - 2);
            const char* a1 = cA + (size_t)(t + 1) * kstep;
            const char* a2 = last ? nA : cA + (size_t)(t + 2) * kstep; const char* b2 = last ? nB : cB + (size_t)(t + 2) * kstep;
            const char* a3 = a2 + kstep; const char* b3 = b2 + kstep;
            if (last && has_next) S.a_ready(nxt);
            if constexpr (SP2) {
            PG8_LDB(B0, 0, 0); PG8_LDB(B1, 0, 1); PG8_SCHED; PG8_LDA(At, 0, 0); PG8_STAGE(PG8_SA(1, 1), a1 + hstep, voffA);
            PG8_WAIT_V(8); PG8_WAIT_L(0); PG8_BAR; PG8_MMA(0, 0, At, B0); PG8_MMA(0, 1, At, B1); PG8_BAR; PG8_SCHED;
            PG8_LDA(At, 0, 1); PG8_STAGE(PG8_SB(0, 0), b2, voffB); PG8_STAGE(PG8_SB(0, 1), b2 + hstep, voffB); PG8_STAGE(PG8_SA(0, 0), a2, voffA);
            PG8_WAIT_V(8); PG8_WAIT_L(0); PG8_BAR; PG8_MMA(1, 0, At, B0); PG8_MMA(1, 1, At, B1); PG8_BAR; PG8_SCHED;
            PG8_LDB(B0, 1, 0); PG8_LDB(B1, 1, 1); PG8_SCHED; PG8_LDA(At, 1, 0); PG8_STAGE(PG8_SA(0, 1), a2 + hstep, voffA);
            PG8_WAIT_V(8); PG8_WAIT_L(0); PG8_BAR; PG8_MMA(0, 0, At, B0); PG8_MMA(0, 1, At, B1); PG8_BAR; PG8_SCHED;
            PG8_LDA(At, 1, 1); PG8_STAGE(PG8_SB(1, 0), b3, voffB); PG8_STAGE(PG8_SB(1, 1), b3 + hstep, voffB); PG8_STAGE(PG8_SA(1, 0), a3, voffA);
            PG8_WAIT_V(8); PG8_WAIT_L(0); PG8_BAR; PG8_MMA(1, 0, At, B0); PG8_MMA(1, 1, At, B1); PG8_BAR; PG8_SCHED;
            } else {
            PG8_LDB(B0, 0, 0); PG8_SCHED; PG8_LDA(At, 0, 0); PG8_STAGE(PG8_SA(1, 1), a1 + hstep, voffA);
            PG8_WAIT_L(8); PG8_BAR; PG8_WAIT_L(0); PG8_MMA(0, 0, At, B0); PG8_BAR; PG8_SCHED;
            PG8_LDB(B1, 0, 1); PG8_STAGE(PG8_SB(0, 0), b2, voffB);
            PG8_BAR; PG8_WAIT_L(0); PG8_MMA(0, 1, At, B1); PG8_BAR;
            PG8_LDA(At, 0, 1); PG8_STAGE(PG8_SA(0, 0), a2, voffA);
            PG8_BAR; PG8_WAIT_L(0); PG8_MMA(1, 0, At, B0); PG8_BAR; PG8_SCHED;
            PG8_STAGE(PG8_SB(0, 1), b2 + hstep, voffB);
            PG8_WAIT_V(6); PG8_BAR; PG8_MMA(1, 1, At, B1); PG8_BAR;
            PG8_LDB(B0, 1, 0); PG8_SCHED; PG8_LDA(At, 1, 0); PG8_STAGE(PG8_SA(0, 1), a2 + hstep, voffA);
            PG8_WAIT_L(8); PG8_BAR; PG8_WAIT_L(0); PG8_MMA(0, 0, At, B0); PG8_BAR; PG8_SCHED;
            PG8_LDB(B1, 1, 1); PG8_STAGE(PG8_SB(1, 0), b3, voffB);
            PG8_BAR; PG8_WAIT_L(0); PG8_MMA(0, 1, At, B1); PG8_BAR;
            PG8_LDA(At, 1, 1); PG8_STAGE(PG8_SA(1, 0), a3, voffA);
            PG8_BAR; PG8_WAIT_L(0); PG8_MMA(1, 0, At, B0); PG8_BAR; PG8_SCHED;
            PG8_STAGE(PG8_SB(1, 1), b3 + hstep, voffB);
            PG8_WAIT_V(6); PG8_BAR; PG8_MMA(1, 1, At, B1); PG8_BAR;
            }
        }
        if constexpr (ALIGN_EPI) { if (wr == 0) PG8_BAR; }
        if constexpr (!Epi::AFTER_DRAIN) { E(acc, cur, wr, wc, fr, fq); S.done(cur); }
        if (!has_next) break;
#pragma unroll
        for (int a = 0; a < 2; ++a)
#pragma unroll
            for (int b = 0; b < 2; ++b)
#pragma unroll
                for (int m = 0; m < 4; ++m)
#pragma unroll
                    for (int n = 0; n < 2; ++n) acc[a][b][m][n] = (f32x4){0.f, 0.f, 0.f, 0.f};
        cur = nxt; cA = nA; cB = nB; ++ui;
        if constexpr (ALIGN_EPI) { if (wr == 1) PG8_BAR; }
    }
    PG8_WAIT_V(0);
    if constexpr (!ALIGN_EPI) { if (wr == 0) PG8_BAR; }
    PG8_BAR;
    if constexpr (Epi::AFTER_DRAIN) { E.fused(acc, cur, wr, wc, fr, fq, lds, wid, lane); S.done(cur); }
#undef PG8_SA
#undef PG8_SB
#undef PG8_STAGE
#undef PG8_LDA
#undef PG8_LDB
#undef PG8_MMA
#undef PG8_WAIT_V
#undef PG8_WAIT_L
#undef PG8_BAR
#undef PG8_SCHED
}
}
#define GAS __attribute__((address_space(1)))
#define LAS __attribute__((address_space(3)))
typedef unsigned short bf16;
typedef unsigned v4u __attribute__((ext_vector_type(4)));
typedef float f32x4 __attribute__((ext_vector_type(4)));
typedef short bf16x8 __attribute__((ext_vector_type(8)));
typedef GAS unsigned gu32;
typedef GAS unsigned long long gu64;
#define RLX_AGENT __ATOMIC_RELAXED, __HIP_MEMORY_SCOPE_AGENT
#define LDS_WAIT() asm volatile("s_waitcnt lgkmcnt(0)" ::: "memory")
#define VM_WAIT() asm volatile("s_waitcnt vmcnt(0)" ::: "memory")
__device__ __forceinline__ unsigned long long rt() { return __builtin_amdgcn_s_memrealtime(); }
__device__ __forceinline__ unsigned f2bf(float f) { unsigned u = __builtin_bit_cast(unsigned, f); return (u + 0x7fffu + ((u >> 16) & 1u)) >> 16; }
__device__ __forceinline__ unsigned pk2(float lo, float hi) { return f2bf(lo) | (f2bf(hi) << 16); }

#define XB_TMO      128
#define XB_XCNT(j)  (256  + 64 * (j))
#define XB_XSUB(j)  (1280 + 64 * (j))
#define XB_XGEN(j)  (2304 + 64 * (j))
#define XB_TOP      3328
#define XB_TOPGEN   3392
#define XCD_BAR_WORDS 3456
#define XB_SPIN_CAP (1u << 18)

__device__ __forceinline__ unsigned xb_ld(unsigned* p)              { return __hip_atomic_load(p, __ATOMIC_RELAXED, __HIP_MEMORY_SCOPE_AGENT); }
__device__ __forceinline__ unsigned xb_add(unsigned* p, unsigned v) { return __hip_atomic_fetch_add(p, v, __ATOMIC_RELAXED, __HIP_MEMORY_SCOPE_AGENT); }
__device__ __forceinline__ unsigned xb_xcc_id() { return (unsigned)__builtin_amdgcn_s_getreg((3 << 11) | 20) & 0xFu; }
#define XB_SPIN(cond, bar) do { unsigned _sp = 0; while (cond) { __builtin_amdgcn_s_sleep(1); \
    if ((++_sp & 255u) == 0u) { if (xb_ld(&(bar)[XB_TMO])) break; if (_sp > XB_SPIN_CAP) { atomicAdd(&(bar)[XB_TMO], 1u); break; } } } } while (0)

struct XcdBarrier {
    unsigned* bar; unsigned x;
    volatile LAS unsigned* st;
};

__device__ __forceinline__ XcdBarrier xcd_barrier_post(unsigned* bar, volatile LAS unsigned* st) {
    XcdBarrier b; b.bar = bar; b.x = xb_xcc_id(); b.st = st;
    if (threadIdx.x == 0) (void)xb_add(&bar[XB_XCNT(b.x)], 1u);
    return b;
}
__device__ __forceinline__ void xcd_barrier_complete(unsigned* bar, unsigned x, unsigned& nloc, unsigned& nx) {
    const unsigned G = gridDim.x * gridDim.y * gridDim.z;
    unsigned sum, cnt, mine, sp = 0u;
    for (;;) {
        sum = 0u; cnt = 0u; mine = 0u;
#pragma unroll
        for (unsigned j = 0; j < 16; ++j) { const unsigned c = xb_ld(&bar[XB_XCNT(j)]); sum += c; cnt += (c > 0u) ? 1u : 0u; mine = (j == x) ? c : mine; }
        if (sum == G) break;
        __builtin_amdgcn_s_sleep(1);
        if ((++sp & 255u) == 0u) { if (xb_ld(&bar[XB_TMO])) break; if (sp > XB_SPIN_CAP) { atomicAdd(&bar[XB_TMO], 1u); break; } }
    }
    nloc = mine > 0u ? mine : 1u; nx = cnt > 0u ? cnt : 1u;
}

__device__ __forceinline__ void xcd_barrier(const XcdBarrier& b) {
    asm volatile("s_waitcnt vmcnt(0)" ::: "memory");
    __syncthreads();
    if (threadIdx.x == 0) {
        unsigned* bar = b.bar;
        __builtin_amdgcn_s_waitcnt(0);
        unsigned nloc = b.st[0], nx = b.st[1];
        if (nloc == 0u) { xcd_barrier_complete(bar, b.x, nloc, nx); b.st[0] = nloc; b.st[1] = nx; }
        const unsigned old = xb_add(&bar[XB_XSUB(b.x)], 1u);
        const unsigned gen = old / nloc;
        if (old + 1u == (gen + 1u) * nloc) {
            __builtin_amdgcn_fence(__ATOMIC_RELEASE, "agent");
            asm volatile("s_waitcnt vmcnt(0)" ::: "memory");
            const unsigned og = xb_add(&bar[XB_TOP], 1u);
            const unsigned tg = og / nx;
            if (og + 1u == (tg + 1u) * nx) xb_add(&bar[XB_TOPGEN], 1u);
            else XB_SPIN(xb_ld(&bar[XB_TOPGEN]) == tg, bar);
            __builtin_amdgcn_fence(__ATOMIC_ACQUIRE, "agent");
            xb_add(&bar[XB_XGEN(b.x)], 1u);
            asm volatile("s_waitcnt vmcnt(0)" ::: "memory");
        } else {
            XB_SPIN(xb_ld(&bar[XB_XGEN(b.x)]) == gen, bar);
            __builtin_amdgcn_fence(__ATOMIC_ACQUIRE, "agent");
            asm volatile("s_waitcnt vmcnt(0)" ::: "memory");
        }
    }
    __syncthreads();
}

constexpr int NWAVES = 8, NTHR = 512;
constexpr int D = 2048, S = 8192, AW = 1024, CW = 1024, INC = 5120, NH = 8, DH = 64, CK = 31;
constexpr int PH = 8, PKEYS = 128, PTOP = 16, PKD = 256, NEXP = 16384;
constexpr float EPS = 1e-6f, LAMBDA_INIT = 0.2f;
constexpr float LOG2E = 1.4426950408889634f;
constexpr float C2 = 0.125f * LOG2E;

constexpr size_t MiB = 1u << 20;
constexpr size_t WS_CTL = 0, CTL_ZERO_BYTES = 1 * MiB;
constexpr size_t WS_MOD = 1 * MiB;
constexpr size_t WS_MODP = 2 * MiB;
constexpr size_t WS_IDX = 5 * MiB, WS_GATE = 9 * MiB;
constexpr size_t WS_WIN = 16 * MiB, WS_WOUT = 36 * MiB, WS_WQ = 44 * MiB;
constexpr size_t WS_UB = 52 * MiB, WS_VB = 116 * MiB;
constexpr size_t WS_XN = 180 * MiB;
constexpr size_t WS_PROJ = 212 * MiB;
constexpr size_t WS_MIX = 212 * MiB;
constexpr size_t WS_Y = 292 * MiB;
constexpr size_t WS_QP = 292 * MiB;
constexpr size_t WS_X1 = 324 * MiB;
constexpr size_t WS_END = 388 * MiB;
constexpr int CW_BAR = 4096, CW_PEERQ = 8192;

constexpr int RING_OFF = 0, RING_BYTES = 131072;
constexpr int LDSCTL_OFF = RING_BYTES, MISC_OFF = LDSCTL_OFF + 320, XTRA_OFF = LDSCTL_OFF + 512;
constexpr int LDS_BYTES = 147456;

__device__ __forceinline__ float bf2f(unsigned short b) { return __uint_as_float((unsigned)b << 16); }
__device__ __forceinline__ float bflo(unsigned u) { return __uint_as_float(u << 16); }
__device__ __forceinline__ float bfhi(unsigned u) { return __uint_as_float(u & 0xffff0000u); }
template <int X> __device__ __forceinline__ float swz_xor(float v) { return __int_as_float(__builtin_amdgcn_ds_swizzle(__float_as_int(v), (X << 10) | 0x1f)); }
template <int X> __device__ __forceinline__ int swz_xor_i(int v) { return __builtin_amdgcn_ds_swizzle(v, (X << 10) | 0x1f); }
__device__ __forceinline__ float xor32_f(float v) { auto rr = __builtin_amdgcn_permlane32_swap(__float_as_uint(v), __float_as_uint(v), false, false); return __uint_as_float((threadIdx.x & 32) ? rr[0] : rr[1]); }
__device__ __forceinline__ int xor32_i(int v) { auto rr = __builtin_amdgcn_permlane32_swap((unsigned)v, (unsigned)v, false, false); return (int)((threadIdx.x & 32) ? rr[0] : rr[1]); }
__device__ __forceinline__ float wave_sum(float v) {
    v += swz_xor<1>(v); v += swz_xor<2>(v); v += swz_xor<4>(v); v += swz_xor<8>(v); v += swz_xor<16>(v);
    auto rr = __builtin_amdgcn_permlane32_swap(__float_as_uint(v), __float_as_uint(v), false, false); return __uint_as_float(rr[0]) + __uint_as_float(rr[1]);
}
__device__ __forceinline__ float wave_max(float v) {
    v = fmaxf(v, swz_xor<1>(v)); v = fmaxf(v, swz_xor<2>(v)); v = fmaxf(v, swz_xor<4>(v)); v = fmaxf(v, swz_xor<8>(v)); v = fmaxf(v, swz_xor<16>(v));
    auto rr = __builtin_amdgcn_permlane32_swap(__float_as_uint(v), __float_as_uint(v), false, false); return fmaxf(__uint_as_float(rr[0]), __uint_as_float(rr[1]));
}
__device__ __forceinline__ float silu_f(float v) { return v / (1.f + __expf(-v)); }

struct Args { const float* in[24]; float* out; unsigned char* ws; };

__device__ __forceinline__ void p0_transpose_item(const float* W, int K, int N, bf16* WT, int row_off, LAS float* scr, int item, int lane) {
    const int nblk = N / 32, kb = item / nblk, nb = item % nblk, k0 = 64 * kb, n0 = 32 * nb;
#pragma unroll 8
    for (int i = 0; i < 32; ++i) { const int kk = 2 * i + (lane >> 5); scr[kk * 33 + (lane & 31)] = W[(size_t)(k0 + kk) * N + n0 + (lane & 31)]; }
    LDS_WAIT(); asm volatile("" ::: "memory");
    const int c = lane & 7;
#pragma unroll
    for (int j = 0; j < 4; ++j) { const int n = (lane >> 3) + 8 * j; const LAS float* s = scr + (8 * c) * 33 + n;
        v4u o; o.x = pk2(s[0 * 33], s[1 * 33]); o.y = pk2(s[2 * 33], s[3 * 33]); o.z = pk2(s[4 * 33], s[5 * 33]); o.w = pk2(s[6 * 33], s[7 * 33]);
        *(GAS v4u*)(WT + (size_t)(row_off + n0 + n) * K + k0 + 8 * c) = o; }
    LDS_WAIT(); asm volatile("" ::: "memory");
}
__device__ __forceinline__ void p0_mod_block(const float* c, const float* w_ada, const float* b_ada, float* mod, LAS float* red, int cb, int tid, int wave, int lane) {
    const int slot = lane / 12, q = lane % 12;
    f32x4 acc = (f32x4){0.f, 0.f, 0.f, 0.f};
    if (slot < 5) {
        const float* wp = w_ada + (size_t)(wave * 256) * (6 * D) + cb * 48 + q * 4;
#pragma unroll 4
        for (int i = 0; i < 52; ++i) { const int r = i * 5 + slot;
            if (r < 256) { const float s = silu_f(c[wave * 256 + r]); const f32x4 w = *(const f32x4*)(wp + (size_t)r * (6 * D)); acc += w * s; } }
        *(LAS f32x4*)(red + (wave * 5 + slot) * 48 + q * 4) = acc;
    }
    __syncthreads();
    if (tid < 48) { float s = b_ada[cb * 48 + tid];
#pragma unroll 8
        for (int p = 0; p < 40; ++p) s += red[p * 48 + tid];
        mod[cb * 48 + tid] = s; }
    __syncthreads();
}
__device__ __forceinline__ void p0_cvt_row_fp6(const float* src, unsigned char* dst, float scale, int lane) {
    typedef float f32x16v __attribute__((ext_vector_type(16))); typedef unsigned u32x6 __attribute__((ext_vector_type(6))); typedef unsigned u32x2 __attribute__((ext_vector_type(2)));
    f32x4 v[8];
#pragma unroll
    for (int j = 0; j < 4; ++j) { v[j] = *(const f32x4*)(src + lane * 16 + 4 * j); v[4 + j] = *(const f32x4*)(src + 1024 + lane * 16 + 4 * j); }
    f32x16v a, b;
#pragma unroll
    for (int j = 0; j < 4; ++j) { a[4 * j] = v[j].x * scale; a[4 * j + 1] = v[j].y * scale; a[4 * j + 2] = v[j].z * scale; a[4 * j + 3] = v[j].w * scale;
                                  b[4 * j] = v[4 + j].x * scale; b[4 * j + 1] = v[4 + j].y * scale; b[4 * j + 2] = v[4 + j].z * scale; b[4 * j + 3] = v[4 + j].w * scale; }
    const u32x6 w = __builtin_amdgcn_cvt_scalef32_2xpk16_fp6_f32(a, b, 1.0f);
    asm volatile("" :: "v"(a), "v"(b));
    u32x2* o = (u32x2*)(dst + lane * 24);
    o[0] = (u32x2){w[0], w[1]}; o[1] = (u32x2){w[2], w[3]}; o[2] = (u32x2){w[4], w[5]};
}

__device__ __forceinline__ void convert_tables(const Args& a, int r0, int r1, int cw, int ncw, int lane) {
    for (int r = r0 + cw; r < r1; r += ncw) {
        if (r < NEXP) p0_cvt_row_fp6(a.in[22] + (size_t)r * D, (unsigned char*)(a.ws + WS_UB) + (size_t)r * 1536, 64.f, lane);
        else p0_cvt_row_fp6(a.in[23] + (size_t)(r - NEXP) * D, (unsigned char*)(a.ws + WS_VB) + (size_t)(r - NEXP) * 1536, 16.f, lane);
    }
}
constexpr int CVT_EARLY_ROWS = 0;

__device__ __forceinline__ void phase_p0a(const Args& a, LAS unsigned char* lds, int vcu, int G, int tid, int wave, int lane) {
    const float* c = a.in[1]; const float* w_ada = a.in[2];
    for (int cb = vcu; cb < 6 * D / 48; cb += G) p0_mod_block(c, w_ada, a.in[3], (float*)(a.ws + WS_MOD), (LAS float*)(lds + XTRA_OFF + 64), cb, tid, wave, lane);
    LAS float* scr = (LAS float*)(lds + RING_OFF + wave * 16384);
    const int gw = vcu * NWAVES + wave, NGW = G * NWAVES;
    constexpr int I_WIN = (D / 64) * (INC / 32), I_WOUT = (D / 64) * (D / 32), I_WQ = I_WOUT, I_TAB = NEXP;
    constexpr int NITEMS = I_WIN + I_WOUT + I_WQ;
    for (int it = gw; it < NITEMS; it += NGW) {
        int r = it;
        if (r < I_WIN) { p0_transpose_item(a.in[8], D, INC, (bf16*)(a.ws + WS_WIN), 0, scr, r, lane); continue; } r -= I_WIN;
        if (r < I_WOUT) { p0_transpose_item(a.in[18], D, D, (bf16*)(a.ws + WS_WOUT), 0, scr, r, lane); continue; } r -= I_WOUT;
        p0_transpose_item(a.in[19], D, D, (bf16*)(a.ws + WS_WQ), 0, scr, r, lane);
    }
}

__device__ __forceinline__ void phase_p0b(const Args& a, LAS unsigned char* lds, int vcu, int G, int tid, int wave, int lane) {
    const float* mod = (const float*)(a.ws + WS_MOD); const float* g_pre = a.in[4];
    LAS float* gm = (LAS float*)(lds + RING_OFF); LAS float* sh = gm + D;
#pragma unroll
    for (int i = 0; i < 4; ++i) { const int k = tid + NTHR * i; sh[k] = mod[k]; gm[k] = g_pre[k] * (1.f + mod[D + k]); }
    __syncthreads();
    const float* x = a.in[0]; bf16* XN = (bf16*)(a.ws + WS_XN);
    const int gw = vcu * NWAVES + wave, NGW = G * NWAVES;
    for (int row = gw; row < S; row += NGW) {
        const float* xr = x + (size_t)row * D + lane * 4;
        f32x4 v[8]; float ss = 0.f;
#pragma unroll
        for (int j = 0; j < 8; ++j) { v[j] = *(const f32x4*)(xr + 256 * j); ss += (v[j].x * v[j].x + v[j].y * v[j].y) + (v[j].z * v[j].z + v[j].w * v[j].w); }
        const float r = rsqrtf(wave_sum(ss) * (1.f / D) + EPS);
#pragma unroll
        for (int j = 0; j < 8; ++j) { const f32x4 g4 = *(const LAS f32x4*)(gm + lane * 4 + 256 * j), s4 = *(const LAS f32x4*)(sh + lane * 4 + 256 * j);
            const f32x4 o = v[j] * r * g4 + s4;
            *(unsigned long long*)(XN + (size_t)row * D + lane * 4 + 256 * j) = (unsigned long long)pk2(o.x, o.y) | ((unsigned long long)pk2(o.z, o.w) << 32); }
    }
}

struct EpiF32 {
    static constexpr bool PERM = false, AFTER_DRAIN = false;
    float* O; int ldc;
    __device__ __forceinline__ void operator()(const pg8::f32x4 (&acc)[2][2][4][2], const pg8::Unit& u, int wr, int wc, int fr, int fq) const {
        const int row0 = u.pm * pg8::BM + wr * 64 + fr, col0 = u.pn * pg8::BM + wc * 32 + 4 * fq;
#pragma unroll
        for (int ai = 0; ai < 2; ++ai)
#pragma unroll
            for (int m = 0; m < 4; ++m) { float* rowp = O + (size_t)(row0 + ai * pg8::HALF + m * 16) * ldc + col0;
#pragma unroll
                for (int bj = 0; bj < 2; ++bj)
#pragma unroll
                    for (int n = 0; n < 2; ++n) *(pg8::f32x4*)(rowp + bj * pg8::HALF + n * 16) = acc[ai][bj][m][n]; }
    }
};

__device__ __forceinline__ void phase_attn_simple(const Args& a, LAS unsigned char* lds, int vcu, int G, int wave, int lane) {
    const bf16* proj = (const bf16*)(a.ws + WS_PROJ); bf16* Y = (bf16*)(a.ws + WS_Y);
    const float* g_subln = a.in[13];
    LAS float* qs = (LAS float*)(lds + RING_OFF) + wave * 128;
    const float lam = __expf(wave_sum(a.in[9][lane] * a.in[10][lane])) - __expf(wave_sum(a.in[11][lane] * a.in[12][lane])) + LAMBDA_INIT;
    const int gw = vcu * NWAVES + wave, NGW = G * NWAVES;
    for (int gid = gw; gid < NH * S; gid += NGW) {
        const int h = gid & 7, qpos = gid >> 3;
        const float slope = exp2f(-(float)(h + 1)) * LOG2E;
        const bf16* qrow = proj + (size_t)qpos * INC + h * 128;
        LDS_WAIT(); asm volatile("" ::: "memory");
        qs[lane] = bf2f(qrow[lane]); qs[64 + lane] = bf2f(qrow[64 + lane]);
        LDS_WAIT(); asm volatile("" ::: "memory");
        float res0 = 0.f, res1 = 0.f;
        for (int m = 0; m < 2; ++m) {
            float mx = -INFINITY, l = 0.f, o0 = 0.f, o1 = 0.f;
            for (int kb = 0; kb <= qpos; kb += 64) {
                const int kpos = kb + lane;
                float sdot = -INFINITY;
                if (kpos <= qpos) {
                    const v4u* kr = (const v4u*)(proj + (size_t)kpos * INC + AW + h * 128 + m * 64);
                    float acc = 0.f;
#pragma unroll
                    for (int i = 0; i < 8; ++i) { const v4u kv = kr[i]; const LAS float* qq = qs + m * 64 + 8 * i;
                        acc += bflo(kv.x) * qq[0] + bfhi(kv.x) * qq[1] + bflo(kv.y) * qq[2] + bfhi(kv.y) * qq[3] + bflo(kv.z) * qq[4] + bfhi(kv.z) * qq[5] + bflo(kv.w) * qq[6] + bfhi(kv.w) * qq[7]; }
                    sdot = acc - slope * (float)(qpos - kpos);
                }
                const float mn = fmaxf(mx, wave_max(sdot));
                const float alpha = exp2f(mx - mn);
                const float p = (kpos <= qpos) ? exp2f(sdot - mn) : 0.f;
                l = l * alpha + wave_sum(p);
                o0 *= alpha; o1 *= alpha;
                const int nk = min(64, qpos - kb + 1);
                for (int j = 0; j < nk; ++j) {
                    const float pj = __shfl(p, j);
                    const unsigned vv = *((const unsigned*)(proj + (size_t)(kb + j) * INC + 2 * AW + h * 128) + lane);
                    o0 += pj * bflo(vv); o1 += pj * bfhi(vv);
                }
                mx = mn;
            }
            const float inv = 1.f / l;
            if (m == 0) { res0 = o0 * inv; res1 = o1 * inv; } else { res0 -= lam * o0 * inv; res1 -= lam * o1 * inv; }
        }
        const float ss = wave_sum(res0 * res0 + res1 * res1);
        const float r = rsqrtf(ss * (1.f / 128.f) + EPS) * (1.f - LAMBDA_INIT);
        *((unsigned*)(Y + (size_t)qpos * D + h * 128) + lane) = pk2(res0 * r * g_subln[2 * lane], res1 * r * g_subln[2 * lane + 1]);
    }
}

__device__ __forceinline__ void block_sum2(float& a, float& b, LAS float* red, int wave, int lane) {
    a = wave_sum(a); b = wave_sum(b);
    __syncthreads();
    if (lane == 0) { red[wave] = a; red[8 + wave] = b; }
    __syncthreads();
    float sa = 0.f, sb = 0.f;
#pragma unroll
    for (int i = 0; i < 8; ++i) { sa += red[i]; sb += red[8 + i]; }
    a = sa; b = sb;
}

__device__ __forceinline__ void phase_conv_simple(const Args& a, LAS unsigned char* lds, int vcu, int G, int tid, int wave, int lane) {
    const bf16* proj = (const bf16*)(a.ws + WS_PROJ); bf16* Y = (bf16*)(a.ws + WS_Y);
    const float* conv_w = a.in[14]; const float* conv_b = a.in[15]; const float* ln_g = a.in[16]; const float* ln_b = a.in[17];
    LAS float* red = (LAS float*)(lds + XTRA_OFF);
    const int per = S / G;
    for (int t = vcu * per; t < (vcu + 1) * per; ++t) {
        float acc0 = 0.f, acc1 = 0.f;
        for (int j = 0; j < CK; ++j) {
            const int tt = t - (CK - 1) + j;
            if (tt < 0) continue;
            const unsigned av = *((const unsigned*)(proj + (size_t)tt * INC + 3 * AW) + tid);
            const unsigned gv = *((const unsigned*)(proj + (size_t)tt * INC + 3 * AW + CW) + tid);
            const float u0 = bflo(av) / (1.f + __expf(-bflo(gv))), u1 = bfhi(av) / (1.f + __expf(-bfhi(gv)));
            acc0 += conv_w[j * CW + 2 * tid] * u0; acc1 += conv_w[j * CW + 2 * tid + 1] * u1;
        }
        acc0 += conv_b[2 * tid]; acc1 += conv_b[2 * tid + 1];
        float s1 = acc0 + acc1, s2 = acc0 * acc0 + acc1 * acc1;
        block_sum2(s1, s2, red, wave, lane);
        const float mu = s1 * (1.f / CW), var = fmaxf(s2 * (1.f / CW) - mu * mu, 0.f), r = rsqrtf(var + EPS);
        const float v0 = (acc0 - mu) * r * ln_g[2 * tid] + ln_b[2 * tid], v1 = (acc1 - mu) * r * ln_g[2 * tid + 1] + ln_b[2 * tid + 1];
        *((unsigned*)(Y + (size_t)t * D + AW) + tid) = pk2(silu_f(v0), silu_f(v1));
    }
}

__device__ __forceinline__ void phase_p3b(const Args& a, LAS unsigned char* lds, int vcu, int G, int tid, int wave, int lane) {
    const float* mod = (const float*)(a.ws + WS_MOD);
    LAS float* gA = (LAS float*)(lds + RING_OFF); LAS float* gB = gA + D; LAS float* sB = gB + D;
#pragma unroll
    for (int i = 0; i < 4; ++i) { const int k = tid + NTHR * i; gA[k] = mod[2 * D + k] * a.in[5][k]; gB[k] = a.in[6][k] * (1.f + mod[4 * D + k]); sB[k] = mod[3 * D + k]; }
    __syncthreads();
    const float* x = a.in[0]; const bf16* mix = (const bf16*)(a.ws + WS_MIX); bf16* XN = (bf16*)(a.ws + WS_XN); float* x1o = (float*)(a.ws + WS_X1);
    const int gw = vcu * NWAVES + wave, NGW = G * NWAVES;
    for (int row = gw; row < S; row += NGW) {
        const size_t ro = (size_t)row * D + lane * 4;
        unsigned long long mv[8]; f32x4 xv[8];
#pragma unroll
        for (int j = 0; j < 8; ++j) { mv[j] = *(const unsigned long long*)(mix + ro + 256 * j); xv[j] = *(const f32x4*)(x + ro + 256 * j); }
        f32x4 v[8]; float ss = 0.f;
#pragma unroll
        for (int j = 0; j < 8; ++j) { const unsigned lo = (unsigned)mv[j], hi = (unsigned)(mv[j] >> 32); v[j] = (f32x4){bflo(lo), bfhi(lo), bflo(hi), bfhi(hi)};
            ss += (v[j].x * v[j].x + v[j].y * v[j].y) + (v[j].z * v[j].z + v[j].w * v[j].w); }
        const float r = rsqrtf(wave_sum(ss) * (1.f / D) + EPS);
        float s2 = 0.f;
#pragma unroll
        for (int j = 0; j < 8; ++j) { const f32x4 g4 = *(const LAS f32x4*)(gA + lane * 4 + 256 * j);
            v[j] = xv[j] + v[j] * r * g4; *(f32x4*)(x1o + ro + 256 * j) = v[j]; s2 += (v[j].x * v[j].x + v[j].y * v[j].y) + (v[j].z * v[j].z + v[j].w * v[j].w); }
        const float r2 = rsqrtf(wave_sum(s2) * (1.f / D) + EPS);
#pragma unroll
        for (int j = 0; j < 8; ++j) { const f32x4 g4 = *(const LAS f32x4*)(gB + lane * 4 + 256 * j), s4 = *(const LAS f32x4*)(sB + lane * 4 + 256 * j);
            const f32x4 o = v[j] * r2 * g4 + s4;
            *(unsigned long long*)(XN + ro + 256 * j) = (unsigned long long)pk2(o.x, o.y) | ((unsigned long long)pk2(o.z, o.w) << 32); }
    }
}

#define ARGMAX_STEP(OV, OI) do { const float ov_ = (OV); const int oi_ = (OI); if (ov_ > v || (ov_ == v && oi_ < i)) { v = ov_; i = oi_; } } while (0)
__device__ __forceinline__ void wave_argmax(float v, int i, float& bv, int& bi) {
    ARGMAX_STEP(swz_xor<1>(v), swz_xor_i<1>(i)); ARGMAX_STEP(swz_xor<2>(v), swz_xor_i<2>(i)); ARGMAX_STEP(swz_xor<4>(v), swz_xor_i<4>(i));
    ARGMAX_STEP(swz_xor<8>(v), swz_xor_i<8>(i)); ARGMAX_STEP(swz_xor<16>(v), swz_xor_i<16>(i)); ARGMAX_STEP(xor32_f(v), xor32_i(i));
    bv = v; bi = i;
}
__device__ __forceinline__ void phase_topk_simple(const Args& a, LAS unsigned char* lds, int vcu, int G, int tid, int wave, int lane) {
    LAS float* kt = (LAS float*)(lds + RING_OFF);
    for (int e = tid; e < 2 * PKEYS * 128; e += NTHR) { const int half = e >> 14, key = (e >> 7) & 127, d = e & 127; kt[half * 16384 + d * 128 + key] = a.in[20 + half][key * 128 + d]; }
    LAS float* qs = (LAS float*)(lds + XTRA_OFF + 64) + wave * 256;
    LAS float* tv = (LAS float*)(lds + XTRA_OFF + 64 + 8192) + wave * 32;
    LAS int* ti = (LAS int*)(lds + XTRA_OFF + 64 + 8192 + 1024) + wave * 32;
    __syncthreads();
    const bf16* QP = (const bf16*)(a.ws + WS_QP); int* idx_out = (int*)(a.ws + WS_IDX); float* g_out = (float*)(a.ws + WS_GATE);
    const int gw = vcu * NWAVES + wave, NGW = G * NWAVES;
    for (int gid = gw; gid < S * PH; gid += NGW) {
        const bf16* qr = QP + (size_t)gid * PKD;
        LDS_WAIT(); asm volatile("" ::: "memory");
#pragma unroll
        for (int i = 0; i < 4; ++i) qs[lane + 64 * i] = bf2f(qr[lane + 64 * i]);
        LDS_WAIT(); asm volatile("" ::: "memory");
        for (int half = 0; half < 2; ++half) {
            const LAS float* kk = kt + half * 16384;
            float s0 = 0.f, s1 = 0.f;
#pragma unroll 8
            for (int d = 0; d < 128; ++d) { const float qv = qs[half * 128 + d]; s0 += qv * kk[d * 128 + lane]; s1 += qv * kk[d * 128 + 64 + lane]; }
            for (int r = 0; r < PTOP; ++r) {
                float lv; int li;
                if (s0 >= s1) { lv = s0; li = lane; } else { lv = s1; li = lane + 64; }
                float bv; int bi; wave_argmax(lv, li, bv, bi);
                if (lane == 0) { tv[half * 16 + r] = bv; ti[half * 16 + r] = bi; }
                if (bi == lane) s0 = -INFINITY;
                if (bi == lane + 64) s1 = -INFINITY;
            }
        }
        LDS_WAIT(); asm volatile("" ::: "memory");
        float cv[4];
#pragma unroll
        for (int e = 0; e < 4; ++e) { const int f = lane * 4 + e; cv[e] = tv[f >> 4] + tv[16 + (f & 15)]; }
        float myv = 0.f; int myi = 0; float mx = 0.f, den = 0.f;
        for (int r = 0; r < PTOP; ++r) {
            float lv = cv[0]; int li = lane * 4;
#pragma unroll
            for (int e = 1; e < 4; ++e) if (cv[e] > lv) { lv = cv[e]; li = lane * 4 + e; }
            float bv; int bi; wave_argmax(lv, li, bv, bi);
            if (r == 0) mx = bv;
            den += __expf(bv - mx);
            if (r == lane) { myv = bv; myi = bi; }
#pragma unroll
            for (int e = 0; e < 4; ++e) if (bi == lane * 4 + e) cv[e] = -INFINITY;
        }
        if (lane < PTOP) {
            const int e = ti[myi >> 4] * PKEYS + ti[16 + (myi & 15)];
            idx_out[(size_t)gid * PTOP + lane] = e;
            g_out[(size_t)gid * PTOP + lane] = __expf(myv - mx) / den;
        }
    }
}

__device__ __forceinline__ void phase_peer_simple(const Args& a, LAS unsigned char* lds, int vcu, int G, int tid, int wave, int lane) {
    const float* mod = (const float*)(a.ws + WS_MOD);
    const bf16* XN = (const bf16*)(a.ws + WS_XN); const bf16* Ub = (const bf16*)(a.ws + WS_UB); const bf16* Vb = (const bf16*)(a.ws + WS_VB);
    const int* IDX = (const int*)(a.ws + WS_IDX); const float* GATE = (const float*)(a.ws + WS_GATE);
    LAS float* act = (LAS float*)(lds + RING_OFF); LAS int* eidx = (LAS int*)(lds + RING_OFF + 512); LAS float* red = (LAS float*)(lds + XTRA_OFF);
    const f32x4 gfin = (f32x4){mod[5 * D + 4 * tid] * a.in[7][4 * tid], mod[5 * D + 4 * tid + 1] * a.in[7][4 * tid + 1], mod[5 * D + 4 * tid + 2] * a.in[7][4 * tid + 2], mod[5 * D + 4 * tid + 3] * a.in[7][4 * tid + 3]};
    const int per = S / G;
    for (int t = vcu * per; t < (vcu + 1) * per; ++t) {
        __syncthreads();
        if (tid < 128) eidx[tid] = IDX[(size_t)t * 128 + tid];
        v4u hv[4];
#pragma unroll
        for (int j = 0; j < 4; ++j) hv[j] = *(const v4u*)(XN + (size_t)t * D + lane * 8 + 512 * j);
        __syncthreads();
#pragma unroll 2
        for (int ee = 0; ee < 16; ++ee) {
            const int e = wave * 16 + ee;
            const bf16* ur = Ub + (size_t)eidx[e] * D + lane * 8;
            float acc = 0.f;
#pragma unroll
            for (int j = 0; j < 4; ++j) { const v4u uv = *(const v4u*)(ur + 512 * j);
                acc += bflo(uv.x) * bflo(hv[j].x) + bfhi(uv.x) * bfhi(hv[j].x) + bflo(uv.y) * bflo(hv[j].y) + bfhi(uv.y) * bfhi(hv[j].y)
                     + bflo(uv.z) * bflo(hv[j].z) + bfhi(uv.z) * bfhi(hv[j].z) + bflo(uv.w) * bflo(hv[j].w) + bfhi(uv.w) * bfhi(hv[j].w); }
            acc = wave_sum(acc);
            if (lane == 0) act[e] = 0.5f * acc * (1.f + erff(acc * 0.70710678118654752f)) * GATE[(size_t)t * 128 + e];
        }
        __syncthreads();
        f32x4 o = (f32x4){0.f, 0.f, 0.f, 0.f};
#pragma unroll 8
        for (int e = 0; e < 128; ++e) {
            const unsigned long long vv = *(const unsigned long long*)(Vb + (size_t)eidx[e] * D + 4 * tid);
            const float av = act[e]; const unsigned lo = (unsigned)vv, hi = (unsigned)(vv >> 32);
            o.x += av * bflo(lo); o.y += av * bfhi(lo); o.z += av * bflo(hi); o.w += av * bfhi(hi);
        }
        float ss = (o.x * o.x + o.y * o.y) + (o.z * o.z + o.w * o.w), dummy = 0.f;
        block_sum2(ss, dummy, red, wave, lane);
        const float r = rsqrtf(ss * (1.f / D) + EPS);
        float* op = a.out + (size_t)t * D + 4 * tid;
        const f32x4 x1 = *(const f32x4*)op;
        *(f32x4*)op = x1 + o * r * gfin;
    }
}


namespace att {
using f32x16 = __attribute__((ext_vector_type(16))) float;
using s16x4 = __attribute__((ext_vector_type(4))) short;
typedef __attribute__((address_space(3))) const char* lds_cptr;
constexpr int KSLOT = 16384, NKS = 3, VSLOT = 16384, NVS = 4, KVB = 64, QBR = 128;
constexpr int LDS_KR = 0, LDS_VR = NKS * KSLOT, LDS_O2 = 0, LDS_OST = 65536, LDS_WS = LDS_VR + NVS * VSLOT, LDS_FLAG = LDS_WS + 2048, ATT_LDS_BYTES = LDS_FLAG + 64;
__device__ __forceinline__ int crow(int r, int hi) { return (r & 3) + 8 * (r >> 2) + 4 * hi; }
__device__ __forceinline__ void glds16(const void* gsrc, unsigned lds_dst) { unsigned keep;
    asm volatile("s_mov_b32 %0, m0\n\ts_mov_b32 m0, %2\n\ts_nop 0\n\tglobal_load_lds_dwordx4 %1, off\n\ts_mov_b32 m0, %0" : "=&s"(keep) : "v"(gsrc), "s"(lds_dst) : "memory"); }
#define ATT_WAIT_BAR(N) asm volatile("s_waitcnt vmcnt(" #N ") lgkmcnt(0)\n\ts_barrier" ::: "memory")
typedef float f32x2_t __attribute__((ext_vector_type(2))); typedef __bf16 bf16x2_t __attribute__((ext_vector_type(2)));
__device__ __forceinline__ unsigned cvtpk(float lo, float hi) { f32x2_t v = {lo, hi}; bf16x2_t b = __builtin_convertvector(v, bf16x2_t); return __builtin_bit_cast(unsigned, b); }
__device__ __forceinline__ float swap_max(float m) { auto rr = __builtin_amdgcn_permlane32_swap(__float_as_uint(m), __float_as_uint(m), false, false); return fmaxf(__uint_as_float(rr[0]), __uint_as_float(rr[1])); }
__device__ __forceinline__ float swap_sum(float m) { auto rr = __builtin_amdgcn_permlane32_swap(__float_as_uint(m), __float_as_uint(m), false, false); return __uint_as_float(rr[0]) + __uint_as_float(rr[1]); }
__device__ __forceinline__ float max3a(float a, float b, float c) { float r; asm("v_max3_f32 %0, %1, %2, %3" : "=v"(r) : "v"(a), "v"(b), "v"(c)); return r; }
#define ATT_VRD(dst, off) asm volatile("ds_read_b64_tr_b16 %0, %1 offset:%c2" : "=v"(dst) : "v"(vaddr), "i"(off) : "memory")
#define ATT_VF(i) (bf16x8){vlo[i][0], vlo[i][1], vlo[i][2], vlo[i][3], vhi[i][0], vhi[i][1], vhi[i][2], vhi[i][3]}

struct UnitCtx {
    const bf16* ksrc; const bf16* vsrc; unsigned kdst, vdst; unsigned lds0; lds_cptr shm3;
    int NT, q0, wq, m, r32, hi, lane, qrow; float ch;
};
#define ATT_DMA(t, ko_, vo_) do { const size_t ro_ = (size_t)(t) * KVB * INC; \
        glds16(c.ksrc + ro_, (unsigned)__builtin_amdgcn_readfirstlane(c.kdst + (ko_))); glds16(c.ksrc + ro_ + (size_t)32 * INC, (unsigned)__builtin_amdgcn_readfirstlane(c.kdst + (ko_) + 8192)); \
        glds16(c.vsrc + ro_, (unsigned)__builtin_amdgcn_readfirstlane(c.vdst + (vo_))); glds16(c.vsrc + ro_ + 64, (unsigned)__builtin_amdgcn_readfirstlane(c.vdst + (vo_) + 8192)); } while (0)

__device__ __forceinline__ void qk_tile(const UnitCtx& c, const bf16x8 (&qr)[4], float m0, int t, int ko, f32x16& p0, f32x16& p1) {
    const int hi = c.hi;
    const float tm = c.ch * (float)(t * KVB + 4 * hi - c.qrow) - m0, c32 = c.ch * 32.f;
#pragma unroll
    for (int r = 0; r < 16; ++r) { p0[r] = c.ch * (float)((r & 3) + 8 * (r >> 2)) + tm; p1[r] = p0[r] + c32; }
    const lds_cptr kp = c.shm3 + LDS_KR + ko + c.r32 * 256;
    bf16x8 ka[4], kb[4];
#pragma unroll
    for (int d0 = 0; d0 < 4; ++d0) { const int off = (((8 * c.m + hi + 2 * d0) ^ (c.r32 & 15)) * 16);
        ka[d0] = *(const __attribute__((address_space(3))) bf16x8*)(kp + off); kb[d0] = *(const __attribute__((address_space(3))) bf16x8*)(kp + off + 8192); }
    asm volatile("" : "+v"(ka[0]), "+v"(ka[1]), "+v"(ka[2]), "+v"(ka[3]), "+v"(kb[0]), "+v"(kb[1]), "+v"(kb[2]), "+v"(kb[3]));
#pragma unroll
    for (int d0 = 0; d0 < 4; ++d0) p0 = __builtin_amdgcn_mfma_f32_32x32x16_bf16(ka[d0], qr[d0], p0, 0, 0, 0);
#pragma unroll
    for (int d0 = 0; d0 < 4; ++d0) p1 = __builtin_amdgcn_mfma_f32_32x32x16_bf16(kb[d0], qr[d0], p1, 0, 0, 0);
    if (t * KVB + KVB - 1 > c.q0 + 32 * c.wq) {
        const int kb_ = t * KVB + 4 * hi;
#pragma unroll
        for (int r = 0; r < 16; ++r) { const int kv = kb_ + (r & 3) + 8 * (r >> 2); if (kv > c.qrow) p0[r] = -INFINITY; if (kv + 32 > c.qrow) p1[r] = -INFINITY; }
    }
}
__device__ __forceinline__ void exp_half(f32x16& p, float& sa, float& sb, v4u& wA, v4u& wB) {
#pragma unroll
    for (int r = 0; r < 16; r += 2) { p[r] = __builtin_amdgcn_exp2f(p[r]); p[r + 1] = __builtin_amdgcn_exp2f(p[r + 1]); sa += p[r]; sb += p[r + 1]; }
    wA = (v4u){cvtpk(p[0], p[1]), cvtpk(p[2], p[3]), cvtpk(p[4], p[5]), cvtpk(p[6], p[7])};
    wB = (v4u){cvtpk(p[8], p[9]), cvtpk(p[10], p[11]), cvtpk(p[12], p[13]), cvtpk(p[14], p[15])};
}
template <int H> __device__ __forceinline__ void pv_half(unsigned vaddr, const v4u& wA, const v4u& wB, f32x16 (&o)[4]) {
    s16x4 vlo[8], vhi[8];
#pragma unroll
    for (int d0 = 0; d0 < 4; ++d0) { ATT_VRD(vlo[d0], d0 * 4096 + H * 2048); ATT_VRD(vhi[d0], d0 * 4096 + H * 2048 + 512); }
#pragma unroll
    for (int d0 = 0; d0 < 4; ++d0) { ATT_VRD(vlo[4 + d0], d0 * 4096 + H * 2048 + 1024); ATT_VRD(vhi[4 + d0], d0 * 4096 + H * 2048 + 1024 + 512); }
    asm volatile("s_waitcnt lgkmcnt(8)" ::: "memory"); __builtin_amdgcn_sched_barrier(0);
#pragma unroll
    for (int d0 = 0; d0 < 4; ++d0) o[d0] = __builtin_amdgcn_mfma_f32_32x32x16_bf16(__builtin_bit_cast(bf16x8, wA), ATT_VF(d0), o[d0], 0, 0, 0);
    asm volatile("s_waitcnt lgkmcnt(0)" ::: "memory"); __builtin_amdgcn_sched_barrier(0);
#pragma unroll
    for (int d0 = 0; d0 < 4; ++d0) o[d0] = __builtin_amdgcn_mfma_f32_32x32x16_bf16(__builtin_bit_cast(bf16x8, wB), ATT_VF(4 + d0), o[d0], 0, 0, 0);
    __builtin_amdgcn_sched_barrier(0);
}

template <int MODE, bool STAG>
__device__ __forceinline__ void sweep(const UnitCtx& c, const bf16x8 (&qr)[4], float m0, f32x16 (&o)[4], float& lsum, float& rmax) {
    const int NT = c.NT;
    ATT_DMA(0, 0, 0); ATT_DMA(1, KSLOT, VSLOT);
    const unsigned vbase = c.lds0 + LDS_VR + ((c.lane >> 4) & 1) * 32 + (c.lane & 3) * 8 + (4 * c.hi + ((c.lane & 15) >> 2)) * 64;
    int ko = 0, vo = 0;
    v4u pw0 = (v4u){0u, 0u, 0u, 0u}, pw1 = pw0, pw2 = pw0, pw3 = pw0;
    unsigned vprev = vbase;
    for (int t = 0; t < NT; ++t) {
        if (t + 1 < NT) ATT_WAIT_BAR(4); else ATT_WAIT_BAR(0);
        { const int t2 = t + 2; if (t2 < NT) { int k2 = ko + 2 * KSLOT; if (k2 >= NKS * KSLOT) k2 -= NKS * KSLOT; int v2 = vo + 2 * VSLOT; if (v2 >= NVS * VSLOT) v2 -= NVS * VSLOT; ATT_DMA(t2, k2, v2); } }
        f32x16 p0, p1;
        if constexpr (MODE == 1) {
            qk_tile(c, qr, m0, t, ko, p0, p1);
            float a = max3a(p0[0], p0[1], p1[0]), b = max3a(p0[2], p0[3], p1[1]); a = max3a(a, p1[2], p1[3]);
#pragma unroll
            for (int r = 4; r < 16; r += 4) { a = max3a(a, p0[r], p0[r + 1]); b = max3a(b, p0[r + 2], p0[r + 3]); a = max3a(a, p1[r], p1[r + 1]); b = max3a(b, p1[r + 2], p1[r + 3]); }
            rmax = max3a(rmax, a, b);
        } else if constexpr (!STAG) {
            qk_tile(c, qr, m0, t, ko, p0, p1);
            const unsigned vaddr = vbase + (unsigned)vo;
            float sa = 0.f, sb = 0.f;
            exp_half(p0, sa, sb, pw0, pw1);
            {
                s16x4 vlo[8], vhi[8];
#pragma unroll
                for (int d0 = 0; d0 < 4; ++d0) { ATT_VRD(vlo[d0], d0 * 4096); ATT_VRD(vhi[d0], d0 * 4096 + 512); }
#pragma unroll
                for (int d0 = 0; d0 < 4; ++d0) { ATT_VRD(vlo[4 + d0], d0 * 4096 + 1024); ATT_VRD(vhi[4 + d0], d0 * 4096 + 1024 + 512); }
                asm volatile("s_waitcnt lgkmcnt(8)" ::: "memory"); __builtin_amdgcn_sched_barrier(0);
#pragma unroll
                for (int d0 = 0; d0 < 4; ++d0) o[d0] = __builtin_amdgcn_mfma_f32_32x32x16_bf16(__builtin_bit_cast(bf16x8, pw0), ATT_VF(d0), o[d0], 0, 0, 0);
                exp_half(p1, sa, sb, pw2, pw3);
                asm volatile("s_waitcnt lgkmcnt(0)" ::: "memory"); __builtin_amdgcn_sched_barrier(0);
#pragma unroll
                for (int d0 = 0; d0 < 4; ++d0) o[d0] = __builtin_amdgcn_mfma_f32_32x32x16_bf16(__builtin_bit_cast(bf16x8, pw1), ATT_VF(4 + d0), o[d0], 0, 0, 0);
                __builtin_amdgcn_sched_barrier(0);
            }
            lsum += sa + sb;
            pv_half<1>(vaddr, pw2, pw3, o);
        } else {
            if (t > 0) { pv_half<0>(vprev, pw0, pw1, o); pv_half<1>(vprev, pw2, pw3, o); }
            qk_tile(c, qr, m0, t, ko, p0, p1);
            float sa = 0.f, sb = 0.f;
            exp_half(p0, sa, sb, pw0, pw1);
            exp_half(p1, sa, sb, pw2, pw3);
            lsum += sa + sb;
            vprev = vbase + (unsigned)vo;
        }
        ko += KSLOT; if (ko >= NKS * KSLOT) ko = 0;
        vo += VSLOT; if (vo >= NVS * VSLOT) vo = 0;
    }
    if constexpr (MODE == 0 && STAG) { pv_half<0>(vprev, pw0, pw1, o); pv_half<1>(vprev, pw2, pw3, o); }
}

__device__ __forceinline__ void attn_unit(int h, int qb, const bf16* PROJ, bf16* Y, const float* g_subln, float lam, LAS unsigned char* shm) {
    int tid_ = threadIdx.x; asm volatile("" : "+v"(tid_)); const int tid = tid_, lane = tid & 63, r32 = lane & 31, hi = lane >> 5; const int w = __builtin_amdgcn_readfirstlane(tid >> 6);
    UnitCtx c;
    c.m = w >> 2; c.wq = w & 3; c.q0 = qb * QBR; c.r32 = r32; c.hi = hi; c.lane = lane;
    c.lds0 = (unsigned)(uintptr_t)shm; c.shm3 = (lds_cptr)shm;
    LAS float* wsf = (LAS float*)(shm + LDS_WS) + w * 64;
    LAS int* flags = (LAS int*)(shm + LDS_FLAG);
    c.ksrc = PROJ + AW + h * 128 + (size_t)(4 * w + (lane >> 4)) * INC + (((lane & 15) ^ ((4 * w + (lane >> 4)) & 15)) * 8);
    c.vsrc = PROJ + 2 * AW + h * 128 + (size_t)(16 * (w & 3) + (lane >> 2)) * INC + (w >> 2) * 32 + (lane & 3) * 8;
    c.kdst = c.lds0 + LDS_KR + w * 1024; c.vdst = c.lds0 + LDS_VR + w * 1024;
    c.NT = c.q0 / KVB + 2;
    c.qrow = c.q0 + 32 * c.wq + r32;
    c.ch = exp2f(-(float)(h + 1)) * LOG2E;
    bf16x8 qr[4];
    { const bf16* Qw = PROJ + (size_t)c.qrow * INC + h * 128 + c.m * 64 + hi * 8;
#pragma unroll
      for (int d0 = 0; d0 < 4; ++d0) qr[d0] = *(const bf16x8*)(Qw + d0 * 16); }
    asm volatile("" : "+v"(qr[0]), "+v"(qr[1]), "+v"(qr[2]), "+v"(qr[3]));
    f32x16 o[4]; float lsum, m0 = 0.f;
#pragma unroll 1
    for (int pass = 0; ; ++pass) {
#pragma unroll
        for (int d = 0; d < 4; ++d) o[d] = f32x16{};
        lsum = 0.f; float dummy = 0.f;
        if (c.m == 0) sweep<0, false>(c, qr, m0, o, lsum, dummy); else sweep<0, true>(c, qr, m0, o, lsum, dummy);
        lsum = swap_sum(lsum);
        const bool bad = !(lsum > 0.f) || !(lsum < 3.0e38f);
        if (lane == 0) flags[w] = 0;
        if (bad) flags[w] = 1;
        ATT_WAIT_BAR(0);
        int anybad = 0;
#pragma unroll
        for (int i = 0; i < 8; ++i) anybad |= flags[i];
        if (anybad == 0 || pass >= 1) break;
        float rmax = -INFINITY;
        ATT_WAIT_BAR(0);
        sweep<1, false>(c, qr, 0.f, o, lsum, rmax);
        m0 = swap_max(rmax);
        ATT_WAIT_BAR(0);
    }
    if (hi == 0) wsf[32 + r32] = 1.f / lsum;
    asm volatile("s_waitcnt lgkmcnt(0)" ::: "memory");
    { const f32x4 fa = *(const LAS f32x4*)(wsf + 32 + 4 * hi), fb = *(const LAS f32x4*)(wsf + 40 + 4 * hi), fc = *(const LAS f32x4*)(wsf + 48 + 4 * hi), fd = *(const LAS f32x4*)(wsf + 56 + 4 * hi);
      const f32x16 fv = (f32x16){fa.x, fa.y, fa.z, fa.w, fb.x, fb.y, fb.z, fb.w, fc.x, fc.y, fc.z, fc.w, fd.x, fd.y, fd.z, fd.w};
#pragma unroll
      for (int d = 0; d < 4; ++d) o[d] = o[d] * fv; }
    LAS float* o2 = (LAS float*)(shm + LDS_O2) + c.wq * 4096 + lane;
    if (c.m == 1) {
#pragma unroll
        for (int d = 0; d < 4; ++d)
#pragma unroll
            for (int r = 0; r < 16; ++r) o2[(d * 16 + r) * 64] = o[d][r];
    }
    ATT_WAIT_BAR(0);
    if (c.m == 0) {
        float ssq[16];
#pragma unroll
        for (int r = 0; r < 16; ++r) ssq[r] = 0.f;
#pragma unroll
        for (int d = 0; d < 4; ++d)
#pragma unroll
            for (int r = 0; r < 16; ++r) { const float v = o[d][r] - lam * o2[(d * 16 + r) * 64]; o[d][r] = v; ssq[r] += v * v; }
#pragma unroll
        for (int r = 0; r < 16; ++r) {
            float s = ssq[r];
            s += swz_xor<1>(s); s += swz_xor<2>(s); s += swz_xor<4>(s); s += swz_xor<8>(s); s += swz_xor<16>(s);
            ssq[r] = rsqrtf(s * (1.f / 128.f) + EPS) * (1.f - LAMBDA_INIT);
        }
        LAS bf16* stg = (LAS bf16*)(shm + LDS_OST) + c.wq * 4096;
#pragma unroll
        for (int d = 0; d < 4; ++d) { const float gd = g_subln[d * 32 + r32];
#pragma unroll
            for (int r = 0; r < 16; ++r) stg[crow(r, hi) * 128 + d * 32 + r32] = (bf16)f2bf(o[d][r] * ssq[r] * gd); }
        asm volatile("s_waitcnt lgkmcnt(0)" ::: "memory");
        bf16* Yw = Y + (size_t)(c.q0 + 32 * c.wq) * D + h * 128;
#pragma unroll
        for (int i = 0; i < 8; ++i) { const int row = i * 4 + (lane >> 4), chn = lane & 15; const v4u v = *(const LAS v4u*)(stg + row * 128 + chn * 8); *(v4u*)(Yw + (size_t)row * D + chn * 8) = v; }
    }
    ATT_WAIT_BAR(0);
}

__device__ __forceinline__ void attn_phase(const Args& a, LAS unsigned char* lds, int vcu, int G, int lane) {
    const bf16* PROJ = (const bf16*)(a.ws + WS_PROJ); bf16* Y = (bf16*)(a.ws + WS_Y);
    const float lam = __expf(wave_sum(a.in[9][lane] * a.in[10][lane])) - __expf(wave_sum(a.in[11][lane] * a.in[12][lane])) + LAMBDA_INIT;
    for (int u = vcu; u < NH * 32; u += G) {
        const int h = u >> 5, s = u & 31;
#pragma unroll 1
        for (int k = 0; k < 2; ++k) attn_unit(h, k == 0 ? 63 - s : s, PROJ, Y, a.in[13], lam, lds);
    }
}
#undef ATT_VRD
#undef ATT_VF
#undef ATT_DMA
}

namespace peer {
typedef int i32x16 __attribute__((ext_vector_type(16)));
typedef float f32x16s __attribute__((ext_vector_type(16)));
typedef float f32x2 __attribute__((ext_vector_type(2)));
typedef unsigned u32x6 __attribute__((ext_vector_type(6)));
typedef float f32x32 __attribute__((ext_vector_type(32)));
typedef float f32x16v __attribute__((ext_vector_type(16)));
constexpr int ROWB = 1536;
constexpr float U_SCALE = 64.f, V_SCALE = 16.f;
template <int N> __device__ __forceinline__ float dpp_ror(float v) { return __int_as_float(__builtin_amdgcn_update_dpp(0, __float_as_int(v), 0x120 + N, 0xf, 0xf, false)); }
__device__ __forceinline__ void dma_row(const char* rowbase, unsigned lds_dst, unsigned voff) {
    unsigned keep; unsigned long long ex; const unsigned v1 = voff + 1024u;
    asm volatile("s_nop 4\n\ts_mov_b32 %0, m0\n\ts_mov_b32 m0, %3\n\ts_nop 0\n\tglobal_load_lds_dwordx4 %4, %2\n\t"
                 "s_add_u32 m0, m0, 0x400\n\ts_mov_b64 %1, exec\n\ts_mov_b64 exec, 0xffffffff\n\tglobal_load_lds_dwordx4 %5, %2\n\t"
                 "s_mov_b64 exec, %1\n\ts_mov_b32 m0, %0" : "=&s"(keep), "=&s"(ex) : "s"(rowbase), "s"(lds_dst), "v"(voff), "v"(v1) : "memory", "scc");
}
__device__ __forceinline__ void sload16(i32x16& d, const void* p) { asm volatile("s_load_dwordx16 %0, %1, 0x0\n\ts_waitcnt lgkmcnt(0)" : "=&s"(d) : "s"(p) : "memory"); }
__device__ __forceinline__ void sload16x2(i32x16& d0, const void* p0, i32x16& d1, const void* p1) {
    asm volatile("s_load_dwordx16 %0, %2, 0x0\n\ts_load_dwordx16 %1, %3, 0x0\n\ts_waitcnt lgkmcnt(0)" : "=&s"(d0), "=&s"(d1) : "s"(p0), "s"(p1) : "memory"); }
#define PIN16(x, o) asm volatile("" : "+v"(x[o]), "+v"(x[o+1]), "+v"(x[o+2]), "+v"(x[o+3]), "+v"(x[o+4]), "+v"(x[o+5]), "+v"(x[o+6]), "+v"(x[o+7]), "+v"(x[o+8]), "+v"(x[o+9]), "+v"(x[o+10]), "+v"(x[o+11]), "+v"(x[o+12]), "+v"(x[o+13]), "+v"(x[o+14]), "+v"(x[o+15]))
#define PEER_SWAIT() asm volatile("s_waitcnt lgkmcnt(0)" ::: "memory")
#define PEER_VWAIT(N) asm volatile("s_waitcnt vmcnt(" #N ")" ::: "memory")
#define PEER_VWAIT_PF() do { if (PEER_PF == 8) PEER_VWAIT(12); else if (PEER_PF == 6) PEER_VWAIT(8); else if (PEER_PF == 4) PEER_VWAIT(4); else PEER_VWAIT(0); } while (0)
__device__ __forceinline__ f32x32 row32(const LAS unsigned char* slot, int lane) {
    typedef unsigned u32x2 __attribute__((ext_vector_type(2)));
    const LAS u32x2* p = (const LAS u32x2*)(slot + lane * 24);
    const u32x2 d0 = p[0], d1 = p[1], d2 = p[2];
    const u32x6 src = (u32x6){d0.x, d0.y, d1.x, d1.y, d2.x, d2.y};
    const f32x32 f = __builtin_amdgcn_cvt_scalef32_pk32_f32_fp6(src, 1.0f);
    asm volatile("" :: "v"(src));
    return f;
}

__device__ __forceinline__ void phase_peer(const Args& a, LAS unsigned char* lds, int vcu, int G, int tid, int wave, int lane, float* dst, int imask = -1) {
    const float* mod = (const float*)(a.ws + WS_MOD);
    const bf16* XN = (const bf16*)(a.ws + WS_XN); const char* Ub = (const char*)(a.ws + WS_UB); const char* Vb = (const char*)(a.ws + WS_VB);
    const int* IDX = (const int*)(a.ws + WS_IDX); const float* GATE = (const float*)(a.ws + WS_GATE);
    LAS float* gfin = (LAS float*)(lds + XTRA_OFF + 64);
#pragma unroll
    for (int i = 0; i < 4; ++i) { const int k = tid + NTHR * i; gfin[k] = mod[5 * D + k] * a.in[7][k]; }
    __syncthreads();
    const int gw = vcu * NWAVES + wave, NGW = G * NWAVES;
    const int ntok = (S - gw + NGW - 1) / NGW;
    if (ntok <= 0) return;
    const int nbb = ntok * 8;
    const unsigned ring = (unsigned)(uintptr_t)(lds + RING_OFF) + (unsigned)wave * 16384u;
    const LAS unsigned char* ringp = lds + RING_OFF + wave * 16384;
    const unsigned voff = (unsigned)lane * 16u;
    i32x16 ic, in_; f32x16s gc;
    sload16(ic, IDX + (size_t)gw * 128);
    in_ = ic;
#define ROWU(v, e) (Ub + (size_t)(unsigned)((v)[e] & imask) * ROWB)
#define ROWV(v, e) (Vb + (size_t)(unsigned)((v)[e] & imask) * ROWB)
#ifndef PEER_PF
#define PEER_PF 8
#endif
#define SLOT(n) (((n) % PEER_PF) * 2048)
#pragma unroll
    for (int e = 0; e < PEER_PF; ++e) dma_row(ROWU(ic, e), ring + SLOT(e), voff);
    int eo[32];
    {
        f32x16v ta, tb;
#pragma unroll
        for (int i = 0; i < 16; ++i) { ta[i] = 0.125f * (float)i; tb[i] = (i < 8) ? 2.f + 0.25f * (float)i : 4.f + 0.5f * (float)(i - 8); }
        const u32x6 tp = __builtin_amdgcn_cvt_scalef32_2xpk16_fp6_f32(ta, tb, 1.0f);
        asm volatile("" :: "v"(ta), "v"(tb));
        const f32x32 tf = __builtin_amdgcn_cvt_scalef32_pk32_f32_fp6(tp, 1.0f);
        asm volatile("" :: "v"(tp));
#pragma unroll
        for (int p = 0; p < 32; ++p) { const float v = tf[p]; const int i = (v < 2.f) ? (int)(v * 8.f) : (v < 4.f) ? 16 + (int)((v - 2.f) * 4.f) : 24 + (int)((v - 4.f) * 2.f);
            eo[p] = ((i & 16) ? 1024 : 0) + lane * 16 + (i & 15); }
    }
    float hp[32];
    float op[32];
    int tok = gw;
    for (int bb = 0; bb < nbb; ++bb) {
        const int b = bb & 7;
        if (b == 0) {
            tok = gw + (bb >> 3) * NGW;
#pragma unroll
            for (int p = 0; p < 32; ++p) hp[p] = bf2f(XN[(size_t)tok * D + eo[p]]);
            PIN16(hp, 0); PIN16(hp, 16);
#pragma unroll
            for (int p = 0; p < 32; ++p) op[p] = 0.f;
        }
        {
            const int nb = (bb + 1 < nbb) ? bb + 1 : bb;
            const size_t nofs = (size_t)(gw + (nb >> 3) * NGW) * 128 + (nb & 7) * 16;
            i32x16 gtmp;
            sload16x2(gtmp, GATE + (size_t)tok * 128 + b * 16, in_, IDX + nofs);
            gc = __builtin_bit_cast(f32x16s, gtmp);
        }
        float s[16];
#pragma unroll
        for (int st = 0; st < 8; ++st) {
            PEER_VWAIT_PF();
            const f32x32 f0 = row32(ringp + SLOT(2 * st), lane), f1 = row32(ringp + SLOT(2 * st + 1), lane);
            PEER_SWAIT();
            {
                const int e8 = 2 * st + PEER_PF;
                if (e8 < 16) { dma_row(ROWU(ic, e8), ring + SLOT(2 * st), voff); dma_row(ROWU(ic, e8 + 1), ring + SLOT(2 * st + 1), voff); }
                else { dma_row(ROWV(ic, e8 - 16), ring + SLOT(2 * st), voff); dma_row(ROWV(ic, e8 - 15), ring + SLOT(2 * st + 1), voff); }
            }
            float a0 = 0.f, a1 = 0.f, b0 = 0.f, b1 = 0.f;
#pragma unroll
            for (int p = 0; p < 32; p += 2) { a0 += f0[p] * hp[p]; b0 += f0[p + 1] * hp[p + 1]; a1 += f1[p] * hp[p]; b1 += f1[p + 1] * hp[p + 1]; }
            s[2 * st] = a0 + b0; s[2 * st + 1] = a1 + b1;
            asm volatile("" : "+v"(s[2 * st]), "+v"(s[2 * st + 1]));
        }
        float u[4];
        {
            float t8[8];
#pragma unroll
            for (int e = 0; e < 8; ++e) { auto rr = __builtin_amdgcn_permlane32_swap(__float_as_uint(s[e]), __float_as_uint(s[e + 8]), false, false); t8[e] = __uint_as_float(rr[0]) + __uint_as_float(rr[1]); }
#pragma unroll
            for (int e = 0; e < 4; ++e) { auto rr = __builtin_amdgcn_permlane16_swap(__float_as_uint(t8[e]), __float_as_uint(t8[e + 4]), false, false); u[e] = __uint_as_float(rr[0]) + __uint_as_float(rr[1]); }
#pragma unroll
            for (int e = 0; e < 4; ++e) { u[e] += dpp_ror<8>(u[e]); u[e] += dpp_ror<4>(u[e]); u[e] += dpp_ror<2>(u[e]); u[e] += dpp_ror<1>(u[e]); }
        }
        if (b == 7) {
            const float* xp = (const float*)(a.ws + WS_X1) + (size_t)tok * D;
#pragma unroll
            for (int p = 0; p < 32; ++p) hp[p] = xp[eo[p]];
        }
        float actv;
        { const int k = lane & 3; const float d = ((k == 0) ? u[0] : (k == 1) ? u[1] : (k == 2) ? u[2] : u[3]) * (1.f / U_SCALE);
          actv = 0.5f * d * (1.f + erff(d * 0.70710678118654752f)) * (1.f / V_SCALE); }
#pragma unroll
        for (int st = 0; st < 8; ++st) {
            PEER_VWAIT_PF();
            const f32x32 f0 = row32(ringp + SLOT(2 * st), lane), f1 = row32(ringp + SLOT(2 * st + 1), lane);
            PEER_SWAIT();
            {
                const int e8 = 2 * st + PEER_PF;
                if (e8 < 16) { dma_row(ROWV(ic, e8), ring + SLOT(2 * st), voff); dma_row(ROWV(ic, e8 + 1), ring + SLOT(2 * st + 1), voff); }
                else { dma_row(ROWU(in_, e8 - 16), ring + SLOT(2 * st), voff); dma_row(ROWU(in_, e8 - 15), ring + SLOT(2 * st + 1), voff); }
            }
            const int e0 = 2 * st, e1 = 2 * st + 1;
            const float g0 = __int_as_float(__builtin_amdgcn_readlane(__float_as_int(actv), 16 * (e0 >> 2) + (e0 & 3))) * gc[e0], g1 = __int_as_float(__builtin_amdgcn_readlane(__float_as_int(actv), 16 * (e1 >> 2) + (e1 & 3))) * gc[e1];
#pragma unroll
            for (int p = 0; p < 32; ++p) op[p] += g0 * f0[p] + g1 * f1[p];
            PIN16(op, 16);
            PIN16(op, 0);
        }
        ic = in_;
        if (b == 7) {
            float ss = 0.f;
#pragma unroll
            for (int p = 0; p < 32; ++p) ss += op[p] * op[p];
            const float r = rsqrtf(wave_sum(ss) * (1.f / D) + EPS);
            float* dp = dst + (size_t)tok * D;
#pragma unroll
            for (int p = 0; p < 32; ++p) dp[eo[p]] = hp[p] + op[p] * r * gfin[eo[p]];
        }
    }
    PEER_VWAIT(0);
#undef ROWU
#undef ROWV
#undef SLOT
}
#undef PEER_SWAIT
#undef PEER_VWAIT
}

namespace peer3 {
using peer::i32x16; using peer::f32x16s; using peer::u32x6; using peer::f32x32; using peer::f32x16v; using peer::ROWB; using peer::U_SCALE; using peer::V_SCALE; using peer::dpp_ror;
using peer::sload16; using peer::sload16x2;
typedef unsigned u32x2 __attribute__((ext_vector_type(2)));
struct Raw { u32x2 a, b, c; };
__device__ __forceinline__ Raw load_row(const char* lanebase, int idx) {
    const u32x2* gp = (const u32x2*)(lanebase + (size_t)(unsigned)idx * ROWB);
    Raw r; r.a = gp[0]; r.b = gp[1]; r.c = gp[2]; return r;
}
__device__ __forceinline__ f32x32 decode(const Raw& r) {
    const u32x6 src = (u32x6){r.a.x, r.a.y, r.b.x, r.b.y, r.c.x, r.c.y};
    const f32x32 f = __builtin_amdgcn_cvt_scalef32_pk32_f32_fp6(src, 1.0f);
    asm volatile("" :: "v"(src));
    return f;
}
__device__ __forceinline__ void calibrate(int (&eo)[32], int lane, float zero) {
    f32x16v ta, tb;
#pragma unroll
    for (int i = 0; i < 16; ++i) { ta[i] = 0.125f * (float)i + zero; tb[i] = ((i < 8) ? 2.f + 0.25f * (float)i : 4.f + 0.5f * (float)(i - 8)) + zero; }
    const u32x6 tp = __builtin_amdgcn_cvt_scalef32_2xpk16_fp6_f32(ta, tb, 1.0f);
    asm volatile("" :: "v"(ta), "v"(tb));
    const f32x32 tf = __builtin_amdgcn_cvt_scalef32_pk32_f32_fp6(tp, 1.0f);
    asm volatile("" :: "v"(tp));
#pragma unroll
    for (int p = 0; p < 32; ++p) { const float v = tf[p]; const int i = (v < 2.f) ? (int)(v * 8.f) : (v < 4.f) ? 16 + (int)((v - 2.f) * 4.f) : 24 + (int)((v - 4.f) * 2.f);
        eo[p] = ((i & 16) ? 1024 : 0) + lane * 16 + (i & 15); }
}
#define PIN16(x, o) asm volatile("" : "+v"(x[o]), "+v"(x[o+1]), "+v"(x[o+2]), "+v"(x[o+3]), "+v"(x[o+4]), "+v"(x[o+5]), "+v"(x[o+6]), "+v"(x[o+7]), "+v"(x[o+8]), "+v"(x[o+9]), "+v"(x[o+10]), "+v"(x[o+11]), "+v"(x[o+12]), "+v"(x[o+13]), "+v"(x[o+14]), "+v"(x[o+15]))

template <int MODE = 0>
__device__ __forceinline__ void phase_peer(const Args& a, LAS unsigned char* lds, int vcu, int G, int tid, int wave, int lane, float* dst, int imask = -1) {
    const float* mod = (const float*)(a.ws + WS_MOD);
    const bf16* XN = (const bf16*)(a.ws + WS_XN); const char* Ul = (const char*)(a.ws + WS_UB) + lane * 24; const char* Vl = (const char*)(a.ws + WS_VB) + lane * 24;
    const int* IDX = (const int*)(a.ws + WS_IDX); const float* GATE = (const float*)(a.ws + WS_GATE);
    LAS float* gfin = (LAS float*)(lds + XTRA_OFF + 64);
#pragma unroll
    for (int i = 0; i < 4; ++i) { const int k = tid + NTHR * i; gfin[k] = mod[5 * D + k] * a.in[7][k]; }
    __syncthreads();
    const int gw = vcu * NWAVES + wave, NGW = G * NWAVES;
    const int ntok = (S - gw + NGW - 1) / NGW;
    if (ntok <= 0) return;
    const int nbb = ntok * 8;
    i32x16 ic, in_; f32x16s gc;
    sload16(ic, IDX + (size_t)gw * 128);
    in_ = ic;
#define ROWU(v, e) load_row(Ul, (v)[e] & imask)
#define ROWV(v, e) load_row(Vl, (v)[e] & imask)
    Raw raw[8];
#pragma unroll
    for (int e = 0; e < 8; ++e) raw[e] = ROWU(ic, e);
    float hp[32];
    float op[32];
    int tok = gw;
    for (int bb = 0; bb < nbb; ++bb) {
        const int b = bb & 7;
        if (b == 0) {
            tok = gw + (bb >> 3) * NGW;
            int eo[32]; { int l2 = lane; float z = 0.f; asm volatile("" : "+v"(l2), "+v"(z)); calibrate(eo, l2, z); }
#pragma unroll
            for (int p = 0; p < 32; ++p) hp[p] = bf2f(XN[(size_t)tok * D + eo[p]]);
            PIN16(hp, 0); PIN16(hp, 16);
#pragma unroll
            for (int p = 0; p < 32; ++p) op[p] = 0.f;
        }
        {
            const int nb = (bb + 1 < nbb) ? bb + 1 : bb;
            const size_t nofs = (size_t)(gw + (nb >> 3) * NGW) * 128 + (nb & 7) * 16;
            i32x16 gtmp;
            sload16x2(gtmp, GATE + (size_t)tok * 128 + b * 16, in_, IDX + nofs);
            gc = __builtin_bit_cast(f32x16s, gtmp);
        }
        float s[16];
#pragma unroll
        for (int n = 0; n < 16; ++n) {
            f32x32 f = decode(raw[n & 7]);
            asm volatile("" : "+v"(f) :: "memory");
            if (MODE != 2) raw[n & 7] = (n + 8 < 16) ? ROWU(ic, n + 8) : ROWV(ic, n - 8);
            float a0 = 0.f, a1 = 0.f, a2 = 0.f, a3 = 0.f;
#pragma unroll
            for (int p = 0; p < (MODE == 1 ? 4 : 32); p += 4) { a0 += f[p] * hp[p]; a1 += f[p + 1] * hp[p + 1]; a2 += f[p + 2] * hp[p + 2]; a3 += f[p + 3] * hp[p + 3]; }
            s[n] = (a0 + a1) + (a2 + a3);
            asm volatile("" : "+v"(s[n]));
        }
        float u[4];
        {
            float t8[8];
#pragma unroll
            for (int e = 0; e < 8; ++e) { auto rr = __builtin_amdgcn_permlane32_swap(__float_as_uint(s[e]), __float_as_uint(s[e + 8]), false, false); t8[e] = __uint_as_float(rr[0]) + __uint_as_float(rr[1]); }
#pragma unroll
            for (int e = 0; e < 4; ++e) { auto rr = __builtin_amdgcn_permlane16_swap(__float_as_uint(t8[e]), __float_as_uint(t8[e + 4]), false, false); u[e] = __uint_as_float(rr[0]) + __uint_as_float(rr[1]); }
#pragma unroll
            for (int e = 0; e < 4; ++e) { u[e] += dpp_ror<8>(u[e]); u[e] += dpp_ror<4>(u[e]); u[e] += dpp_ror<2>(u[e]); u[e] += dpp_ror<1>(u[e]); }
        }
        int eo[32];
        if (b == 7) {
            { int l2 = lane; float z = 0.f; asm volatile("" : "+v"(l2), "+v"(z)); calibrate(eo, l2, z); }
            const float* xp = (const float*)(a.ws + WS_X1) + (size_t)tok * D;
#pragma unroll
            for (int p = 0; p < 32; ++p) hp[p] = xp[eo[p]];
        }
        float actv;
        { const int k = lane & 3; const float d = ((k == 0) ? u[0] : (k == 1) ? u[1] : (k == 2) ? u[2] : u[3]) * (1.f / U_SCALE);
          actv = 0.5f * d * (1.f + erff(d * 0.70710678118654752f)) * (1.f / V_SCALE); }
#pragma unroll
        for (int n = 0; n < 16; ++n) {
            f32x32 f = decode(raw[n & 7]);
            asm volatile("" : "+v"(f) :: "memory");
            if (MODE != 2) raw[n & 7] = (n + 8 < 16) ? ROWV(ic, n + 8) : ROWU(in_, n - 8);
            const float g = __int_as_float(__builtin_amdgcn_readlane(__float_as_int(actv), 16 * (n >> 2) + (n & 3))) * gc[n];
#pragma unroll
            for (int p = 0; p < (MODE == 1 ? 2 : 32); ++p) op[p] += g * f[p];
            if (n & 1) { PIN16(op, 16); PIN16(op, 0); }
        }
        ic = in_;
        if (b == 7) {
            float ss = 0.f;
#pragma unroll
            for (int p = 0; p < 32; ++p) ss += op[p] * op[p];
            const float r = rsqrtf(wave_sum(ss) * (1.f / D) + EPS);
            float* dp = dst + (size_t)tok * D;
#pragma unroll
            for (int p = 0; p < 32; ++p) dp[eo[p]] = hp[p] + op[p] * r * gfin[eo[p]];
        }
    }
#undef ROWU
#undef ROWV
}
#undef PIN16
}

namespace peer4 {
using peer::u32x6; using peer::f32x32; using peer::f32x16v; using peer::ROWB; using peer::U_SCALE; using peer::V_SCALE; using peer::dpp_ror;
using peer3::Raw; using peer3::decode; using peer3::calibrate;
typedef unsigned u32x2 __attribute__((ext_vector_type(2)));
typedef float f32x2 __attribute__((ext_vector_type(2)));
constexpr int PF = 4;
#define PIN16(x, o) asm volatile("" : "+v"(x[o]), "+v"(x[o+1]), "+v"(x[o+2]), "+v"(x[o+3]), "+v"(x[o+4]), "+v"(x[o+5]), "+v"(x[o+6]), "+v"(x[o+7]), "+v"(x[o+8]), "+v"(x[o+9]), "+v"(x[o+10]), "+v"(x[o+11]), "+v"(x[o+12]), "+v"(x[o+13]), "+v"(x[o+14]), "+v"(x[o+15]))
__device__ __forceinline__ Raw load_row(const char* tab, int idx, unsigned voff24) {
    const char* rb = tab + (size_t)(unsigned)idx * ROWB; asm volatile("" : "+s"(rb));
    typedef const __attribute__((address_space(1))) u32x2* gptr;
    gptr gp = (gptr)(rb + voff24);
    Raw r; r.a = gp[0]; r.b = gp[1]; r.c = gp[2]; return r;
}
struct Ids { int v[16]; };
__device__ __forceinline__ Ids ids_of(int ent) { Ids I;
#pragma unroll
    for (int e = 0; e < 16; ++e) I.v[e] = __builtin_amdgcn_readlane(ent, e);
    return I; }

__device__ __forceinline__ void phase_peer(const Args& a, LAS unsigned char* lds, int vcu, int G, int tid, int wave, int lane, unsigned xcc, float* dst) {
    const float* mod = (const float*)(a.ws + WS_MOD);
    const bf16* XN = (const bf16*)(a.ws + WS_XN); const char* Ub = (const char*)(a.ws + WS_UB); const char* Vb = (const char*)(a.ws + WS_VB);
    const int* IDX = (const int*)(a.ws + WS_IDX); const float* GATE = (const float*)(a.ws + WS_GATE);
    LAS float* gfin = (LAS float*)(lds + XTRA_OFF + 64);
#pragma unroll
    for (int i = 0; i < 4; ++i) { const int k = tid + NTHR * i; gfin[k] = mod[5 * D + k] * a.in[7][k]; }
    __syncthreads();
    const int gw = vcu * NWAVES + wave, NGW = G * NWAVES;
    const int ntok = (S - gw + NGW - 1) / NGW;
    LAS int* SI = (LAS int*)(lds + RING_OFF + wave * 16384);
    LAS float* SG = (LAS float*)(lds + RING_OFF + wave * 16384 + 512);
    LAS float* ACT = (LAS float*)(lds + RING_OFF + wave * 16384 + 1024);
    const unsigned voff24 = (unsigned)lane * 24u;
    float hp[32];
    f32x2 op[16];
#pragma unroll 1
    for (int t = 0; t < ntok; ++t) {
        const int tok = gw + t * NGW;
        {
            const int i0 = IDX[(size_t)tok * 128 + lane], i1 = IDX[(size_t)tok * 128 + 64 + lane];
            const float g0 = GATE[(size_t)tok * 128 + lane], g1 = GATE[(size_t)tok * 128 + 64 + lane];
            const int k0 = ((i0 >> 11) - (int)xcc) & 7, k1 = ((i1 >> 11) - (int)xcc) & 7;
            int pos0 = 0, pos1 = 0, off = 0;
#pragma unroll
            for (int j = 0; j < 8; ++j) {
                const unsigned long long m0 = __ballot(k0 == j), m1 = __ballot(k1 == j);
                const int n0 = __builtin_popcountll(m0);
                const int c0 = __builtin_amdgcn_mbcnt_hi((unsigned)(m0 >> 32), __builtin_amdgcn_mbcnt_lo((unsigned)m0, 0u));
                const int c1 = __builtin_amdgcn_mbcnt_hi((unsigned)(m1 >> 32), __builtin_amdgcn_mbcnt_lo((unsigned)m1, 0u));
                pos0 = (k0 == j) ? off + c0 : pos0; pos1 = (k1 == j) ? off + n0 + c1 : pos1;
                off += n0 + __builtin_popcountll(m1);
            }
            SI[pos0] = i0; SI[pos1] = i1; SG[pos0] = g0; SG[pos1] = g1;
        }
        {
            int eo[32]; { int l2 = lane; float z = 0.f; asm volatile("" : "+v"(l2), "+v"(z)); calibrate(eo, l2, z); }
#pragma unroll
            for (int p = 0; p < 32; ++p) hp[p] = bf2f(XN[(size_t)tok * D + eo[p]]);
            PIN16(hp, 0); PIN16(hp, 16);
#pragma unroll
            for (int p = 0; p < 16; ++p) op[p] = (f32x2){0.f, 0.f};
        }
        Ids ic = ids_of(SI[lane & 15]), in_ = ic;
        Raw raw[PF];
#pragma unroll
        for (int e = 0; e < PF; ++e) raw[e] = load_row(Ub, ic.v[e], voff24);
#pragma unroll 1
        for (int b = 0; b < 8; ++b) {
            const char* nxt = (b == 7) ? Vb : Ub;
            in_ = ids_of(SI[((b + 1) & 7) * 16 + (lane & 15)]);
            float s[16];
#pragma unroll
            for (int n = 0; n < 16; ++n) {
                f32x32 f = decode(raw[n % PF]);
                asm volatile("" : "+v"(f) :: "memory");
                { const int t2 = n + PF; raw[n % PF] = (t2 < 16) ? load_row(Ub, ic.v[t2 & 15], voff24) : load_row(nxt, in_.v[t2 & 15], voff24); }
                float a0 = 0.f, a1 = 0.f, a2 = 0.f, a3 = 0.f;
#pragma unroll
                for (int p = 0; p < 32; p += 4) { a0 += f[p] * hp[p]; a1 += f[p + 1] * hp[p + 1]; a2 += f[p + 2] * hp[p + 2]; a3 += f[p + 3] * hp[p + 3]; }
                s[n] = (a0 + a1) + (a2 + a3);
                asm volatile("" : "+v"(s[n]));
            }
            float u[4];
            {
                float t8[8];
#pragma unroll
                for (int e = 0; e < 8; ++e) { auto rr = __builtin_amdgcn_permlane32_swap(__float_as_uint(s[e]), __float_as_uint(s[e + 8]), false, false); t8[e] = __uint_as_float(rr[0]) + __uint_as_float(rr[1]); }
#pragma unroll
                for (int e = 0; e < 4; ++e) { auto rr = __builtin_amdgcn_permlane16_swap(__float_as_uint(t8[e]), __float_as_uint(t8[e + 4]), false, false); u[e] = __uint_as_float(rr[0]) + __uint_as_float(rr[1]); }
#pragma unroll
                for (int e = 0; e < 4; ++e) { u[e] += dpp_ror<8>(u[e]); u[e] += dpp_ror<4>(u[e]); u[e] += dpp_ror<2>(u[e]); u[e] += dpp_ror<1>(u[e]); }
            }
            { const int k = lane & 3; const float d = ((k == 0) ? u[0] : (k == 1) ? u[1] : (k == 2) ? u[2] : u[3]) * (1.f / U_SCALE);
              ACT[b * 64 + lane] = 0.5f * d * (1.f + erff(d * 0.70710678118654752f)) * (1.f / V_SCALE); }
            ic = in_;
        }
        int eo[32];
#pragma unroll 1
        for (int b = 0; b < 8; ++b) {
            in_ = ids_of(SI[((b + 1) & 7) * 16 + (lane & 15)]);
            const float coef = ACT[b * 64 + lane] * SG[b * 16 + 4 * (lane >> 4) + (lane & 3)];
            if (b == 7) {
                { int l2 = lane; float z = 0.f; asm volatile("" : "+v"(l2), "+v"(z)); calibrate(eo, l2, z); }
                const float* xp = (const float*)(a.ws + WS_X1) + (size_t)tok * D;
#pragma unroll
                for (int p = 0; p < 32; ++p) hp[p] = xp[eo[p]];
            }
#pragma unroll
            for (int n = 0; n < 16; ++n) {
                f32x32 f = decode(raw[n % PF]);
                asm volatile("" : "+v"(f) :: "memory");
                { const int t2 = n + PF; raw[n % PF] = (t2 < 16) ? load_row(Vb, ic.v[t2 & 15], voff24) : load_row(Vb, in_.v[t2 & 15], voff24); }
                const float g = __int_as_float(__builtin_amdgcn_readlane(__float_as_int(coef), 16 * (n >> 2) + (n & 3)));
                const f32x2 g2 = (f32x2){g, g};
#pragma unroll
                for (int p = 0; p < 16; ++p) op[p] = __builtin_elementwise_fma((f32x2){f[2 * p], f[2 * p + 1]}, g2, op[p]);
            }
            ic = in_;
        }
        {
            float ss = 0.f;
#pragma unroll
            for (int p = 0; p < 16; ++p) ss += op[p].x * op[p].x + op[p].y * op[p].y;
            const float r = rsqrtf(wave_sum(ss) * (1.f / D) + EPS);
            float* dp = dst + (size_t)tok * D;
#pragma unroll
            for (int p = 0; p < 32; ++p) dp[eo[p]] = hp[p] + ((p & 1) ? op[p >> 1].y : op[p >> 1].x) * r * gfin[eo[p]];
        }
    }
}
#undef PIN16
}

namespace topk {
using f32x16 = __attribute__((ext_vector_type(16))) float;
constexpr int LDS_KIMG = 0, LDS_TK = 65536;
__device__ __forceinline__ float swapf(float m) { auto rr = __builtin_amdgcn_permlane32_swap(__float_as_uint(m), __float_as_uint(m), false, false); return (threadIdx.x & 32) ? __uint_as_float(rr[0]) : __uint_as_float(rr[1]); }
__device__ __forceinline__ float max3(float a, float b, float c) { return fmaxf(fmaxf(a, b), c); }

__device__ __forceinline__ void half_topk(const bf16* qrow  , const LAS unsigned char* kimg, int r32, int hi, float (&vals)[16]) {
    bf16x8 qf[8];
#pragma unroll
    for (int ks = 0; ks < 8; ++ks) qf[ks] = *(const bf16x8*)(qrow + ks * 16 + hi * 8);
    float p[64];
#pragma unroll
    for (int blk = 0; blk < 4; ++blk) {
        f32x16 acc = f32x16{};
#pragma unroll
        for (int ks = 0; ks < 8; ++ks) {
            const bf16x8 kf = *(const LAS bf16x8*)(kimg + (ks * 2 + hi) * 2048 + (32 * blk + r32) * 16);
            acc = __builtin_amdgcn_mfma_f32_32x32x16_bf16(kf, qf[ks], acc, 0, 0, 0);
        }
#pragma unroll
        for (int r = 0; r < 16; ++r) { const int key = 32 * blk + (r & 3) + 8 * (r >> 2) + 4 * hi; p[blk * 16 + r] = __uint_as_float((__float_as_uint(acc[r]) & 0xffffff80u) | (unsigned)(127 - key)); }
    }
#pragma unroll
    for (int rd = 0; rd < 16; ++rd) {
        float m = max3(p[0], p[1], p[2]);
#pragma unroll
        for (int i = 3; i < 63; i += 2) m = max3(m, p[i], p[i + 1]);
        m = fmaxf(m, p[63]);
        const float g = fmaxf(m, swapf(m));
        vals[rd] = g;
#pragma unroll
        for (int i = 0; i < 64; ++i) p[i] = (__float_as_uint(p[i]) == __float_as_uint(g)) ? -INFINITY : p[i];
    }
}

__device__ __forceinline__ void phase_topk(const Args& a, LAS unsigned char* lds, int vcu, int G, int tid, int wave, int lane) {
    for (int e = tid; e < 2 * 128 * 16; e += NTHR) {
        const int half = e >> 11, key = (e >> 4) & 127, c = e & 15;
        const float* src = a.in[20 + half] + key * 128 + c * 8;
        const f32x4 x0 = *(const f32x4*)src, x1 = *(const f32x4*)(src + 4);
        v4u o; o.x = pk2(x0.x, x0.y); o.y = pk2(x0.z, x0.w); o.z = pk2(x1.x, x1.y); o.w = pk2(x1.z, x1.w);
        *(LAS v4u*)(lds + LDS_KIMG + half * 32768 + c * 2048 + key * 16) = o;
    }
    __syncthreads();
    const bf16* QP = (const bf16*)(a.ws + WS_QP); int* idx_out = (int*)(a.ws + WS_IDX); float* g_out = (float*)(a.ws + WS_GATE);
    const int r32 = lane & 31, hi = lane >> 5;
    LAS int* tk = (LAS int*)(lds + LDS_TK + wave * 4096) + r32 * 32;
    const int gw = vcu * NWAVES + wave, NGW = G * NWAVES;
    if (wave < 4) convert_tables(a, CVT_EARLY_ROWS, 2 * NEXP, gw, NGW, lane);
    for (int task = gw; task < (S / 32) * PH; task += NGW) {
        const int tb = task >> 3, h = task & 7, token = tb * 32 + r32;
        const bf16* qrow = QP + (size_t)token * D + h * PKD;
        float v1[16], v2[16];
        half_topk(qrow, lds + LDS_KIMG, r32, hi, v1);
        half_topk(qrow + 128, lds + LDS_KIMG + 32768, r32, hi, v2);
        if (hi == 0) {
#pragma unroll
            for (int i = 0; i < 16; ++i) { tk[i] = 127 - (int)(__float_as_uint(v1[i]) & 0x7fu); tk[16 + i] = 127 - (int)(__float_as_uint(v2[i]) & 0x7fu); }
        }
        float c[25];
        {
            int k = 0;
#pragma unroll
            for (int ai = 0; ai < 16; ++ai)
#pragma unroll
                for (int bi = 0; bi < 16; ++bi) if ((ai + 1) * (bi + 1) <= 16) {
                    const float sm = __uint_as_float(__float_as_uint(v1[ai]) & 0xffffff80u) + __uint_as_float(__float_as_uint(v2[bi]) & 0xffffff80u);
                    const float pk = __uint_as_float((__float_as_uint(sm) & 0xffffff00u) | (unsigned)(255 - (ai * 16 + bi)));
                    if ((k & 1) == 0) c[k >> 1] = pk; else c[k >> 1] = hi ? pk : c[k >> 1];
                    ++k;
                }
        }
        float top[16];
#pragma unroll
        for (int rd = 0; rd < 16; ++rd) {
            float m = c[0];
#pragma unroll
            for (int i = 1; i < 25; i += 2) m = max3(m, c[i], c[i + 1]);
            const float g = fmaxf(m, swapf(m));
            top[rd] = g;
#pragma unroll
            for (int i = 0; i < 25; ++i) c[i] = (__float_as_uint(c[i]) == __float_as_uint(g)) ? -INFINITY : c[i];
        }
        asm volatile("s_waitcnt lgkmcnt(0)" ::: "memory");
        const float mx = __uint_as_float(__float_as_uint(top[0]) & 0xffffff00u);
        float ev[16], den = 0.f;
#pragma unroll
        for (int i = 0; i < 16; ++i) { ev[i] = __expf(__uint_as_float(__float_as_uint(top[i]) & 0xffffff00u) - mx); den += ev[i]; }
        const float rden = 1.f / den;
        if (hi == 0) {
            const size_t ob = ((size_t)token * PH + h) * PTOP;
#pragma unroll
            for (int q4 = 0; q4 < 4; ++q4) {
                int oi[4]; float og[4];
#pragma unroll
                for (int i = 0; i < 4; ++i) { const int flat = 255 - (int)(__float_as_uint(top[q4 * 4 + i]) & 0xffu); oi[i] = tk[flat >> 4] * PKEYS + tk[16 + (flat & 15)]; og[i] = ev[q4 * 4 + i] * rden; }
                *(v4u*)(idx_out + ob + q4 * 4) = (v4u){(unsigned)oi[0], (unsigned)oi[1], (unsigned)oi[2], (unsigned)oi[3]};
                *(f32x4*)(g_out + ob + q4 * 4) = (f32x4){og[0], og[1], og[2], og[3]};
            }
        }
        asm volatile("s_waitcnt lgkmcnt(0)" ::: "memory");
    }
    if (wave >= 4) convert_tables(a, CVT_EARLY_ROWS, 2 * NEXP, gw, NGW, lane);
}
}

namespace conv {
constexpr int TCH = 32, ROWS = TCH + CK - 1;
constexpr int LDS_U = 0, LDS_PART = ROWS * CW * 2, LDS_STAT = LDS_PART + 8 * 64 * 4;
template <int N> __device__ __forceinline__ float dpp_ror(float v) { return __int_as_float(__builtin_amdgcn_update_dpp(0, __float_as_int(v), 0x120 + N, 0xf, 0xf, false)); }

__device__ __forceinline__ void phase_conv(const Args& a, LAS unsigned char* lds, int vcu, int G, int tid, int wave, int lane) {
    const bf16* PROJ = (const bf16*)(a.ws + WS_PROJ); bf16* Y = (bf16*)(a.ws + WS_Y);
    const float* conv_w = a.in[14]; const float* conv_b = a.in[15]; const float* ln_g = a.in[16]; const float* ln_b = a.in[17];
    LAS unsigned* ut = (LAS unsigned*)(lds + LDS_U);
    LAS float* part = (LAS float*)(lds + LDS_PART);
    LAS float* stat = (LAS float*)(lds + LDS_STAT);
    float w0[CK], w1[CK];
#pragma unroll
    for (int j = 0; j < CK; ++j) { const float2 wv = *(const float2*)(conv_w + j * CW + 2 * tid); w0[j] = wv.x; w1[j] = wv.y; }
    const float2 cb = *(const float2*)(conv_b + 2 * tid), lg = *(const float2*)(ln_g + 2 * tid), lb = *(const float2*)(ln_b + 2 * tid);
    for (int ch = vcu; ch < S / TCH; ch += G) {
        const int t0 = ch * TCH;
        __syncthreads();
#pragma unroll 8
        for (int r = 0; r < ROWS; ++r) {
            const int tt = t0 - (CK - 1) + r;
            unsigned pk = 0u;
            if (tt >= 0) {
                const unsigned av = *((const unsigned*)(PROJ + (size_t)tt * INC + 3 * AW) + tid);
                const unsigned gv = *((const unsigned*)(PROJ + (size_t)tt * INC + 3 * AW + CW) + tid);
                pk = pk2(bflo(av) * __builtin_amdgcn_rcpf(1.f + __expf(-bflo(gv))), bfhi(av) * __builtin_amdgcn_rcpf(1.f + __expf(-bfhi(gv))));
            }
            ut[r * 512 + tid] = pk;
        }
        __syncthreads();
        float y0[TCH], y1[TCH];
#pragma unroll
        for (int g8 = 0; g8 < 4; ++g8) {
            unsigned uu[38];
#pragma unroll
            for (int r = 0; r < 38; ++r) uu[r] = ut[(g8 * 8 + r) * 512 + tid];
#pragma unroll
            for (int t = 0; t < 8; ++t) {
                float s0 = cb.x, s1 = cb.y;
#pragma unroll
                for (int j = 0; j < CK; ++j) { s0 += w0[j] * bflo(uu[t + j]); s1 += w1[j] * bfhi(uu[t + j]); }
                y0[g8 * 8 + t] = s0; y1[g8 * 8 + t] = s1;
            }
        }
#pragma unroll
        for (int hf = 0; hf < 2; ++hf) {
            float v[32];
#pragma unroll
            for (int t = 0; t < 16; ++t) { const float a0 = y0[hf * 16 + t], a1 = y1[hf * 16 + t]; v[2 * t] = a0 + a1; v[2 * t + 1] = a0 * a0 + a1 * a1; }
            float h16[16];
#pragma unroll
            for (int i = 0; i < 16; ++i) { auto rr = __builtin_amdgcn_permlane32_swap(__float_as_uint(v[i]), __float_as_uint(v[i + 16]), false, false); h16[i] = __uint_as_float(rr[0]) + __uint_as_float(rr[1]); }
            float h8[8];
#pragma unroll
            for (int i = 0; i < 8; ++i) { auto rr = __builtin_amdgcn_permlane16_swap(__float_as_uint(h16[i]), __float_as_uint(h16[i + 8]), false, false); h8[i] = __uint_as_float(rr[0]) + __uint_as_float(rr[1]); }
#pragma unroll
            for (int i = 0; i < 8; ++i) { h8[i] += dpp_ror<8>(h8[i]); h8[i] += dpp_ror<4>(h8[i]); h8[i] += dpp_ror<2>(h8[i]); h8[i] += dpp_ror<1>(h8[i]); }
            if ((lane & 15) == 0) {
                *(LAS f32x4*)(part + wave * 64 + hf * 32 + 8 * (lane >> 4)) = (f32x4){h8[0], h8[1], h8[2], h8[3]};
                *(LAS f32x4*)(part + wave * 64 + hf * 32 + 8 * (lane >> 4) + 4) = (f32x4){h8[4], h8[5], h8[6], h8[7]};
            }
        }
        __syncthreads();
        if (tid < TCH) {
            float s = 0.f, ss = 0.f;
#pragma unroll
            for (int w = 0; w < 8; ++w) { s += part[w * 64 + 2 * tid]; ss += part[w * 64 + 2 * tid + 1]; }
            const float mu = s * (1.f / CW), var = fmaxf(ss * (1.f / CW) - mu * mu, 0.f);
            stat[2 * tid] = mu; stat[2 * tid + 1] = rsqrtf(var + EPS);
        }
        __syncthreads();
#pragma unroll
        for (int t = 0; t < TCH; ++t) {
            const float mu = stat[2 * t], rs = stat[2 * t + 1];
            const float v0 = (y0[t] - mu) * rs * lg.x + lb.x, v1 = (y1[t] - mu) * rs * lg.y + lb.y;
            *((unsigned*)(Y + (size_t)(t0 + t) * D + AW) + tid) = pk2(v0 * __builtin_amdgcn_rcpf(1.f + __expf(-v0)), v1 * __builtin_amdgcn_rcpf(1.f + __expf(-v1)));
        }
    }
}
}
#ifndef PROBE_ID
#define PROBE_ID (-1)
#endif
#ifndef PROBE_K
#define PROBE_K 8
#endif
#define TICK(k) do { if (PROBE_ID >= 0) { const unsigned long long now_ = __builtin_amdgcn_s_memrealtime(); if (PROBE_ID == (k)) tsel_ = now_ - tprev_; tprev_ = now_; } } while (0)
#define TOCK() do { if (PROBE_ID >= 0) tprev_ = __builtin_amdgcn_s_memrealtime(); } while (0)
#ifndef REP_P0A
#define REP_P0A 1
#endif
#ifndef REP_P0B
#define REP_P0B 1
#endif
#ifndef REP_P1
#define REP_P1 1
#endif
#ifndef REP_CONV
#define REP_CONV 1
#endif
#ifndef REP_ATT
#define REP_ATT 1
#endif
#ifndef REP_P3
#define REP_P3 1
#endif
#ifndef REP_P3B
#define REP_P3B 1
#endif
#ifndef REP_P4
#define REP_P4 1
#endif
#ifndef REP_P5
#define REP_P5 1
#endif
#ifndef REP_P6
#define REP_P6 1
#endif
#ifndef REP_BAR
#define REP_BAR 1
#endif
#define REPEAT(n) _Pragma("unroll 1") for (int rep_ = 0; rep_ < (n); ++rep_)
__global__ void __launch_bounds__(NTHR, 2) mega_fwd(Args args) {
    extern __shared__ __attribute__((aligned(16))) unsigned char lds_raw[];
    LAS unsigned char* lds = (LAS unsigned char*)lds_raw;
    int tid = threadIdx.x, lane = tid & 63, wave = __builtin_amdgcn_readfirstlane(tid >> 6);
    const int G = gridDim.x; const int bx = blockIdx.x; const int vcu = (G % 8 == 0) ? (bx % 8) * (G / 8) + bx / 8 : bx;
    for (int u = tid; u < (LDS_BYTES - LDSCTL_OFF) / 4; u += NTHR) ((LAS unsigned*)(lds + LDSCTL_OFF))[u] = 0u;
    __syncthreads();
    gu32* ctl = (gu32*)(args.ws + WS_CTL);
    XcdBarrier bar = xcd_barrier_post((unsigned*)(ctl + CW_BAR), (volatile LAS unsigned*)(lds + MISC_OFF) + 8);

    unsigned long long tprev_ = 0, tsel_ = 0;
#define RETID() do { int t_ = threadIdx.x; asm volatile("" : "+v"(t_)); tid = t_; lane = tid & 63; wave = __builtin_amdgcn_readfirstlane(tid >> 6); } while (0)
    TOCK(); REPEAT(REP_P0A) { RETID(); phase_p0a(args, lds, vcu, G, tid, wave, lane); }
    TICK(0);
    REPEAT(REP_BAR) xcd_barrier(bar);
    TICK(10);
    TOCK(); REPEAT(REP_P0B) { RETID(); phase_p0b(args, lds, vcu, G, tid, wave, lane); }
    TICK(1);
    xcd_barrier(bar);
    TICK(11);
    TOCK(); REPEAT(REP_P1) {
        pg8::Gemm g{(const pg8::bf16_t*)(args.ws + WS_XN), (const pg8::bf16_t*)(args.ws + WS_WIN), S, INC, D};
        pg8::StaticOrder So; So.init(S, INC, G, bx);
        pg8::EpiBf16<0> E{(pg8::bf16_t*)(args.ws + WS_PROJ), INC, nullptr, AW, (size_t)AW, C2};
        pg8::gemm_phase<pg8::EpiBf16<0>, pg8::StaticOrder, true, true>(lds + RING_OFF, g, So, E);
    }
    TICK(2);
    xcd_barrier(bar);
    TICK(12);
    TOCK(); REPEAT(REP_CONV) { RETID(); conv::phase_conv(args, lds, vcu, G, tid, wave, lane); }
    TICK(3);
    TOCK(); REPEAT(REP_ATT) { RETID(); att::attn_phase(args, lds, vcu, G, lane); }
    TICK(4);
    xcd_barrier(bar);
    TICK(13);
    TOCK(); REPEAT(REP_P3) {
        pg8::Gemm g{(const pg8::bf16_t*)(args.ws + WS_Y), (const pg8::bf16_t*)(args.ws + WS_WOUT), S, D, D};
        pg8::StaticOrder So; So.init(S, D, G, bx);
        pg8::EpiBf16<0> E{(pg8::bf16_t*)(args.ws + WS_MIX), D, nullptr, 0, 0, 1.f};
        pg8::gemm_phase<pg8::EpiBf16<0>, pg8::StaticOrder, true, true>(lds + RING_OFF, g, So, E);
    }
    TICK(5);
    xcd_barrier(bar);
    TICK(14);
    TOCK(); REPEAT(REP_P3B) { RETID(); phase_p3b(args, lds, vcu, G, tid, wave, lane); }
    TICK(6);
    xcd_barrier(bar);
    TICK(15);
    TOCK(); REPEAT(REP_P4) {
        pg8::Gemm g{(const pg8::bf16_t*)(args.ws + WS_XN), (const pg8::bf16_t*)(args.ws + WS_WQ), S, D, D};
        pg8::StaticOrder So; So.init(S, D, G, bx);
        pg8::EpiBf16<0> E{(pg8::bf16_t*)(args.ws + WS_QP), D, nullptr, 0, 0, 1.f};
        pg8::gemm_phase<pg8::EpiBf16<0>, pg8::StaticOrder, true, true>(lds + RING_OFF, g, So, E);
    }
    TICK(7);
    xcd_barrier(bar);
    TICK(16);
    TOCK(); REPEAT(REP_P5) { RETID(); topk::phase_topk(args, lds, vcu, G, tid, wave, lane); }
    TICK(8);
    xcd_barrier(bar);
    TICK(17);
    TOCK(); REPEAT(REP_P6) { RETID(); peer4::phase_peer(args, lds, vcu, G, tid, wave, lane, bar.x, (rep_ + 1 < REP_P6) ? (float*)(args.ws + WS_MIX) : args.out); }
    TICK(9);
    if (PROBE_ID >= 0 && blockIdx.x == 0) { const unsigned long long t0_ = __builtin_amdgcn_s_memrealtime(); while (__builtin_amdgcn_s_memrealtime() - t0_ < tsel_ * PROBE_K) __builtin_amdgcn_s_sleep(8); }
}

extern "C" void kernel_launch(void* const* d_in, const int* in_sizes, int n_in, void* d_out, int out_size, void* d_ws, size_t ws_size, hipStream_t stream) {
    static int grid = 0;
    if (grid == 0) {
        if (n_in != 24 || out_size != S * D || ws_size < WS_END) { fprintf(stderr, "kernel_launch: unexpected problem shape (n_in %d, out %d, ws %zu)\n", n_in, out_size, ws_size); grid = -1; return; }
        int dev = 0, cus = 0;
        if (hipGetDevice(&dev) != hipSuccess || hipDeviceGetAttribute(&cus, hipDeviceAttributeMultiprocessorCount, dev) != hipSuccess) { grid = -1; return; }
        if (hipFuncSetAttribute((const void*)mega_fwd, hipFuncAttributeMaxDynamicSharedMemorySize, LDS_BYTES) != hipSuccess) { fprintf(stderr, "kernel_launch: hipFuncSetAttribute failed\n"); grid = -1; return; }
        int per_cu = 0;
        if (hipOccupancyMaxActiveBlocksPerMultiprocessor(&per_cu, (const void*)mega_fwd, NTHR, LDS_BYTES) != hipSuccess || per_cu < 1) fprintf(stderr, "kernel_launch: occupancy query reports %d\n", per_cu);
        (void)hipGetLastError();
        grid = cus;
    }
    if (grid < 0) return;
    if (hipMemsetAsync((char*)d_ws + WS_CTL, 0, CTL_ZERO_BYTES, stream) != hipSuccess) return;
    Args a{};
    for (int i = 0; i < 24; ++i) a.in[i] = (const float*)d_in[i];
    a.out = (float*)d_out; a.ws = (unsigned char*)d_ws;
    hipLaunchKernelGGL(mega_fwd, dim3(grid), dim3(NTHR), LDS_BYTES, stream, a);
}
```
